# Optimizing an MI355X kernel written in HIP

```python
import jax
import jax.numpy as jnp
from jax import lax
import numpy as np


D_MODEL = 1024
BATCH = 4
SEQ = 4096
DEPTH = 2

N_META = 16
BLOCK = 128
EPS = 1e-6
FOX_HEADS = 8
FOX_HEAD_DIM = 64
MLA_HEADS = 8
MLA_Q_RANK = 256
MLA_KV_RANK = 128
MLA_NOPE_DIM = 64
MLA_ROPE_DIM = 32
MLA_V_DIM = 64
ROPE_THETA = 10000.0
SWA_Q_HEADS = 8
SWA_KV_HEADS = 2
SWA_HEAD_DIM = 64
WINDOW = 128
N_BRANCH = 3
BRANCH_WIDTH = FOX_HEADS * FOX_HEAD_DIM
D_FF = 2816
CONV_WIDTH = 3
IN_SPLITS = (FOX_HEADS * FOX_HEAD_DIM, FOX_HEADS * FOX_HEAD_DIM, FOX_HEADS * FOX_HEAD_DIM, FOX_HEADS,
             MLA_Q_RANK, MLA_KV_RANK, MLA_ROPE_DIM,
             SWA_Q_HEADS * SWA_HEAD_DIM, SWA_KV_HEADS * SWA_HEAD_DIM, SWA_KV_HEADS * SWA_HEAD_DIM,
             N_BRANCH * D_MODEL)
IN_WIDTH = sum(IN_SPLITS)

kernel_name = 'hybrid_fox_mla_swa_convffn'


def rms_norm(x, g):
    xf = x.astype(jnp.float32)
    y = xf * lax.rsqrt(jnp.mean(xf * xf, axis=-1, keepdims=True) + EPS)
    return (y * g.astype(jnp.float32)).astype(x.dtype)


def rope(x, pos):
    half = x.shape[-1] // 2
    freqs = ROPE_THETA ** (-jnp.arange(half, dtype=jnp.float32) / half)
    ang = pos.astype(jnp.float32)[:, None] * freqs[None, :]
    cos = jnp.cos(ang)[:, None, :]
    sin = jnp.sin(ang)[:, None, :]
    xf = x.astype(jnp.float32)
    x1, x2 = xf[..., :half], xf[..., half:]
    return jnp.concatenate([x1 * cos - x2 * sin, x2 * cos + x1 * sin], axis=-1).astype(x.dtype)


def alibi_slopes(n_heads):
    return jnp.exp2(-8.0 * jnp.arange(1, n_heads + 1, dtype=jnp.float32) / n_heads)


def causal_block_attention(q, k, v, log_decay=None):
    B, L, H, dk = q.shape
    M = N_META
    nb = (L - M) // BLOCK
    scale = dk ** -0.5
    pos = jnp.arange(L)

    def attend(qb, qpos, kk, vv, kpos, qdec=None, kdec=None):
        s = jnp.einsum('bqhd,bkhd->bhqk', qb, kk, preferred_element_type=jnp.float32) * scale
        if qdec is not None:
            s = s + jnp.swapaxes(qdec, 1, 2)[..., :, None] - jnp.swapaxes(kdec, 1, 2)[..., None, :]
        s = jnp.where(kpos[None, :] <= qpos[:, None], s, -jnp.inf)
        p = jax.nn.softmax(s, axis=-1).astype(vv.dtype)
        return jnp.einsum('bhqk,bkhd->bqhd', p, vv)

    qb = q[:, M:].reshape(B, nb, BLOCK, H, dk).swapaxes(0, 1)
    posb = pos[M:].reshape(nb, BLOCK)
    if log_decay is not None:
        meta = attend(q[:, :M], pos[:M], k[:, :M], v[:, :M], pos[:M], log_decay[:, :M], log_decay[:, :M])
        decb = log_decay[:, M:].reshape(B, nb, BLOCK, H).swapaxes(0, 1)
        real = lax.map(lambda a: attend(a[0], a[1], k, v, pos, a[2], log_decay), (qb, posb, decb))
    else:
        meta = attend(q[:, :M], pos[:M], k[:, :M], v[:, :M], pos[:M])
        real = lax.map(lambda a: attend(a[0], a[1], k, v, pos), (qb, posb))
    real = real.swapaxes(0, 1).reshape(B, L - M, H, v.shape[-1])
    return jnp.concatenate([meta, real], axis=1)


def sliding_window_attention(q, k, v, sinks, slopes):
    B, L, Hq, d = q.shape
    Hkv = k.shape[2]
    G = Hq // Hkv
    M = N_META
    nb = (L - M) // BLOCK
    scale = d ** -0.5
    q = q.reshape(B, L, Hkv, G, d)
    sinks = sinks.astype(jnp.float32).reshape(Hkv, G)
    slopes = slopes.reshape(Hkv, G, 1, 1)

    def attend(qq, kk, vv, valid, dist):
        s = jnp.einsum('...qhgd,...khd->...hgqk', qq, kk, preferred_element_type=jnp.float32) * scale - slopes * dist
        s = jnp.where(valid, s, -jnp.inf)
        sink = jnp.broadcast_to(sinks[:, :, None, None], s.shape[:-1] + (1,))
        p = jax.nn.softmax(jnp.concatenate([s, sink], axis=-1), axis=-1)[..., :-1].astype(vv.dtype)
        return jnp.einsum('...hgqk,...khd->...qhgd', p, vv)

    mpos = jnp.arange(M)
    mdist = (mpos[:, None] - mpos[None, :]).astype(jnp.float32)
    meta = attend(q[:, :M], k[:, :M], v[:, :M], mdist >= 0, mdist)

    def band(t):
        tr = t[:, M:].reshape(B, nb, BLOCK, Hkv, d)
        prev = jnp.concatenate([jnp.zeros_like(tr[:, :1]), tr[:, :-1]], axis=1)
        meta_t = jnp.broadcast_to(t[:, None, :M], (B, nb, M, Hkv, d))
        return jnp.concatenate([meta_t, prev, tr], axis=2)

    blk = jnp.arange(nb)
    qpos = M + blk[:, None] * BLOCK + jnp.arange(BLOCK)[None, :]
    band_pos = M + (blk[:, None] - 1) * BLOCK + jnp.arange(2 * BLOCK)[None, :]
    band_dist = qpos[:, :, None] - band_pos[:, None, :]
    band_ok = (band_pos[:, None, :] >= M) & (band_dist >= 0) & (band_dist < WINDOW)
    meta_dist = qpos[:, :, None] - mpos[None, None, :]
    valid = jnp.concatenate([jnp.ones((nb, BLOCK, M), dtype=bool), band_ok], axis=-1)
    dist = jnp.concatenate([meta_dist, band_dist], axis=-1).astype(jnp.float32)
    qr = q[:, M:].reshape(B, nb, BLOCK, Hkv, G, d)
    real = attend(qr, band(k), band(v), valid[:, None, None], dist[:, None, None])
    return jnp.concatenate([meta.reshape(B, M, Hq, d), real.reshape(B, L - M, Hq, d)], axis=1)


def mixer_block(h, norm1_g, w_in, fox_forget_b, fox_q_g, fox_k_g, mla_q_a_g, mla_w_q_up, mla_kv_a_g,
                mla_w_kv_up, mla_q_g, mla_k_g, swa_q_g, swa_k_g, swa_sinks, w_branch, w_o):
    B, L, _ = h.shape
    pos = jnp.arange(L)
    xn = rms_norm(h, norm1_g)
    proj = xn @ w_in
    offsets = [int(o) for o in np.cumsum(IN_SPLITS)[:-1]]
    fq, fk, fv, ff, cq, ckv, krope, sq, sk, sv, gates = jnp.split(proj, offsets, axis=-1)

    fq = rms_norm(fq.reshape(B, L, FOX_HEADS, FOX_HEAD_DIM), fox_q_g)
    fk = rms_norm(fk.reshape(B, L, FOX_HEADS, FOX_HEAD_DIM), fox_k_g)
    fv = fv.reshape(B, L, FOX_HEADS, FOX_HEAD_DIM)
    log_decay = jnp.cumsum(jax.nn.log_sigmoid((ff + fox_forget_b).astype(jnp.float32)), axis=1)
    out_a = causal_block_attention(fq, fk, fv, log_decay)

    q = (rms_norm(cq, mla_q_a_g) @ mla_w_q_up).reshape(B, L, MLA_HEADS, MLA_NOPE_DIM + MLA_ROPE_DIM)
    q = rms_norm(q, mla_q_g)
    q = jnp.concatenate([q[..., :MLA_NOPE_DIM], rope(q[..., MLA_NOPE_DIM:], pos)], axis=-1)
    kv = (rms_norm(ckv, mla_kv_a_g) @ mla_w_kv_up).reshape(B, L, MLA_HEADS, MLA_NOPE_DIM + MLA_V_DIM)
    k_nope, v_mla = kv[..., :MLA_NOPE_DIM], kv[..., MLA_NOPE_DIM:]
    k = jnp.concatenate([k_nope, jnp.broadcast_to(krope[:, :, None, :], (B, L, MLA_HEADS, MLA_ROPE_DIM))], axis=-1)
    k = rms_norm(k, mla_k_g)
    k = jnp.concatenate([k[..., :MLA_NOPE_DIM], rope(k[..., MLA_NOPE_DIM:], pos)], axis=-1)
    out_b = causal_block_attention(q, k, v_mla)

    sq = rms_norm(sq.reshape(B, L, SWA_Q_HEADS, SWA_HEAD_DIM), swa_q_g)
    sk = rms_norm(sk.reshape(B, L, SWA_KV_HEADS, SWA_HEAD_DIM), swa_k_g)
    sv = sv.reshape(B, L, SWA_KV_HEADS, SWA_HEAD_DIM)
    out_c = sliding_window_attention(sq, sk, sv, swa_sinks, alibi_slopes(SWA_Q_HEADS))

    branches = jnp.stack([out_a.reshape(B, L, BRANCH_WIDTH), out_b.reshape(B, L, BRANCH_WIDTH),
                          out_c.reshape(B, L, BRANCH_WIDTH)], axis=2)
    g = jax.nn.sigmoid(gates.reshape(B, L, N_BRANCH, D_MODEL))
    y = jnp.einsum('blnc,ncd->blnd', branches, w_branch)
    merged = jnp.sum(g * y, axis=2)
    return h + merged @ w_o


def conv_ffn(h, norm2_g, w_up, conv_w, conv_b, w_down):
    L = h.shape[1]
    u = rms_norm(h, norm2_g) @ w_up
    up = jnp.pad(u, ((0, 0), (CONV_WIDTH - 1, 0), (0, 0)))
    c = conv_b
    for i in range(CONV_WIDTH):
        c = c + conv_w[i] * up[:, i:i + L]
    gate, val = jnp.split(c, 2, axis=-1)
    return h + (jax.nn.silu(gate) * val) @ w_down


def setup_inputs(seed: int = 0) -> dict:
    key = jax.random.key(seed)
    ks = jax.random.split(key, 23)
    f32 = jnp.float32
    nrm = lambda k, shape, s: jax.random.normal(k, shape, f32) * s
    gain = lambda k, shape: 1.0 + 0.1 * jax.random.normal(k, shape, f32)
    return {
        'x': nrm(ks[0], (BATCH, SEQ, D_MODEL), 1.0),
        'meta_tokens': nrm(ks[1], (N_META, D_MODEL), 1.0),
        'norm1_g': gain(ks[2], (DEPTH, D_MODEL)),
        'w_in': nrm(ks[3], (DEPTH, D_MODEL, IN_WIDTH), D_MODEL ** -0.5),
        'fox_forget_b': 3.0 + 0.1 * jax.random.normal(ks[4], (DEPTH, FOX_HEADS), f32),
        'fox_q_g': gain(ks[5], (DEPTH, FOX_HEAD_DIM)),
        'fox_k_g': gain(ks[6], (DEPTH, FOX_HEAD_DIM)),
        'mla_q_a_g': gain(ks[7], (DEPTH, MLA_Q_RANK)),
        'mla_w_q_up': nrm(ks[8], (DEPTH, MLA_Q_RANK, MLA_HEADS * (MLA_NOPE_DIM + MLA_ROPE_DIM)), MLA_Q_RANK ** -0.5),
        'mla_kv_a_g': gain(ks[9], (DEPTH, MLA_KV_RANK)),
        'mla_w_kv_up': nrm(ks[10], (DEPTH, MLA_KV_RANK, MLA_HEADS * (MLA_NOPE_DIM + MLA_V_DIM)), MLA_KV_RANK ** -0.5),
        'mla_q_g': gain(ks[11], (DEPTH, MLA_NOPE_DIM + MLA_ROPE_DIM)),
        'mla_k_g': gain(ks[12], (DEPTH, MLA_NOPE_DIM + MLA_ROPE_DIM)),
        'swa_q_g': gain(ks[13], (DEPTH, SWA_HEAD_DIM)),
        'swa_k_g': gain(ks[14], (DEPTH, SWA_HEAD_DIM)),
        'swa_sinks': nrm(ks[15], (DEPTH, SWA_Q_HEADS), 0.5),
        'w_branch': nrm(ks[16], (DEPTH, N_BRANCH, BRANCH_WIDTH, D_MODEL), BRANCH_WIDTH ** -0.5),
        'w_o': nrm(ks[17], (DEPTH, D_MODEL, D_MODEL), D_MODEL ** -0.5),
        'norm2_g': gain(ks[18], (DEPTH, D_MODEL)),
        'ffn_w_up': nrm(ks[19], (DEPTH, D_MODEL, 2 * D_FF), D_MODEL ** -0.5),
        'ffn_conv_w': nrm(ks[20], (DEPTH, CONV_WIDTH, 2 * D_FF), CONV_WIDTH ** -0.5),
        'ffn_conv_b': nrm(ks[21], (DEPTH, 2 * D_FF), 0.02),
        'ffn_w_down': nrm(ks[22], (DEPTH, D_FF, D_MODEL), D_FF ** -0.5),
    }


def reference(x, meta_tokens, norm1_g, w_in, fox_forget_b, fox_q_g, fox_k_g, mla_q_a_g, mla_w_q_up,
              mla_kv_a_g, mla_w_kv_up, mla_q_g, mla_k_g, swa_q_g, swa_k_g, swa_sinks, w_branch, w_o,
              norm2_g, ffn_w_up, ffn_conv_w, ffn_conv_b, ffn_w_down):
    B = x.shape[0]
    meta = jnp.broadcast_to(meta_tokens[None].astype(x.dtype), (B, N_META, x.shape[-1]))
    h = jnp.concatenate([meta, x], axis=1)
    for l in range(DEPTH):
        h = mixer_block(h, norm1_g[l], w_in[l], fox_forget_b[l], fox_q_g[l], fox_k_g[l], mla_q_a_g[l],
                        mla_w_q_up[l], mla_kv_a_g[l], mla_w_kv_up[l], mla_q_g[l], mla_k_g[l], swa_q_g[l],
                        swa_k_g[l], swa_sinks[l], w_branch[l], w_o[l])
        h = conv_ffn(h, norm2_g[l], ffn_w_up[l], ffn_conv_w[l], ffn_conv_b[l], ffn_w_down[l])
    return h[:, N_META:]
```

```cpp
#include <hip/hip_runtime.h>
#include <hip/hip_cooperative_groups.h>
#include <cstdio>
namespace cg = cooperative_groups;

#define DI __device__ __forceinline__
typedef __attribute__((ext_vector_type(8))) short bf16x8;
typedef __attribute__((ext_vector_type(4))) short s16x4;
typedef __attribute__((ext_vector_type(16))) float f32x16;
typedef __attribute__((ext_vector_type(4))) float f32x4;
typedef __attribute__((ext_vector_type(2))) float f32x2;
typedef __attribute__((ext_vector_type(2))) __bf16 bf16x2_t;
typedef unsigned short bf16_t;

constexpr int D = 1024, NBATCH = 4, SEQ = 4096, L = 4112, T = NBATCH * L  , LP = 4224;
constexpr int DFF = 2816;
constexpr int NIN = 2816;
constexpr float EPS = 1e-6f;
constexpr float LOG2E = 1.4426950408889634f;
constexpr int NTHREADS = 512;
constexpr int SMEM_BYTES = 147456 + 64;

constexpr size_t OFF_WIN = 0;
constexpr size_t OFF_WG = OFF_WIN + (size_t)NIN * 1024 * 2;
constexpr size_t OFF_WQUP = OFF_WG + (size_t)3072 * 1024 * 2;
constexpr size_t OFF_WKVUP = OFF_WQUP + (size_t)768 * 256 * 2;
constexpr size_t OFF_WBR = OFF_WKVUP + (size_t)1024 * 128 * 2;
constexpr size_t OFF_WO = OFF_WBR + (size_t)3 * 1024 * 512 * 2;
constexpr size_t OFF_WUP = OFF_WO + (size_t)1024 * 1024 * 2;
constexpr size_t OFF_WDN = OFF_WUP + (size_t)5632 * 1024 * 2;
constexpr size_t OFF_HB = OFF_WDN + (size_t)1024 * 2816 * 2;
constexpr size_t OFF_SS = OFF_HB + (size_t)T * 1024 * 2;
constexpr size_t OFF_SSKR = OFF_SS + (size_t)8 * T * 4;
constexpr size_t OFF_ROPE = OFF_SSKR + (size_t)T * 4;
constexpr size_t OFF_LF = OFF_ROPE + (size_t)L * 32 * 4;
constexpr size_t OFF_CDEC = OFF_LF + (size_t)T * 8 * 4;
constexpr size_t OFF_HMETA = OFF_CDEC + (size_t)32 * LP * 4;
constexpr size_t OFF_KR = OFF_HMETA + (size_t)64 * 1024 * 4;
constexpr size_t OFF_CTR = OFF_KR + (size_t)T * 32 * 2;
constexpr size_t OFF_XBAR = OFF_CTR + 256;
constexpr size_t OFF_ARENA = OFF_XBAR + 3456 * 4 + 128;
constexpr size_t SZ64 = (size_t)NBATCH * 8 * LP * 64 * 2;
constexpr size_t SZ96 = (size_t)NBATCH * 8 * LP * 96 * 2;
constexpr size_t SZKS = (size_t)NBATCH * 2 * LP * 64 * 2;
constexpr size_t A_QF = OFF_ARENA;
constexpr size_t A_QS = A_QF + SZ64;
constexpr size_t A_QM = A_QS + SZ64;
constexpr size_t A_KF = A_QM + SZ96;
constexpr size_t A_VF = A_KF + SZ64;
constexpr size_t A_KS = A_VF + SZ64;
constexpr size_t A_VS = A_KS + SZKS;
constexpr size_t A_KM = A_VS + SZKS;
constexpr size_t A_VM = A_KM + SZ96;
constexpr size_t A_CQ = A_VM + SZ64;
constexpr size_t A_CKV = A_CQ + (size_t)T * 256 * 2;
constexpr size_t A_END = A_CKV + (size_t)T * 128 * 2;
constexpr size_t A_MERGED = A_KF;
constexpr size_t A_ACT = OFF_ARENA;
static_assert((size_t)T * 1024 * 2 <= 2 * SZ64, "merged alias");
static_assert(A_END <= (size_t)256 * 1024 * 1024, "workspace");
static_assert(A_ACT + (size_t)T * 2816 * 2 <= A_END, "act alias");

struct Params {
  const float* in[23];
  float* out;
  unsigned char* ws;
  int ph_lo, ph_hi;
};

__device__ const double ROPE_FREQ[16] = {1.0, 0.5623413251903491, 0.31622776601683794, 0.1778279410038923, 0.1, 0.05623413251903491,
  0.03162277660168379, 0.01778279410038923, 0.01, 0.005623413251903491, 0.0031622776601683794, 0.0017782794100389228, 0.001,
  0.0005623413251903491, 0.00031622776601683794, 0.00017782794100389227};

DI unsigned pk2(float a, float b) {
  f32x2 v = {a, b};
  bf16x2_t r = __builtin_convertvector(v, bf16x2_t);
  return __builtin_bit_cast(unsigned, r);
}
DI uint2 pk4(float a, float b, float c, float d) { return make_uint2(pk2(a, b), pk2(c, d)); }
DI bf16_t f2bf(float v) { return (bf16_t)(pk2(v, 0.f) & 0xffffu); }
DI float bf2f(bf16_t v) { return __uint_as_float(((unsigned)v) << 16); }
DI float xor32(float v) { return v + __shfl_xor(v, 32); }
DI float fexp2(float x) { return __builtin_amdgcn_exp2f(x); }
DI f32x16 mfma32(bf16x8 a, bf16x8 b, f32x16 c) { return __builtin_amdgcn_mfma_f32_32x32x16_bf16(a, b, c, 0, 0, 0); }
DI float* hrow(const Params& p, int b, int pos) {
  return pos >= 16 ? p.out + ((size_t)(b * SEQ + pos - 16)) * D : (float*)(p.ws + OFF_HMETA) + (size_t)(b * 16 + pos) * D;
}

template <int WM, int WN, int TM, int TN, bool LOWREG = false, class RowOff>
DI void gemm_main(const bf16_t* __restrict__ A, RowOff rowoff, int a_kstride, const bf16_t* __restrict__ Bt, int ldb, int n0,
                  int nk, int mvalid, f32x16 (&acc)[TM][TN], char* smem) {
  static_assert(WM * WN == 8, "8 waves");
  constexpr int BM = WM * TM * 32, BN = WN * TN * 32;
  constexpr int NA = (BM + 63) / 64, NB = (BN + 63) / 64;
  constexpr int STAGE = (BM + BN) * 144;
  static_assert(2 * STAGE <= 147456, "smem");
  const int tid = threadIdx.x, lane = tid & 63, wid = __builtin_amdgcn_readfirstlane(tid >> 6);
  const int r = lane & 31, h = lane >> 5;
  const int wm = wid / WN, wn = wid % WN;
  const int lrow = tid >> 3, c8 = tid & 7;
  int aoff[NA];
#pragma unroll
  for (int i = 0; i < NA; ++i) aoff[i] = rowoff(min(lrow + 64 * i, BM - 1)) + c8 * 8;
  const bf16_t* bptr = Bt + (size_t)(n0 + lrow) * ldb + c8 * 8;
  bf16x8 ra0[NA], rb0[NB];
  auto gload = [&](int kt, bf16x8 (&ra)[NA], bf16x8 (&rb)[NB]) {
#pragma unroll
    for (int i = 0; i < NA; ++i) ra[i] = *(const bf16x8*)(A + aoff[i] + (size_t)kt * a_kstride);
#pragma unroll
    for (int i = 0; i < NB; ++i)
      if (BN % 64 == 0 || lrow + 64 * i < BN) rb[i] = *(const bf16x8*)(bptr + (size_t)(64 * i) * ldb + kt * 64);
  };
  auto sstore = [&](int s, bf16x8 (&ra)[NA], bf16x8 (&rb)[NB]) {
    char* as = smem + s * STAGE;
    char* bs = as + BM * 144;
#pragma unroll
    for (int i = 0; i < NA; ++i)
      if (BM % 64 == 0 || lrow + 64 * i < BM) *(bf16x8*)(as + (lrow + 64 * i) * 144 + c8 * 16) = ra[i];
#pragma unroll
    for (int i = 0; i < NB; ++i)
      if (BN % 64 == 0 || lrow + 64 * i < BN) *(bf16x8*)(bs + (lrow + 64 * i) * 144 + c8 * 16) = rb[i];
  };
  const int ntm = min(TM, max(0, (mvalid - wm * TM * 32 + 31) >> 5));
  gload(0, ra0, rb0);
  sstore(0, ra0, rb0);
  if (nk > 1) gload(1, ra0, rb0);
#pragma unroll 1
  for (int kt = 0; kt < nk; ++kt) {
    __syncthreads();
    if (kt + 1 < nk) sstore((kt + 1) & 1, ra0, rb0);
    __builtin_amdgcn_sched_barrier(0);
    if (kt + 2 < nk) gload(kt + 2, ra0, rb0);
    __builtin_amdgcn_sched_barrier(0);
    const char* as = smem + (kt & 1) * STAGE + (wm * TM * 32 + r) * 144 + h * 16;
    const char* bs = smem + (kt & 1) * STAGE + BM * 144 + (wn * TN * 32 + r) * 144 + h * 16;
    if (ntm > 0) {
      __builtin_amdgcn_s_setprio(1);
#pragma unroll
      for (int ks = 0; ks < 4; ++ks) {
        bf16x8 af[TM], bf[TN];
#pragma unroll
        for (int tn = 0; tn < TN; ++tn) bf[tn] = *(const bf16x8*)(bs + tn * 32 * 144 + ks * 32);
#pragma unroll
        for (int tm = 0; tm < TM; ++tm) af[tm] = *(const bf16x8*)(as + tm * 32 * 144 + ks * 32);
#pragma unroll
        for (int tm = 0; tm < TM; ++tm)
#pragma unroll
          for (int tn = 0; tn < TN; ++tn) acc[tm][tn] = mfma32(bf[tn], af[tm], acc[tm][tn]);
        if (LOWREG) __builtin_amdgcn_sched_barrier(0);
      }
      __builtin_amdgcn_s_setprio(0);
    }
  }
  __syncthreads();
}


template <class RowOff>
DI void gemm_rem(const bf16_t* __restrict__ A, RowOff rowoff, int a_kstride, const bf16_t* __restrict__ Bt, int ldb, int n0,
                 int nk, f32x16& acc, char* smem) {
  constexpr int PITCH = 272, STAGE = (64 + 128) * PITCH;
  const int nk2 = nk >> 1;
  const int tid = threadIdx.x, lane = tid & 63, wid = __builtin_amdgcn_readfirstlane(tid >> 6);
  const int r = lane & 31, h = lane >> 5;
  const int wm = wid >> 2, wn = wid & 3;
  const int lrow = tid >> 3, c8 = tid & 7;
  const bf16_t* ap = A + rowoff(lrow) + c8 * 8;
  const bf16_t* bp = Bt + (size_t)(n0 + lrow) * ldb + c8 * 8;
  bf16x8 ra[2][2], rb0[2][2], rb1[2][2];
  auto gload = [&](int k2, int s) {
#pragma unroll
    for (int hf = 0; hf < 2; ++hf) {
      const int kt = 2 * k2 + hf;
      ra[s][hf] = *(const bf16x8*)(ap + (size_t)kt * a_kstride);
      rb0[s][hf] = *(const bf16x8*)(bp + kt * 64);
      rb1[s][hf] = *(const bf16x8*)(bp + (size_t)64 * ldb + kt * 64);
    }
  };
  auto sstore = [&](int st, int s) {
    char* as = smem + st * STAGE;
#pragma unroll
    for (int hf = 0; hf < 2; ++hf) {
      *(bf16x8*)(as + lrow * PITCH + hf * 128 + c8 * 16) = ra[s][hf];
      *(bf16x8*)(as + (64 + lrow) * PITCH + hf * 128 + c8 * 16) = rb0[s][hf];
      *(bf16x8*)(as + (128 + lrow) * PITCH + hf * 128 + c8 * 16) = rb1[s][hf];
    }
  };
  auto compute = [&](int k2) {
    const char* as = smem + (k2 & 1) * STAGE + (wm * 32 + r) * PITCH + h * 16;
    const char* bs = smem + (k2 & 1) * STAGE + (64 + wn * 32 + r) * PITCH + h * 16;
#pragma unroll
    for (int ks = 0; ks < 8; ++ks) {
      const bf16x8 bf = *(const bf16x8*)(bs + ks * 32);
      const bf16x8 af = *(const bf16x8*)(as + ks * 32);
      acc = mfma32(bf, af, acc);
    }
  };
  gload(0, 0);
  gload(1, 1);
  sstore(0, 0);
  __syncthreads();
#pragma unroll 1
  for (int k2 = 0; k2 < nk2; k2 += 2) {
    if (k2 + 2 < nk2) gload(k2 + 2, 0);
    __builtin_amdgcn_sched_barrier(0);
    compute(k2);
    __builtin_amdgcn_sched_barrier(0);
    sstore(1, 1);
    __syncthreads();
    if (k2 + 3 < nk2) gload(k2 + 3, 1);
    __builtin_amdgcn_sched_barrier(0);
    compute(k2 + 1);
    __builtin_amdgcn_sched_barrier(0);
    if (k2 + 2 < nk2) sstore(0, 0);
    __syncthreads();
  }
}

template <int TM, int TN>
DI void zero_acc(f32x16 (&acc)[TM][TN]) {
#pragma unroll
  for (int a = 0; a < TM; ++a)
#pragma unroll
    for (int b = 0; b < TN; ++b)
#pragma unroll
      for (int i = 0; i < 16; ++i) acc[a][b][i] = 0.f;
}

DI int inproj_src_col(int n) {
  if (n < 1536) return n;
  if (n < 2048) return 1960 + (n - 1536);
  if (n < 2176) return 2472 + (n - 2048);
  if (n < 2304) return 2600 + (n - 2176);
  if (n < 2560) return 1544 + (n - 2304);
  if (n < 2688) return 1800 + (n - 2560);
  if (n < 2720) return 1928 + (n - 2688);
  if (n < 2728) return 1536 + (n - 2720);
  return -1;
}
DI void conv_mat(const float* __restrict__ src, int ldsrc, int K, int Np, const float* __restrict__ gain, int map,
                 bf16_t* __restrict__ dst, int& base, char* smem) {
  float* tl = (float*)smem;
  const int tk = K / 64, tn = Np / 64, nt = tk * tn;
  const int G = gridDim.x;
  int start = (int)(((long)blockIdx.x - base) % G);
  if (start < 0) start += G;
  const int tid = threadIdx.x;
  const int lk = tid >> 4, n4 = (tid & 15) * 4;
  const int sn = tid >> 3, k8 = (tid & 7) * 8;
  auto issue = [&](int t, f32x4& a, f32x4& b) {
    const int k0 = (t % tk) * 64, n0 = (t / tk) * 64;
    const int nn = n0 + n4;
    int sc;
    if (map == 0) sc = nn;
    else if (map == 1) sc = inproj_src_col(nn);
    else if (map == 2) sc = 2728 + nn;
    else sc = (nn >> 6) * 32 + (nn & 31) + ((nn & 32) ? DFF : 0);
    a = f32x4{0.f, 0.f, 0.f, 0.f};
    b = a;
    if (sc >= 0) {
      a = *(const f32x4*)(src + (size_t)(k0 + lk) * ldsrc + sc);
      b = *(const f32x4*)(src + (size_t)(k0 + lk + 32) * ldsrc + sc);
    }
    if (gain) {
      const float g0 = gain[k0 + lk], g1 = gain[k0 + lk + 32];
#pragma unroll
      for (int j = 0; j < 4; ++j) { a[j] *= g0; b[j] *= g1; }
    }
  };
  f32x4 ca, cb2;
  int t = start;
  if (t < nt) issue(t, ca, cb2);
  while (t < nt) {
#pragma unroll
    for (int j = 0; j < 4; ++j) {
      tl[(n4 + j) * 65 + lk] = ca[j];
      tl[(n4 + j) * 65 + lk + 32] = cb2[j];
    }
    __syncthreads();
    const int tnx = t + G;
    f32x4 na, nb;
    if (tnx < nt) issue(tnx, na, nb);
    {
      const int k0 = (t % tk) * 64, n0 = (t / tk) * 64;
      float v[8];
#pragma unroll
      for (int j = 0; j < 8; ++j) v[j] = tl[sn * 65 + k8 + j];
      *(uint4*)(dst + (size_t)(n0 + sn) * K + k0 + k8) = make_uint4(pk2(v[0], v[1]), pk2(v[2], v[3]), pk2(v[4], v[5]), pk2(v[6], v[7]));
    }
    __syncthreads();
    ca = na; cb2 = nb;
    t = tnx;
  }
  base += nt;
}
DI void convert_layer(const Params& p, int l, char* smem) {
  unsigned char* ws = p.ws;
  int base = 0;
  const float* w_in = p.in[3] + (size_t)l * 1024 * 5800;
  conv_mat(w_in, 5800, 1024, NIN, p.in[2] + l * 1024, 1, (bf16_t*)(ws + OFF_WIN), base, smem);
  conv_mat(w_in, 5800, 1024, 3072, p.in[2] + l * 1024, 2, (bf16_t*)(ws + OFF_WG), base, smem);
  conv_mat(p.in[8] + (size_t)l * 256 * 768, 768, 256, 768, p.in[7] + l * 256, 0, (bf16_t*)(ws + OFF_WQUP), base, smem);
  conv_mat(p.in[10] + (size_t)l * 128 * 1024, 1024, 128, 1024, p.in[9] + l * 128, 0, (bf16_t*)(ws + OFF_WKVUP), base, smem);
  for (int n = 0; n < 3; ++n)
    conv_mat(p.in[16] + ((size_t)l * 3 + n) * 512 * 1024, 1024, 512, 1024, nullptr, 0,
             (bf16_t*)(ws + OFF_WBR) + (size_t)n * 1024 * 512, base, smem);
  conv_mat(p.in[17] + (size_t)l * 1024 * 1024, 1024, 1024, 1024, nullptr, 0, (bf16_t*)(ws + OFF_WO), base, smem);
  conv_mat(p.in[19] + (size_t)l * 1024 * 5632, 5632, 1024, 5632, p.in[18] + l * 1024, 3, (bf16_t*)(ws + OFF_WUP), base, smem);
  conv_mat(p.in[22] + (size_t)l * 2816 * 1024, 1024, 2816, 1024, nullptr, 0, (bf16_t*)(ws + OFF_WDN), base, smem);
}

DI void phase_init(const Params& p) {
  unsigned char* ws = p.ws;
  const int tid = threadIdx.x, lane = tid & 63, wid = tid >> 6;
  const int gw = blockIdx.x * 8 + wid, nw = gridDim.x * 8;
  const int gt = blockIdx.x * NTHREADS + tid, ntot = gridDim.x * NTHREADS;
  float* ss = (float*)(ws + OFF_SS);
  bf16_t* hb = (bf16_t*)(ws + OFF_HB);
  for (int m = gw; m < T; m += nw) {
    int b = m / L, pos = m - b * L;
    const float* src = pos < 16 ? p.in[1] + pos * D : p.in[0] + ((size_t)(b * SEQ + pos - 16)) * D;
    float* dsth = hrow(p, b, pos);
    float s = 0.f;
#pragma unroll
    for (int i = 0; i < 4; ++i) {
      int c = (i * 64 + lane) * 4;
      f32x4 v = *(const f32x4*)(src + c);
      *(f32x4*)(dsth + c) = v;
      *(uint2*)(hb + (size_t)m * D + c) = pk4(v[0], v[1], v[2], v[3]);
      s += v[0] * v[0] + v[1] * v[1] + v[2] * v[2] + v[3] * v[3];
    }
#pragma unroll
    for (int o = 32; o >= 1; o >>= 1) s += __shfl_xor(s, o);
    if (lane == 0) ss[m] = s;
  }
  for (int i = gt; i < 7 * T; i += ntot) ss[T + i] = 0.f;
  if (gt < 64) ((unsigned*)(ws + OFF_CTR))[gt] = 0u;
  for (int i = gt; i < 3456; i += ntot) ((unsigned*)(ws + OFF_XBAR))[i] = 0u;
  float* rc = (float*)(ws + OFF_ROPE);
  float* rsn = rc + L * 16;
  for (int i = gt; i < L * 16; i += ntot) {
    int pos = i >> 4, c = i & 15;
    double ang = (double)pos * ROPE_FREQ[c];
    double k = rint(ang * 0.15915494309189535);
    double x = ang - k * 6.283185307179586476925;
    double x2 = x * x;
    double sn = 0.0, cs = 0.0;
    double ts = x, tc = 1.0;
#pragma unroll 1
    for (int n = 0; n < 15; ++n) {
      sn += ts;
      cs += tc;
      tc = -tc * x2 / (double)((2 * n + 1) * (2 * n + 2));
      ts = -ts * x2 / (double)((2 * n + 2) * (2 * n + 3));
    }
    rc[i] = (float)cs;
    rsn[i] = (float)sn;
  }
}


struct TileIter {
  int xcd, loc, nloc, per, nt, i;
  bool xmode;
  DI TileIter(int ntiles) {
    nt = ntiles;
    xmode = (gridDim.x & 7) == 0;
    if (xmode) { xcd = blockIdx.x & 7; loc = blockIdx.x >> 3; nloc = gridDim.x >> 3; per = (ntiles + 7) >> 3; i = loc; }
    else { xcd = 0; loc = blockIdx.x; nloc = gridDim.x; per = ntiles; i = loc; }
  }
  DI int next() {
    if (i >= per) return -1;
    const int t = xcd * per + i;
    i += nloc;
    return t < nt ? t : -1;
  }
};

DI void phase_inproj(const Params& p, int l, char* smem) {
  unsigned char* ws = p.ws;
  const bf16_t* hb = (const bf16_t*)(ws + OFF_HB);
  const bf16_t* W = (const bf16_t*)(ws + OFF_WIN);
  const float* ss1 = (const float*)(ws + OFF_SS) + (size_t)(l * 2) * T;
  float* ss_cq = (float*)(ws + OFF_SS) + (size_t)(4 + l) * T;
  float* ss_ckv = (float*)(ws + OFF_SS) + (size_t)(6 + l) * T;
  float* ss_kr = (float*)(ws + OFF_SSKR);
  const int lane = threadIdx.x & 63, wid = __builtin_amdgcn_readfirstlane(threadIdx.x >> 6), r = lane & 31, h = lane >> 5, wm = wid >> 2, wn = wid & 3;
  constexpr int NT = NIN / 256, MT = (T + 255) / 256;
  TileIter tit(NT * MT);
  for (int t = tit.next(); t >= 0; t = tit.next()) {
    const int nt = t % NT, mt = t / NT;
    const int m0 = mt * 256, n0 = nt * 256;
    f32x16 acc[4][2];
    zero_acc(acc);
    gemm_main<2, 4, 4, 2>(hb, [&](int row) { return min(m0 + row, T - 1) * D; }, 64, W, D, n0, D / 64, T - m0, acc, smem);
    const int n0w = n0 + wn * 64;
#pragma unroll
    for (int tm = 0; tm < 4; ++tm) {
      const int m = m0 + wm * 128 + tm * 32 + r;
      const bool valid = m < T;
      const int mm = valid ? m : T - 1;
      const int b = mm / L, pos = mm - b * L;
      const float rs = rsqrtf(ss1[mm] * (1.f / 1024.f) + EPS);
#pragma unroll
      for (int tn = 0; tn < 2; ++tn)
#pragma unroll
        for (int i = 0; i < 16; ++i) acc[tm][tn][i] *= rs;
      float ssq = 0.f;
#pragma unroll
      for (int tn = 0; tn < 2; ++tn)
#pragma unroll
        for (int i = 0; i < 16; ++i) ssq += acc[tm][tn][i] * acc[tm][tn][i];
      if (n0w < 2304) {
        int kind, head, nh;
        const float* gain = nullptr;
        float scale = 1.f;
        bf16_t* dst;
        if (n0w < 512) { kind = 0; head = n0w >> 6; nh = 8; gain = p.in[5] + l * 64; scale = 0.125f * LOG2E; dst = (bf16_t*)(ws + A_QF); }
        else if (n0w < 1024) { kind = 0; head = (n0w - 512) >> 6; nh = 8; gain = p.in[6] + l * 64; dst = (bf16_t*)(ws + A_KF); }
        else if (n0w < 1536) { kind = 1; head = (n0w - 1024) >> 6; nh = 8; dst = (bf16_t*)(ws + A_VF); }
        else if (n0w < 2048) { kind = 0; head = (n0w - 1536) >> 6; nh = 8; gain = p.in[13] + l * 64; scale = 0.125f * LOG2E; dst = (bf16_t*)(ws + A_QS); }
        else if (n0w < 2176) { kind = 0; head = (n0w - 2048) >> 6; nh = 2; gain = p.in[14] + l * 64; dst = (bf16_t*)(ws + A_KS); }
        else { kind = 1; head = (n0w - 2176) >> 6; nh = 2; dst = (bf16_t*)(ws + A_VS); }
        if (kind == 0) {
          const float tot = xor32(ssq);
          const float rr = rsqrtf(tot * (1.f / 64.f) + EPS) * scale;
          bf16_t* drow = dst + ((size_t)(b * nh + head) * LP + pos) * 64;
#pragma unroll
          for (int tn = 0; tn < 2; ++tn)
#pragma unroll
            for (int g4 = 0; g4 < 4; ++g4) {
              const int d = tn * 32 + 8 * g4 + 4 * h;
              const f32x4 gv = *(const f32x4*)(gain + d);
              uint2 o = pk4(acc[tm][tn][4 * g4] * rr * gv[0], acc[tm][tn][4 * g4 + 1] * rr * gv[1],
                            acc[tm][tn][4 * g4 + 2] * rr * gv[2], acc[tm][tn][4 * g4 + 3] * rr * gv[3]);
              if (valid) *(uint2*)(drow + d) = o;
            }
        } else {
          bf16_t* dcol = dst + ((size_t)(b * nh + head) * 64) * LP + pos;
          if (valid) {
#pragma unroll
            for (int tn = 0; tn < 2; ++tn)
#pragma unroll
              for (int i = 0; i < 16; ++i) {
                const int d = tn * 32 + (i & 3) + 8 * (i >> 2) + 4 * h;
                dcol[(size_t)d * LP] = f2bf(acc[tm][tn][i]);
              }
          }
        }
      } else if (n0w < 2688) {
        bf16_t* dst;
        float* ssd;
        int ld, c0;
        if (n0w < 2560) { dst = (bf16_t*)(ws + A_CQ); ssd = ss_cq; ld = 256; c0 = n0w - 2304; }
        else { dst = (bf16_t*)(ws + A_CKV); ssd = ss_ckv; ld = 128; c0 = n0w - 2560; }
        const float tot = xor32(ssq);
        if (valid) {
#pragma unroll
          for (int tn = 0; tn < 2; ++tn)
#pragma unroll
            for (int g4 = 0; g4 < 4; ++g4) {
              const int d = c0 + tn * 32 + 8 * g4 + 4 * h;
              *(uint2*)(dst + (size_t)m * ld + d) =
                  pk4(acc[tm][tn][4 * g4], acc[tm][tn][4 * g4 + 1], acc[tm][tn][4 * g4 + 2], acc[tm][tn][4 * g4 + 3]);
            }
          if (h == 0) atomicAdd(ssd + m, tot);
        }
      } else if (n0w == 2688) {
        float s0 = 0.f;
#pragma unroll
        for (int i = 0; i < 16; ++i) s0 += acc[tm][0][i] * acc[tm][0][i];
        s0 = xor32(s0);
        if (valid) {
          bf16_t* kr = (bf16_t*)(ws + OFF_KR) + (size_t)m * 32;
#pragma unroll
          for (int g4 = 0; g4 < 4; ++g4)
            *(uint2*)(kr + 8 * g4 + 4 * h) =
                pk4(acc[tm][0][4 * g4], acc[tm][0][4 * g4 + 1], acc[tm][0][4 * g4 + 2], acc[tm][0][4 * g4 + 3]);
          if (h == 0) ss_kr[m] = s0;
          float* lf = (float*)(ws + OFF_LF) + (size_t)m * 8 + 4 * h;
          f32x4 o;
#pragma unroll
          for (int j = 0; j < 4; ++j) {
            float x = acc[tm][1][j] + p.in[4][l * 8 + 4 * h + j];
            o[j] = fminf(x, 0.f) - log1pf(__expf(-fabsf(x)));
          }
          *(f32x4*)lf = o;
        }
      }
    }
  }
}

DI void phase_mla_up(const Params& p, int l, char* smem) {
  unsigned char* ws = p.ws;
  const int lane = threadIdx.x & 63, wid = __builtin_amdgcn_readfirstlane(threadIdx.x >> 6), r = lane & 31, h = lane >> 5;
  const float* rope_c = (const float*)(ws + OFF_ROPE);
  const float* rope_s = rope_c + L * 16;
  constexpr int MT = 64;
  {
    const bf16_t* A = (const bf16_t*)(ws + A_CQ);
    const bf16_t* W = (const bf16_t*)(ws + OFF_WQUP);
    const float* ssc = (const float*)(ws + OFF_SS) + (size_t)(4 + l) * T;
    const float* g = p.in[11] + l * 96;
    bf16_t* Qm = (bf16_t*)(ws + A_QM);
    const float qscale = 0.10206207261596575f * LOG2E;
    auto epi = [&](f32x16 (&acc)[1][3], int m, int head) {
      const int b = m / L, pos = m - b * L;
      const float rs = rsqrtf(ssc[m] * (1.f / 256.f) + EPS);
      float ssq = 0.f;
#pragma unroll
      for (int tn = 0; tn < 3; ++tn)
#pragma unroll
        for (int i = 0; i < 16; ++i) { acc[0][tn][i] *= rs; ssq += acc[0][tn][i] * acc[0][tn][i]; }
      ssq = xor32(ssq);
      const float rr = rsqrtf(ssq * (1.f / 96.f) + EPS);
      bf16_t* drow = Qm + ((size_t)(b * 8 + head) * LP + pos) * 96;
#pragma unroll
      for (int tn = 0; tn < 2; ++tn)
#pragma unroll
        for (int g4 = 0; g4 < 4; ++g4) {
          const int d = tn * 32 + 8 * g4 + 4 * h;
          const f32x4 gv = *(const f32x4*)(g + d);
          *(uint2*)(drow + d) = pk4(acc[0][tn][4 * g4] * rr * gv[0] * qscale, acc[0][tn][4 * g4 + 1] * rr * gv[1] * qscale,
                                    acc[0][tn][4 * g4 + 2] * rr * gv[2] * qscale, acc[0][tn][4 * g4 + 3] * rr * gv[3] * qscale);
        }
#pragma unroll
      for (int g4 = 0; g4 < 2; ++g4) {
        const int c = 8 * g4 + 4 * h;
        const f32x4 g1 = *(const f32x4*)(g + 64 + c);
        const f32x4 g2 = *(const f32x4*)(g + 80 + c);
        const f32x4 cs = *(const f32x4*)(rope_c + pos * 16 + c);
        const f32x4 sn = *(const f32x4*)(rope_s + pos * 16 + c);
        float o1[4], o2[4];
#pragma unroll
        for (int j = 0; j < 4; ++j) {
          float x1 = acc[0][2][4 * g4 + j] * rr * g1[j];
          float x2 = acc[0][2][4 * g4 + 8 + j] * rr * g2[j];
          o1[j] = (x1 * cs[j] - x2 * sn[j]) * qscale;
          o2[j] = (x2 * cs[j] + x1 * sn[j]) * qscale;
        }
        *(uint2*)(drow + 64 + c) = pk4(o1[0], o1[1], o1[2], o1[3]);
        *(uint2*)(drow + 80 + c) = pk4(o2[0], o2[1], o2[2], o2[3]);
      }
    };
    for (int t = blockIdx.x; t < 8 * MT; t += gridDim.x) {
      const int head = t % 8, mt = t / 8;
      const int m0 = mt * 256;
      f32x16 acc[1][3];
      zero_acc(acc);
      gemm_main<8, 1, 1, 3>(A, [&](int row) { return (m0 + row) * 256; }, 64, W, 256, head * 96, 4, 256, acc, smem);
      epi(acc, m0 + wid * 32 + r, head);
    }
    for (int nt = (int)blockIdx.x - 8; nt >= 0 && nt < 2; nt += gridDim.x) {
      const int wm = wid >> 2, wn = wid & 3;
      f32x16 acc[1][3];
      zero_acc(acc);
      gemm_main<2, 4, 1, 3>(A, [&](int row) { return min(16384 + row, T - 1) * 256; }, 64, W, 256, nt * 384, 4, 64, acc, smem);
      epi(acc, 16384 + wm * 32 + r, nt * 4 + wn);
    }
  }
  {
    const bf16_t* A = (const bf16_t*)(ws + A_CKV);
    const bf16_t* W = (const bf16_t*)(ws + OFF_WKVUP);
    const float* ssc = (const float*)(ws + OFF_SS) + (size_t)(6 + l) * T;
    const float* ss_kr = (const float*)(ws + OFF_SSKR);
    const bf16_t* krp = (const bf16_t*)(ws + OFF_KR);
    const float* g = p.in[12] + l * 96;
    bf16_t* Km = (bf16_t*)(ws + A_KM);
    bf16_t* Vm = (bf16_t*)(ws + A_VM);
    auto epi = [&](f32x16 (&a)[2], int m, int head, int part) {
      const int b = m / L, pos = m - b * L;
      const float rs = rsqrtf(ssc[m] * (1.f / 128.f) + EPS);
      float ssq = 0.f;
#pragma unroll
      for (int tn = 0; tn < 2; ++tn)
#pragma unroll
        for (int i = 0; i < 16; ++i) { a[tn][i] *= rs; ssq += a[tn][i] * a[tn][i]; }
      ssq = xor32(ssq);
      if (part == 0) {
        const float rr = rsqrtf((ssq + ss_kr[m]) * (1.f / 96.f) + EPS);
        bf16_t* drow = Km + ((size_t)(b * 8 + head) * LP + pos) * 96;
#pragma unroll
        for (int tn = 0; tn < 2; ++tn)
#pragma unroll
          for (int g4 = 0; g4 < 4; ++g4) {
            const int d = tn * 32 + 8 * g4 + 4 * h;
            const f32x4 gv = *(const f32x4*)(g + d);
            *(uint2*)(drow + d) = pk4(a[tn][4 * g4] * rr * gv[0], a[tn][4 * g4 + 1] * rr * gv[1], a[tn][4 * g4 + 2] * rr * gv[2],
                                      a[tn][4 * g4 + 3] * rr * gv[3]);
          }
        const int c0 = 8 * h;
        const bf16x8 k1 = *(const bf16x8*)(krp + (size_t)m * 32 + c0);
        const bf16x8 k2 = *(const bf16x8*)(krp + (size_t)m * 32 + 16 + c0);
        float o1[8], o2[8];
#pragma unroll
        for (int j = 0; j < 8; ++j) {
          float x1 = bf2f((bf16_t)k1[j]) * rr * g[64 + c0 + j];
          float x2 = bf2f((bf16_t)k2[j]) * rr * g[80 + c0 + j];
          float cs = rope_c[pos * 16 + c0 + j], sn = rope_s[pos * 16 + c0 + j];
          o1[j] = x1 * cs - x2 * sn;
          o2[j] = x2 * cs + x1 * sn;
        }
        *(uint4*)(drow + 64 + c0) = make_uint4(pk2(o1[0], o1[1]), pk2(o1[2], o1[3]), pk2(o1[4], o1[5]), pk2(o1[6], o1[7]));
        *(uint4*)(drow + 80 + c0) = make_uint4(pk2(o2[0], o2[1]), pk2(o2[2], o2[3]), pk2(o2[4], o2[5]), pk2(o2[6], o2[7]));
      } else {
        bf16_t* dcol = Vm + ((size_t)(b * 8 + head) * 64) * LP + pos;
#pragma unroll
        for (int tn = 0; tn < 2; ++tn)
#pragma unroll
          for (int i = 0; i < 16; ++i) {
            const int d = tn * 32 + (i & 3) + 8 * (i >> 2) + 4 * h;
            dcol[(size_t)d * LP] = f2bf(a[tn][i]);
          }
      }
    };
    {
      const int wm = wid >> 1, wn = wid & 1;
      for (int t = blockIdx.x; t < 8 * MT; t += gridDim.x) {
        const int head = t % 8, mt = t / 8;
        const int m0 = mt * 256;
        f32x16 acc[2][2];
        zero_acc(acc);
        gemm_main<4, 2, 2, 2>(A, [&](int row) { return (m0 + row) * 128; }, 64, W, 128, head * 128, 2, 256, acc, smem);
#pragma unroll
        for (int tm = 0; tm < 2; ++tm) epi(acc[tm], m0 + wm * 64 + tm * 32 + r, head, wn);
      }
    }
    for (int nt = (int)blockIdx.x - 16; nt >= 0 && nt < 4; nt += gridDim.x) {
      const int wm = wid >> 2, wn = wid & 3;
      f32x16 acc[1][2];
      zero_acc(acc);
      gemm_main<2, 4, 1, 2>(A, [&](int row) { return min(16384 + row, T - 1) * 128; }, 64, W, 128, nt * 256, 2, 64, acc, smem);
      epi(acc[0], 16384 + wm * 32 + r, nt * 2 + (wn >> 1), wn & 1);
    }
  }
  {
    const float* lf = (const float*)(ws + OFF_LF);
    float* cd = (float*)(ws + OFF_CDEC);
    float* wtot = (float*)smem;
    const int tid = threadIdx.x;
    for (int s = (int)blockIdx.x - 32; s >= 0 && s < 32; s += gridDim.x) {
      const int b = s >> 3, hd = s & 7;
      float v[9];
#pragma unroll
      for (int c = 0; c < 9; ++c) {
        const int pos = tid * 9 + c;
        v[c] = pos < L ? lf[((size_t)(b * L + pos)) * 8 + hd] : 0.f;
      }
#pragma unroll
      for (int c = 1; c < 9; ++c) v[c] += v[c - 1];
      float tot = v[8];
#pragma unroll
      for (int o = 1; o < 64; o <<= 1) {
        float u = __shfl_up(tot, o);
        if (lane >= o) tot += u;
      }
      __syncthreads();
      if (lane == 63) wtot[wid] = tot;
      __syncthreads();
      float base = tot - v[8];
      for (int w = 0; w < wid; ++w) base += wtot[w];
#pragma unroll
      for (int c = 0; c < 9; ++c) {
        const int pos = tid * 9 + c;
        if (pos < L) cd[(size_t)s * LP + pos] = v[c] + base;
      }
    }
  }
}

template <int DK, int MODE>
DI void attn_item(bf16_t* Qs, const bf16_t* __restrict__ Ks, const bf16_t* __restrict__ Vt, const float* __restrict__ cdec,
                  int q0, int q_end, float slope2, float sink2, char* smem) {
  constexpr int KROW = (DK + 8) * 2;
  constexpr int KSZ = 64 * KROW;
  constexpr int VSZ = 64 * 136;
  constexpr int STAGE = KSZ + VSZ + 256;
  constexpr int NKC = DK / 8;
  constexpr int NKT = 64 * NKC;
  constexpr int NKL = (NKT + 511) / 512;
  constexpr int NS = DK / 16;
  const int tid = threadIdx.x, lane = tid & 63, w = __builtin_amdgcn_readfirstlane(tid >> 6), r = lane & 31, h = lane >> 5;
  const int qi = q0 + w * 32 + r;
  const bool wave_on = q0 + w * 32 < q_end;
  bf16x8 qf[NS];
#pragma unroll
  for (int s = 0; s < NS; ++s) qf[s] = *(const bf16x8*)(Qs + (size_t)qi * DK + s * 16 + 8 * h);
  const int kt_hi = (q_end - 1) >> 6;
  int t_lo = 0, ntiles;
  if (MODE == 2) { t_lo = max(1, (q0 - 127) >> 6); ntiles = 1 + max(0, kt_hi - t_lo + 1); }
  else ntiles = kt_hi + 1;
  auto tile_of = [&](int j) { return MODE == 2 ? (j == 0 ? 0 : t_lo + j - 1) : j; };

  bf16x8 rk[NKL], rv;
  float rc = 0.f;
  auto gload = [&](int tile) {
    const int k0 = tile * 64;
#pragma unroll
    for (int i = 0; i < NKL; ++i) {
      const int c = tid + i * 512, row = c / NKC, cc = c % NKC;
      if (NKT % 512 == 0 || c < NKT) rk[i] = *(const bf16x8*)(Ks + (size_t)(k0 + row) * DK + cc * 8);
    }
    {
      const int row = tid >> 3, cc = tid & 7;
      rv = *(const bf16x8*)(Vt + (size_t)row * LP + k0 + cc * 8);
    }
    if (MODE == 0 && tid < 64) rc = cdec[k0 + tid] * LOG2E;
  };
  auto sstore = [&](int s) {
    char* kb = smem + s * STAGE;
    char* vb = kb + KSZ;
#pragma unroll
    for (int i = 0; i < NKL; ++i) {
      const int c = tid + i * 512, row = c / NKC, cc = c % NKC;
      if (NKT % 512 == 0 || c < NKT) *(bf16x8*)(kb + row * KROW + cc * 16) = rk[i];
    }
    {
      const int row = tid >> 3, cc = tid & 7;
      s16x4 lo = {rv[0], rv[1], rv[2], rv[3]}, hi = {rv[4], rv[5], rv[6], rv[7]};
      *(s16x4*)(vb + row * 136 + cc * 16) = lo;
      *(s16x4*)(vb + row * 136 + cc * 16 + 8) = hi;
    }
    if (MODE == 0 && tid < 64) *(float*)(vb + VSZ + tid * 4) = rc;
  };

  f32x16 o[2];
#pragma unroll
  for (int i = 0; i < 16; ++i) { o[0][i] = 0.f; o[1][i] = 0.f; }
  float m_run = -1e30f, l_run = 0.f;

  gload(tile_of(0));
  sstore(0);
#pragma unroll
  for (int s = 0; s < NS; ++s) asm volatile("" ::"v"(qf[s]));
  __syncthreads();
  for (int j = 0; j < ntiles; ++j) {
    if (j + 1 < ntiles) gload(tile_of(j + 1));
    __builtin_amdgcn_sched_barrier(0);
    const int k0 = tile_of(j) * 64;
    const char* kb = smem + (j & 1) * STAGE;
    const char* vb = kb + KSZ;
    bool active = wave_on && (k0 <= q0 + w * 32 + 31);
    if (MODE == 2) active = active && (k0 == 0 || k0 + 63 >= q0 + w * 32 - 127);
    if (active) {
      f32x16 s[2];
#pragma unroll
      for (int kt = 0; kt < 2; ++kt) {
#pragma unroll
        for (int i = 0; i < 16; ++i) s[kt][i] = 0.f;
#pragma unroll
        for (int ks = 0; ks < NS; ++ks) {
          bf16x8 kf = *(const bf16x8*)(kb + (kt * 32 + r) * KROW + ks * 32 + h * 16);
          s[kt] = mfma32(kf, qf[ks], s[kt]);
        }
      }
      const bool need_mask = (MODE == 2) || (k0 + 63 > q0 + w * 32);
      float mx = -1e30f;
      if (MODE == 0 || MODE == 2) {
#pragma unroll
        for (int kt = 0; kt < 2; ++kt)
#pragma unroll
          for (int g4 = 0; g4 < 4; ++g4) {
            const int kj0 = k0 + kt * 32 + 8 * g4 + 4 * h;
            f32x4 ck;
            if (MODE == 0) ck = *(const f32x4*)(vb + VSZ + (kt * 32 + 8 * g4 + 4 * h) * 4);
#pragma unroll
            for (int jj = 0; jj < 4; ++jj) {
              if (MODE == 0) s[kt][4 * g4 + jj] -= ck[jj];
              if (MODE == 2) s[kt][4 * g4 + jj] -= slope2 * (float)(qi - kj0 - jj);
            }
          }
      }
      if (__builtin_amdgcn_readfirstlane((int)need_mask)) {
#pragma unroll
        for (int kt = 0; kt < 2; ++kt)
#pragma unroll
          for (int i = 0; i < 16; ++i) {
            const int kj = k0 + kt * 32 + (i & 3) + 8 * (i >> 2) + 4 * h;
            bool ok = kj <= qi;
            if (MODE == 2) ok = ok && (kj < 16 || qi - kj < 128);
            s[kt][i] = ok ? s[kt][i] : -1e30f;
          }
        asm volatile("" ::: "memory");
      }
#pragma unroll
      for (int kt = 0; kt < 2; ++kt)
#pragma unroll
        for (int i = 0; i < 16; ++i) mx = fmaxf(mx, s[kt][i]);
      mx = fmaxf(mx, __shfl_xor(mx, 32));
      const float m_new = fmaxf(m_run, mx);
      const float alpha = fexp2(m_run - m_new);
      m_run = m_new;
      float psum = 0.f;
#pragma unroll
      for (int kt = 0; kt < 2; ++kt)
#pragma unroll
        for (int i = 0; i < 16; ++i) {
          float pv = fexp2(s[kt][i] - m_new);
          s[kt][i] = pv;
          psum += pv;
        }
      l_run = l_run * alpha + psum;
#pragma unroll
      for (int i = 0; i < 16; ++i) { o[0][i] *= alpha; o[1][i] *= alpha; }
#pragma unroll
      for (int kt = 0; kt < 2; ++kt)
#pragma unroll
        for (int st = 0; st < 2; ++st) {
          unsigned pw[4];
#pragma unroll
          for (int u = 0; u < 4; ++u) pw[u] = pk2(s[kt][8 * st + 2 * u], s[kt][8 * st + 2 * u + 1]);
          uint4 pu = make_uint4(pw[0], pw[1], pw[2], pw[3]);
          const bf16x8 pf = __builtin_bit_cast(bf16x8, pu);
#pragma unroll
          for (int dt = 0; dt < 2; ++dt) {
            const char* va = vb + (dt * 32 + r) * 136 + (kt * 32 + 16 * st + 4 * h) * 2;
            const s16x4 lo = *(const s16x4*)va;
            const s16x4 hi = *(const s16x4*)(va + 16);
            const bf16x8 vf = {lo[0], lo[1], lo[2], lo[3], hi[0], hi[1], hi[2], hi[3]};
            o[dt] = mfma32(vf, pf, o[dt]);
          }
        }
    }
    __builtin_amdgcn_sched_barrier(0);
    if (j + 1 < ntiles) sstore((j + 1) & 1);
    __syncthreads();
  }
  float lt = l_run + __shfl_xor(l_run, 32);
  if (MODE == 2) lt += fexp2(sink2 - m_run);
  const float inv = 1.f / lt;
  if (qi < q_end) {
    bf16_t* orow = Qs + (size_t)qi * DK;
#pragma unroll
    for (int dt = 0; dt < 2; ++dt)
#pragma unroll
      for (int g4 = 0; g4 < 4; ++g4) {
        const int d = dt * 32 + 8 * g4 + 4 * h;
        *(uint2*)(orow + d) = pk4(o[dt][4 * g4] * inv, o[dt][4 * g4 + 1] * inv, o[dt][4 * g4 + 2] * inv, o[dt][4 * g4 + 3] * inv);
      }
  }
}

DI int next_item(unsigned* ctr, int* sidx) {
  if (threadIdx.x == 0) *sidx = (int)atomicAdd(ctr, 1u);
  __syncthreads();
  const int idx = *sidx;
  __syncthreads();
  return idx;
}
DI void phase_attn(const Params& p, int l, char* smem) {
  unsigned char* ws = p.ws;
  unsigned* ctr = (unsigned*)(ws + OFF_CTR) + l * 4;
  int* sidx = (int*)(smem + 147456);
  constexpr int NQT = 17, NIT = 32 * NQT;
#pragma unroll 1
  while (true) {
    const int idx = next_item(ctr, sidx);
    if (idx >= NIT) break;
    const int qt = NQT - 1 - (idx >> 5), bh = idx & 31;
    const int q0 = qt == 0 ? 0 : 16 + 256 * (qt - 1), q_end = qt == 0 ? 16 : q0 + 256;
    attn_item<64, 0>((bf16_t*)(ws + A_QF) + (size_t)bh * LP * 64, (const bf16_t*)(ws + A_KF) + (size_t)bh * LP * 64,
                     (const bf16_t*)(ws + A_VF) + (size_t)bh * 64 * LP, (const float*)(ws + OFF_CDEC) + (size_t)bh * LP, q0, q_end,
                     0.f, 0.f, smem);
  }
#pragma unroll 1
  while (true) {
    const int idx = next_item(ctr + 1, sidx);
    if (idx >= NIT) break;
    const int qt = NQT - 1 - (idx >> 5), bh = idx & 31;
    const int q0 = qt == 0 ? 0 : 16 + 256 * (qt - 1), q_end = qt == 0 ? 16 : q0 + 256;
    attn_item<96, 1>((bf16_t*)(ws + A_QM) + (size_t)bh * LP * 96, (const bf16_t*)(ws + A_KM) + (size_t)bh * LP * 96,
                     (const bf16_t*)(ws + A_VM) + (size_t)bh * 64 * LP, nullptr, q0, q_end, 0.f, 0.f, smem);
  }
#pragma unroll 1
  while (true) {
    const int idx = next_item(ctr + 2, sidx);
    if (idx >= NIT) break;
    const int qt = idx >> 5, bh = idx & 31, b = bh >> 3, hq = bh & 7, hk = hq >> 2;
    const int q0 = qt == 0 ? 0 : 16 + 256 * (qt - 1), q_end = qt == 0 ? 16 : q0 + 256;
    const float slope2 = fexp2(-(float)(hq + 1)) * LOG2E;
    const float sink2 = p.in[15][l * 8 + hq] * LOG2E;
    attn_item<64, 2>((bf16_t*)(ws + A_QS) + (size_t)bh * LP * 64, (const bf16_t*)(ws + A_KS) + (size_t)(b * 2 + hk) * LP * 64,
                     (const bf16_t*)(ws + A_VS) + (size_t)(b * 2 + hk) * 64 * LP, nullptr, q0, q_end, slope2, sink2, smem);
  }
}

DI void phase_merge(const Params& p, int l, char* smem) {
  unsigned char* ws = p.ws;
  const bf16_t* hb = (const bf16_t*)(ws + OFF_HB);
  const bf16_t* Wg = (const bf16_t*)(ws + OFF_WG);
  const bf16_t* Wb = (const bf16_t*)(ws + OFF_WBR);
  const float* ss1 = (const float*)(ws + OFF_SS) + (size_t)(l * 2) * T;
  bf16_t* merged = (bf16_t*)(ws + A_MERGED);
  const int lane = threadIdx.x & 63, wid = __builtin_amdgcn_readfirstlane(threadIdx.x >> 6), r = lane & 31, h = lane >> 5, wm = wid >> 1, wn = wid & 1;
  constexpr int NT = 8, MT = 64;
  TileIter tit(NT * MT);
  for (int t = tit.next(); t >= 0; t = tit.next()) {
    const int nt = t % NT, mt = t / NT;
    const int m0 = mt * 256, n0 = nt * 128;
    float rs[2];
#pragma unroll
    for (int tm = 0; tm < 2; ++tm) rs[tm] = rsqrtf(ss1[min(m0 + wm * 64 + tm * 32 + r, T - 1)] * (1.f / 1024.f) + EPS);
#pragma unroll 1
    for (int n = 0; n < 3; ++n) {
      f32x16 acc[2][2];
      zero_acc(acc);
      gemm_main<4, 2, 2, 2, false>(hb, [&](int row) { return min(m0 + row, T - 1) * D; }, 64, Wg + (size_t)n * 1024 * 1024, D, n0, D / 64,
                            T - m0, acc, smem);
      unsigned gp[2][2][8];
#pragma unroll
      for (int tm = 0; tm < 2; ++tm)
#pragma unroll
      for (int tn = 0; tn < 2; ++tn)
#pragma unroll
        for (int u = 0; u < 8; ++u) {
          float a = __builtin_amdgcn_rcpf(1.f + __expf(-acc[tm][tn][2 * u] * rs[tm]));
          float bq = __builtin_amdgcn_rcpf(1.f + __expf(-acc[tm][tn][2 * u + 1] * rs[tm]));
          gp[tm][tn][u] = pk2(a, bq);
        }
      zero_acc(acc);
      const bf16_t* Ab;
      int rstride, kstride;
      if (n == 0) { Ab = (const bf16_t*)(ws + A_QF); rstride = 64; kstride = LP * 64; }
      else if (n == 1) { Ab = (const bf16_t*)(ws + A_QM); rstride = 96; kstride = LP * 96; }
      else { Ab = (const bf16_t*)(ws + A_QS); rstride = 64; kstride = LP * 64; }
      gemm_main<4, 2, 2, 2, false>(Ab, [&](int row) {
        int mr = min(m0 + row, T - 1);
        int b = mr / L, pos = mr - b * L;
        return (b * 8 * LP + pos) * rstride; }, kstride, Wb + (size_t)n * 1024 * 512, 512, n0, 8, T - m0, acc, smem);
#pragma unroll
      for (int tm = 0; tm < 2; ++tm) {
        const int m = m0 + wm * 64 + tm * 32 + r;
        if (m < T) {
#pragma unroll
          for (int tn = 0; tn < 2; ++tn)
#pragma unroll
            for (int g4 = 0; g4 < 4; ++g4) {
              const int col = n0 + wn * 64 + tn * 32 + 8 * g4 + 4 * h;
              uint2* dst = (uint2*)(merged + (size_t)m * D + col);
              uint2 old = make_uint2(0u, 0u);
              if (n > 0) old = *dst;
              const unsigned g0 = gp[tm][tn][2 * g4], g1 = gp[tm][tn][2 * g4 + 1];
              float f0 = __uint_as_float(g0 << 16) * acc[tm][tn][4 * g4] + __uint_as_float(old.x << 16);
              float f1 = __uint_as_float(g0 & 0xffff0000u) * acc[tm][tn][4 * g4 + 1] + __uint_as_float(old.x & 0xffff0000u);
              float f2 = __uint_as_float(g1 << 16) * acc[tm][tn][4 * g4 + 2] + __uint_as_float(old.y << 16);
              float f3 = __uint_as_float(g1 & 0xffff0000u) * acc[tm][tn][4 * g4 + 3] + __uint_as_float(old.y & 0xffff0000u);
              *dst = pk4(f0, f1, f2, f3);
            }
        }
      }
    }
  }
  {
    const int wm1 = wid >> 2, wn1 = wid & 3;
    for (int nt = blockIdx.x; nt < 8; nt += gridDim.x) {
      const int m0 = 16384, n0 = nt * 128;
      const int m = m0 + wm1 * 32 + r;
      const float rs1 = rsqrtf(ss1[m] * (1.f / 1024.f) + EPS);
#pragma unroll 1
      for (int n = 0; n < 3; ++n) {
        f32x16 acc[1][1];
        zero_acc(acc);
        gemm_rem(hb, [&](int row) { return min(m0 + row, T - 1) * D; }, 64, Wg + (size_t)n * 1024 * 1024, D, n0, D / 64, acc[0][0], smem);
        unsigned gp[8];
#pragma unroll
        for (int u = 0; u < 8; ++u)
          gp[u] = pk2(__builtin_amdgcn_rcpf(1.f + __expf(-acc[0][0][2 * u] * rs1)), __builtin_amdgcn_rcpf(1.f + __expf(-acc[0][0][2 * u + 1] * rs1)));
        zero_acc(acc);
        const bf16_t* Ab;
        int rstride, kstride;
        if (n == 0) { Ab = (const bf16_t*)(ws + A_QF); rstride = 64; kstride = LP * 64; }
        else if (n == 1) { Ab = (const bf16_t*)(ws + A_QM); rstride = 96; kstride = LP * 96; }
        else { Ab = (const bf16_t*)(ws + A_QS); rstride = 64; kstride = LP * 64; }
        gemm_rem(Ab, [&](int row) {
          int mr = min(m0 + row, T - 1);
          int b = mr / L, pos = mr - b * L;
          return (b * 8 * LP + pos) * rstride; }, kstride, Wb + (size_t)n * 1024 * 512, 512, n0, 8, acc[0][0], smem);
#pragma unroll
        for (int g4 = 0; g4 < 4; ++g4) {
          const int col = n0 + wn1 * 32 + 8 * g4 + 4 * h;
          uint2* dst = (uint2*)(merged + (size_t)m * D + col);
          uint2 old = make_uint2(0u, 0u);
          if (n > 0) old = *dst;
          const unsigned g0 = gp[2 * g4], g1 = gp[2 * g4 + 1];
          float f0 = __uint_as_float(g0 << 16) * acc[0][0][4 * g4] + __uint_as_float(old.x << 16);
          float f1 = __uint_as_float(g0 & 0xffff0000u) * acc[0][0][4 * g4 + 1] + __uint_as_float(old.x & 0xffff0000u);
          float f2 = __uint_as_float(g1 << 16) * acc[0][0][4 * g4 + 2] + __uint_as_float(old.y << 16);
          float f3 = __uint_as_float(g1 & 0xffff0000u) * acc[0][0][4 * g4 + 3] + __uint_as_float(old.y & 0xffff0000u);
          *dst = pk4(f0, f1, f2, f3);
        }
      }
    }
  }
}


DI void stage_half(const f32x16 (&acc)[4][2], int hp, int wm, int wn, int r, int h, const float (&rowscale)[4], float* stg) {
  if ((wn >> 1) == hp) {
#pragma unroll
    for (int tm = 0; tm < 4; ++tm) {
      float* srow = stg + (wm * 128 + tm * 32 + r) * 132 + (wn & 1) * 64 + 4 * h;
#pragma unroll
      for (int tn = 0; tn < 2; ++tn)
#pragma unroll
        for (int g4 = 0; g4 < 4; ++g4) {
          f32x4 v = {acc[tm][tn][4 * g4] * rowscale[tm], acc[tm][tn][4 * g4 + 1] * rowscale[tm],
                     acc[tm][tn][4 * g4 + 2] * rowscale[tm], acc[tm][tn][4 * g4 + 3] * rowscale[tm]};
          *(f32x4*)(srow + tn * 32 + 8 * g4) = v;
        }
    }
  }
}

DI void phase_resid(const Params& p, const bf16_t* A, int K, const bf16_t* W, float* ss_next, bool last, char* smem) {
  unsigned char* ws = p.ws;
  bf16_t* hb = (bf16_t*)(ws + OFF_HB);
  const int tid = threadIdx.x, lane = tid & 63, wid = __builtin_amdgcn_readfirstlane(tid >> 6), r = lane & 31, h = lane >> 5, wm = wid >> 2, wn = wid & 3;
  constexpr int NT = 4, MT = 64;
  float* stg = (float*)smem;
  TileIter tit(NT * MT);
  for (int t = tit.next(); t >= 0; t = tit.next()) {
    const int nt = t % NT, mt = t / NT;
    const int m0 = mt * 256, n0 = nt * 256;
    f32x16 acc[4][2];
    zero_acc(acc);
    gemm_main<2, 4, 4, 2>(A, [&](int row) { return min(m0 + row, T - 1) * K; }, 64, W, K, n0, K / 64, T - m0, acc, smem);
    const float ones[4] = {1.f, 1.f, 1.f, 1.f};
#pragma unroll 1
    for (int hp = 0; hp < 2; ++hp) {
      const int chunk = tid & 15;
      const int col = n0 + hp * 128 + chunk * 8;
      f32x4 h0[2], h1[2];
      auto hptr = [&](int it) {
        const int m = m0 + (tid >> 4) + 32 * it;
        const int b = m / L, pos = m - b * L;
        return hrow(p, b, pos) + col;
      };
      auto issue = [&](int bt) {
#pragma unroll
        for (int q = 0; q < 2; ++q) {
          const float* hp_ = hptr(bt * 2 + q);
          h0[q] = *(const f32x4*)hp_;
          h1[q] = *(const f32x4*)(hp_ + 4);
        }
      };
      auto process = [&](int bt) {
#pragma unroll
        for (int q = 0; q < 2; ++q) {
          const int row = (tid >> 4) + 32 * (bt * 2 + q);
          const int m = m0 + row;
          float* hp_ = hptr(bt * 2 + q);
          const f32x4 a0 = *(const f32x4*)(stg + row * 132 + chunk * 8);
          const f32x4 a1 = *(const f32x4*)(stg + row * 132 + chunk * 8 + 4);
          f32x4 v0, v1;
          float ssq = 0.f;
#pragma unroll
          for (int j = 0; j < 4; ++j) {
            v0[j] = a0[j] + h0[q][j];
            v1[j] = a1[j] + h1[q][j];
            ssq += v0[j] * v0[j] + v1[j] * v1[j];
          }
          *(f32x4*)hp_ = v0;
          *(f32x4*)(hp_ + 4) = v1;
          if (!last) {
            *(uint4*)(hb + (size_t)m * D + col) = make_uint4(pk2(v0[0], v0[1]), pk2(v0[2], v0[3]), pk2(v1[0], v1[1]), pk2(v1[2], v1[3]));
            ssq += __shfl_xor(ssq, 8);
            ssq += __shfl_xor(ssq, 4);
            ssq += __shfl_xor(ssq, 2);
            ssq += __shfl_xor(ssq, 1);
            if (chunk == 0) atomicAdd(ss_next + m, ssq);
          }
        }
      };
      issue(0);
      stage_half(acc, hp, wm, wn, r, h, ones, stg);
      __syncthreads();
      process(0);
#pragma unroll
      for (int bt = 1; bt < 4; ++bt) {
        __builtin_amdgcn_sched_barrier(0);
        issue(bt);
        process(bt);
      }
      __syncthreads();
    }
  }
  for (int nt = blockIdx.x; nt < 8; nt += gridDim.x) {
    const int m0 = 16384, n0 = nt * 128;
    f32x16 acc[1][1];
    zero_acc(acc);
    gemm_rem(A, [&](int row) { return min(m0 + row, T - 1) * K; }, 64, W, K, n0, K / 64, acc[0][0], smem);
    const int m = m0 + wm * 32 + r;
    const int b = m / L, pos = m - b * L;
    float* hr = hrow(p, b, pos);
    float ssq = 0.f;
    f32x4 hv[4];
#pragma unroll
    for (int g4 = 0; g4 < 4; ++g4) hv[g4] = *(const f32x4*)(hr + n0 + wn * 32 + 8 * g4 + 4 * h);
#pragma unroll
    for (int g4 = 0; g4 < 4; ++g4) {
      const int col = n0 + wn * 32 + 8 * g4 + 4 * h;
      f32x4 v;
#pragma unroll
      for (int j = 0; j < 4; ++j) { v[j] = hv[g4][j] + acc[0][0][4 * g4 + j]; ssq += v[j] * v[j]; }
      *(f32x4*)(hr + col) = v;
      if (!last) *(uint2*)(hb + (size_t)m * D + col) = pk4(v[0], v[1], v[2], v[3]);
    }
    ssq = xor32(ssq);
    if (!last && h == 0) atomicAdd(ss_next + m, ssq);
  }
}

DI void phase_up(const Params& p, int l, char* smem) {
  unsigned char* ws = p.ws;
  const bf16_t* hb = (const bf16_t*)(ws + OFF_HB);
  const bf16_t* W = (const bf16_t*)(ws + OFF_WUP);
  const float* ss2 = (const float*)(ws + OFF_SS) + (size_t)(l * 2 + 1) * T;
  const float* cw = p.in[20] + (size_t)l * 3 * 5632;
  const float* cb = p.in[21] + (size_t)l * 5632;
  bf16_t* act = (bf16_t*)(ws + A_ACT);
  const int tid = threadIdx.x, lane = tid & 63, wid = __builtin_amdgcn_readfirstlane(tid >> 6), r = lane & 31, h = lane >> 5, wm = wid >> 2, wn = wid & 3;
  constexpr int NT = 5632 / 256, MT = (T + 253) / 254;
  float* stg = (float*)smem;
  TileIter tit(NT * MT);
  for (int t = tit.next(); t >= 0; t = tit.next()) {
    const int nt = t % NT, mt = t / NT;
    const int mbase = mt * 254 - 2, n0 = nt * 256;
    f32x16 acc[4][2];
    zero_acc(acc);
    float rsv[4];
#pragma unroll
    for (int tm = 0; tm < 4; ++tm) rsv[tm] = ss2[min(max(mbase + wm * 128 + tm * 32 + r, 0), T - 1)];
    gemm_main<2, 4, 4, 2>(hb, [&](int row) { return min(max(mbase + row, 0), T - 1) * D; }, 64, W, D, n0, D / 64, T - mbase, acc,
                          smem);
#pragma unroll
    for (int tm = 0; tm < 4; ++tm) rsv[tm] = rsqrtf(rsv[tm] * (1.f / 1024.f) + EPS);
#pragma unroll 1
    for (int hp = 0; hp < 2; ++hp) {
      const int chunk = tid & 15, grp = chunk >> 3, jl0 = (chunk & 7) * 4;
      const int jg0 = (n0 / 64 + hp * 2 + grp) * 32 + jl0;
      f32x4 wg[3], wv[3];
#pragma unroll
      for (int i = 0; i < 3; ++i) {
        wg[i] = *(const f32x4*)(cw + i * 5632 + jg0);
        wv[i] = *(const f32x4*)(cw + i * 5632 + DFF + jg0);
      }
      const f32x4 bg = *(const f32x4*)(cb + jg0), bv = *(const f32x4*)(cb + DFF + jg0);
      stage_half(acc, hp, wm, wn, r, h, rsv, stg);
      __syncthreads();
      {
        const float* sgc = stg + grp * 64 + jl0;
#pragma unroll 2
        for (int it = 0; it < 8; ++it) {
          const int row = 2 + (tid >> 4) + 32 * it;
          const int gm = mbase + row;
          if (row < 256 && gm < T) {
            const int b = gm / L, pos = gm - b * L;
            const float* s0 = sgc + row * 132;
            const f32x4 g0 = *(const f32x4*)(s0), v0 = *(const f32x4*)(s0 + 32);
            const f32x4 g1 = *(const f32x4*)(s0 - 132), v1 = *(const f32x4*)(s0 - 132 + 32);
            const f32x4 g2 = *(const f32x4*)(s0 - 264), v2 = *(const f32x4*)(s0 - 264 + 32);
            float o[4];
#pragma unroll
            for (int j = 0; j < 4; ++j) {
              float a = bg[j] + wg[2][j] * g0[j], c = bv[j] + wv[2][j] * v0[j];
              if (pos >= 1) { a += wg[1][j] * g1[j]; c += wv[1][j] * v1[j]; }
              if (pos >= 2) { a += wg[0][j] * g2[j]; c += wv[0][j] * v2[j]; }
              o[j] = a * __builtin_amdgcn_rcpf(1.f + __expf(-a)) * c;
            }
            *(uint2*)(act + (size_t)gm * DFF + jg0) = pk4(o[0], o[1], o[2], o[3]);
          }
        }
      }
      __syncthreads();
    }
  }
}

#define XB_TMO      128
#define XB_XCNT(j)  (256  + 64 * (j))
#define XB_XSUB(j)  (1280 + 64 * (j))
#define XB_XGEN(j)  (2304 + 64 * (j))
#define XB_TOP      3328
#define XB_TOPGEN   3392
#define XB_SPIN_CAP (1u << 22)
DI unsigned xb_ld(unsigned* p) { return __hip_atomic_load(p, __ATOMIC_RELAXED, __HIP_MEMORY_SCOPE_AGENT); }
DI unsigned xb_add(unsigned* p, unsigned v) { return __hip_atomic_fetch_add(p, v, __ATOMIC_RELAXED, __HIP_MEMORY_SCOPE_AGENT); }
DI unsigned xb_xcc_id() { return (unsigned)__builtin_amdgcn_s_getreg((3 << 11) | 20) & 0xFu; }
#define XB_SPIN(cond, bar) do { unsigned _sp = 0; while (cond) { __builtin_amdgcn_s_sleep(1); \
    if ((++_sp & 255u) == 0u) { if (xb_ld(&(bar)[XB_TMO])) break; if (_sp > XB_SPIN_CAP) { atomicAdd(&(bar)[XB_TMO], 1u); break; } } } } while (0)
DI void xcd_barrier_complete(unsigned* bar, unsigned x, unsigned& nloc, unsigned& nx) {
  const unsigned G = gridDim.x;
  unsigned sum, cnt, mine, sp = 0u;
  for (;;) {
    sum = 0u; cnt = 0u; mine = 0u;
#pragma unroll
    for (unsigned j = 0; j < 16; ++j) { const unsigned c = xb_ld(&bar[XB_XCNT(j)]); sum += c; cnt += (c > 0u) ? 1u : 0u; mine = (j == x) ? c : mine; }
    if (sum == G) break;
    __builtin_amdgcn_s_sleep(1);
    if ((++sp & 255u) == 0u) { if (xb_ld(&bar[XB_TMO])) break; if (sp > XB_SPIN_CAP) { atomicAdd(&bar[XB_TMO], 1u); break; } }
  }
  nloc = mine > 0u ? mine : 1u; nx = cnt > 0u ? cnt : 1u;
}
DI void xcd_barrier(unsigned* bar, unsigned x, volatile unsigned* st) {
  asm volatile("s_waitcnt vmcnt(0)" ::: "memory");
  __syncthreads();
  if (threadIdx.x == 0) {
    __builtin_amdgcn_s_waitcnt(0);
    unsigned nloc = st[0], nx = st[1];
    if (nloc == 0u) { xcd_barrier_complete(bar, x, nloc, nx); st[0] = nloc; st[1] = nx; }
    const unsigned old = xb_add(&bar[XB_XSUB(x)], 1u);
    const unsigned gen = old / nloc;
    if (old + 1u == (gen + 1u) * nloc) {
      __builtin_amdgcn_fence(__ATOMIC_RELEASE, "agent");
      asm volatile("s_waitcnt vmcnt(0)" ::: "memory");
      const unsigned og = xb_add(&bar[XB_TOP], 1u);
      const unsigned tg = og / nx;
      if (og + 1u == (tg + 1u) * nx) xb_add(&bar[XB_TOPGEN], 1u);
      else XB_SPIN(xb_ld(&bar[XB_TOPGEN]) == tg, bar);
      __builtin_amdgcn_fence(__ATOMIC_ACQUIRE, "agent");
      xb_add(&bar[XB_XGEN(x)], 1u);
      asm volatile("s_waitcnt vmcnt(0)" ::: "memory");
    } else {
      XB_SPIN(xb_ld(&bar[XB_XGEN(x)]) == gen, bar);
      __builtin_amdgcn_fence(__ATOMIC_ACQUIRE, "agent");
      asm volatile("s_waitcnt vmcnt(0)" ::: "memory");
    }
  }
  __syncthreads();
}

constexpr int NPHASES = 16;
__global__ void __launch_bounds__(NTHREADS, 2) mega_kernel(Params p) {
  __shared__ __attribute__((aligned(16))) char smem[SMEM_BYTES];
  cg::grid_group grid = cg::this_grid();
  unsigned char* ws = p.ws;
  int ph = 0;
  __shared__ __attribute__((aligned(16))) unsigned xb_st[4];
  unsigned* xbar = (unsigned*)(ws + OFF_XBAR);
  const unsigned xb_x = xb_xcc_id();
  if (threadIdx.x < 4) xb_st[threadIdx.x] = 0u;
#define RUN(body)                                   \
  {                                                 \
    if (ph >= p.ph_lo && ph < p.ph_hi) {            \
      body;                                         \
      if (ph + 1 < p.ph_hi) {                       \
        if (ph == 0) {                              \
          grid.sync();                              \
          if (threadIdx.x == 0) (void)xb_add(&xbar[XB_XCNT(xb_x)], 1u); \
        } else xcd_barrier(xbar, xb_x, xb_st);      \
      }                                             \
    }                                               \
    ++ph;                                           \
  }
  RUN(convert_layer(p, 0, smem); phase_init(p));
#define LAYER(l)                                                                                          \
  RUN(phase_inproj(p, l, smem));                                                                          \
  RUN(phase_mla_up(p, l, smem));                                                                          \
  RUN(phase_attn(p, l, smem));                                                                            \
  RUN(phase_merge(p, l, smem));                                                                           \
  RUN(phase_resid(p, (const bf16_t*)(ws + A_MERGED), 1024, (const bf16_t*)(ws + OFF_WO),                  \
                  (float*)(ws + OFF_SS) + (size_t)(l * 2 + 1) * T, false, smem));                         \
  RUN(phase_up(p, l, smem));                                                                              \
  RUN(phase_resid(p, (const bf16_t*)(ws + A_ACT), DFF, (const bf16_t*)(ws + OFF_WDN),                     \
                  (float*)(ws + OFF_SS) + (size_t)((l + 1) * 2) * T, l == 1, smem));
  LAYER(0)
  RUN(convert_layer(p, 1, smem));
  LAYER(1)
#undef LAYER
#undef RUN
}

extern "C" void kernel_launch(void* const* d_in, const int* in_sizes, int n_in, void* d_out, int out_size, void* d_ws,
                              size_t ws_size, hipStream_t stream) {
  static int grid_blocks = 0;
  if (!grid_blocks) {
    int dev = 0, cus = 0, per_cu = 0;
    hipGetDevice(&dev);
    hipDeviceGetAttribute(&cus, hipDeviceAttributeMultiprocessorCount, dev);
    hipOccupancyMaxActiveBlocksPerMultiprocessor(&per_cu, mega_kernel, NTHREADS, 0);
    if (per_cu < 1) per_cu = 1;
    if (per_cu > 1) per_cu = 1;
    grid_blocks = cus * per_cu;
    if (ws_size < A_END) fprintf(stderr, "workspace too small: %zu < %zu\n", ws_size, (size_t)A_END);
  }
  Params p{};
  for (int i = 0; i < 23; ++i) p.in[i] = (const float*)d_in[i];
  p.out = (float*)d_out;
  p.ws = (unsigned char*)d_ws;
  p.ph_lo = 0;
  p.ph_hi = NPHASES;
  void* args[] = {&p};
  hipError_t e = hipLaunchCooperativeKernel((void*)mega_kernel, dim3(grid_blocks), dim3(NTHREADS), args, 0, stream);
  if (e != hipSuccess) fprintf(stderr, "cooperative launch failed: %s (grid %d)\n", hipGetErrorString(e), grid_blocks);
}
```

```cpp
#include <hip/hip_runtime.h>
#include <hip/hip_cooperative_groups.h>
#include <cstdio>
namespace cg = cooperative_groups;

#define DI __device__ __forceinline__
typedef __attribute__((ext_vector_type(8))) short bf16x8;
typedef __attribute__((ext_vector_type(4))) short s16x4;
typedef __attribute__((ext_vector_type(16))) float f32x16;
typedef __attribute__((ext_vector_type(4))) float f32x4;
typedef __attribute__((ext_vector_type(2))) float f32x2;
typedef __attribute__((ext_vector_type(2))) __bf16 bf16x2_t;
typedef unsigned short bf16_t;

constexpr int D = 1024, NBATCH = 4, SEQ = 4096, L = 4112, T = NBATCH * L  , LP = 4224;
constexpr int DFF = 2816;
constexpr int NIN = 2816;
constexpr float EPS = 1e-6f;
constexpr float LOG2E = 1.4426950408889634f;
constexpr int NTHREADS = 512;
constexpr int SMEM_BYTES = 147456 + 64;

constexpr size_t OFF_WIN = 0;
constexpr size_t OFF_WG = OFF_WIN + (size_t)NIN * 1024 * 2;
constexpr size_t OFF_WQUP = OFF_WG + (size_t)3072 * 1024 * 2;
constexpr size_t OFF_WKVUP = OFF_WQUP + (size_t)768 * 256 * 2;
constexpr size_t OFF_WBR = OFF_WKVUP + (size_t)1024 * 128 * 2;
constexpr size_t OFF_WO = OFF_WBR + (size_t)3 * 1024 * 512 * 2;
constexpr size_t OFF_WUP = OFF_WO + (size_t)1024 * 1024 * 2;
constexpr size_t OFF_WDN = OFF_WUP + (size_t)5632 * 1024 * 2;
constexpr size_t OFF_HB = OFF_WDN + (size_t)1024 * 2816 * 2;
constexpr size_t OFF_SS = OFF_HB + (size_t)T * 1024 * 2;
constexpr size_t OFF_SSKR = OFF_SS + (size_t)8 * T * 4;
constexpr size_t OFF_ROPE = OFF_SSKR + (size_t)T * 4;
constexpr size_t OFF_LF = OFF_ROPE + (size_t)L * 32 * 4;
constexpr size_t OFF_CDEC = OFF_LF + (size_t)T * 8 * 4;
constexpr size_t OFF_HMETA = OFF_CDEC + (size_t)32 * LP * 4;
constexpr size_t OFF_KR = OFF_HMETA + (size_t)64 * 1024 * 4;
constexpr size_t OFF_CTR = OFF_KR + (size_t)T * 32 * 2;
constexpr size_t OFF_XBAR = OFF_CTR + 256;
constexpr size_t OFF_ARENA = OFF_XBAR + 3456 * 4 + 128;
constexpr size_t SZ64 = (size_t)NBATCH * 8 * LP * 64 * 2;
constexpr size_t SZ96 = (size_t)NBATCH * 8 * LP * 96 * 2;
constexpr size_t SZKS = (size_t)NBATCH * 2 * LP * 64 * 2;
constexpr size_t A_QF = OFF_ARENA;
constexpr size_t A_QS = A_QF + SZ64;
constexpr size_t A_QM = A_QS + SZ64;
constexpr size_t A_KF = A_QM + SZ96;
constexpr size_t A_VF = A_KF + SZ64;
constexpr size_t A_KS = A_VF + SZ64;
constexpr size_t A_VS = A_KS + SZKS;
constexpr size_t A_KM = A_VS + SZKS;
constexpr size_t A_VM = A_KM + SZ96;
constexpr size_t A_CQ = A_VM + SZ64;
constexpr size_t A_CKV = A_CQ + (size_t)T * 256 * 2;
constexpr size_t A_END = A_CKV + (size_t)T * 128 * 2;
constexpr size_t A_MERGED = A_KF;
constexpr size_t A_ACT = OFF_ARENA;
static_assert((size_t)T * 1024 * 2 <= 2 * SZ64, "merged alias");
static_assert(A_END <= (size_t)256 * 1024 * 1024, "workspace");
static_assert(A_ACT + (size_t)T * 2816 * 2 <= A_END, "act alias");

struct Params {
  const float* in[23];
  float* out;
  unsigned char* ws;
  int ph_lo, ph_hi;
};

__device__ const double ROPE_FREQ[16] = {1.0, 0.5623413251903491, 0.31622776601683794, 0.1778279410038923, 0.1, 0.05623413251903491,
  0.03162277660168379, 0.01778279410038923, 0.01, 0.005623413251903491, 0.0031622776601683794, 0.0017782794100389228, 0.001,
  0.0005623413251903491, 0.00031622776601683794, 0.00017782794100389227};

DI unsigned pk2(float a, float b) {
  f32x2 v = {a, b};
  bf16x2_t r = __builtin_convertvector(v, bf16x2_t);
  return __builtin_bit_cast(unsigned, r);
}
DI uint2 pk4(float a, float b, float c, float d) { return make_uint2(pk2(a, b), pk2(c, d)); }
DI bf16_t f2bf(float v) { return (bf16_t)(pk2(v, 0.f) & 0xffffu); }
DI float bf2f(bf16_t v) { return __uint_as_float(((unsigned)v) << 16); }
DI float xor32(float v) {
  const auto r = __builtin_amdgcn_permlane32_swap(__float_as_uint(v), __float_as_uint(v), false, false);
  return __uint_as_float(r[0]) + __uint_as_float(r[1]);
}
DI float max32(float v) {
  const auto r = __builtin_amdgcn_permlane32_swap(__float_as_uint(v), __float_as_uint(v), false, false);
  return fmaxf(__uint_as_float(r[0]), __uint_as_float(r[1]));
}
DI float fexp2(float x) { return __builtin_amdgcn_exp2f(x); }
DI f32x16 mfma32(bf16x8 a, bf16x8 b, f32x16 c) { return __builtin_amdgcn_mfma_f32_32x32x16_bf16(a, b, c, 0, 0, 0); }
DI float* hrow(const Params& p, int b, int pos) {
  return pos >= 16 ? p.out + ((size_t)(b * SEQ + pos - 16)) * D : (float*)(p.ws + OFF_HMETA) + (size_t)(b * 16 + pos) * D;
}

template <int WM, int WN, int TM, int TN, bool LOWREG = false, class RowOff>
DI void gemm_main(const bf16_t* __restrict__ A, RowOff rowoff, int a_kstride, const bf16_t* __restrict__ Bt, int ldb, int n0,
                  int nk, int mvalid, f32x16 (&acc)[TM][TN], char* smem) {
  static_assert(WM * WN == 8, "8 waves");
  constexpr int BM = WM * TM * 32, BN = WN * TN * 32;
  constexpr int NA = (BM + 63) / 64, NB = (BN + 63) / 64;
  constexpr int STAGE = (BM + BN) * 144;
  static_assert(2 * STAGE <= 147456, "smem");
  const int tid = threadIdx.x, lane = tid & 63, wid = __builtin_amdgcn_readfirstlane(tid >> 6);
  const int r = lane & 31, h = lane >> 5;
  const int wm = wid / WN, wn = wid % WN;
  const int lrow = tid >> 3, c8 = tid & 7;
  int aoff[NA];
#pragma unroll
  for (int i = 0; i < NA; ++i) aoff[i] = rowoff(min(lrow + 64 * i, BM - 1)) + c8 * 8;
  const bf16_t* bptr = Bt + (size_t)(n0 + lrow) * ldb + c8 * 8;
  bf16x8 ra0[NA], rb0[NB];
  auto gload = [&](int kt, bf16x8 (&ra)[NA], bf16x8 (&rb)[NB]) {
#pragma unroll
    for (int i = 0; i < NA; ++i) ra[i] = *(const bf16x8*)(A + aoff[i] + (size_t)kt * a_kstride);
#pragma unroll
    for (int i = 0; i < NB; ++i)
      if (BN % 64 == 0 || lrow + 64 * i < BN) rb[i] = *(const bf16x8*)(bptr + (size_t)(64 * i) * ldb + kt * 64);
  };
  auto sstore = [&](int s, bf16x8 (&ra)[NA], bf16x8 (&rb)[NB]) {
    char* as = smem + s * STAGE;
    char* bs = as + BM * 144;
#pragma unroll
    for (int i = 0; i < NA; ++i)
      if (BM % 64 == 0 || lrow + 64 * i < BM) *(bf16x8*)(as + (lrow + 64 * i) * 144 + c8 * 16) = ra[i];
#pragma unroll
    for (int i = 0; i < NB; ++i)
      if (BN % 64 == 0 || lrow + 64 * i < BN) *(bf16x8*)(bs + (lrow + 64 * i) * 144 + c8 * 16) = rb[i];
  };
  const int ntm = min(TM, max(0, (mvalid - wm * TM * 32 + 31) >> 5));
  gload(0, ra0, rb0);
  sstore(0, ra0, rb0);
  if (nk > 1) gload(1, ra0, rb0);
#pragma unroll 1
  for (int kt = 0; kt < nk; ++kt) {
    __syncthreads();
    if (kt + 1 < nk) sstore((kt + 1) & 1, ra0, rb0);
    __builtin_amdgcn_sched_barrier(0);
    if (kt + 2 < nk) gload(kt + 2, ra0, rb0);
    __builtin_amdgcn_sched_barrier(0);
    const char* as = smem + (kt & 1) * STAGE + (wm * TM * 32 + r) * 144 + h * 16;
    const char* bs = smem + (kt & 1) * STAGE + BM * 144 + (wn * TN * 32 + r) * 144 + h * 16;
    if (ntm > 0) {
      __builtin_amdgcn_s_setprio(1);
#pragma unroll
      for (int ks = 0; ks < 4; ++ks) {
        bf16x8 af[TM], bf[TN];
#pragma unroll
        for (int tn = 0; tn < TN; ++tn) bf[tn] = *(const bf16x8*)(bs + tn * 32 * 144 + ks * 32);
#pragma unroll
        for (int tm = 0; tm < TM; ++tm) af[tm] = *(const bf16x8*)(as + tm * 32 * 144 + ks * 32);
#pragma unroll
        for (int tm = 0; tm < TM; ++tm)
#pragma unroll
          for (int tn = 0; tn < TN; ++tn) acc[tm][tn] = mfma32(bf[tn], af[tm], acc[tm][tn]);
        if (LOWREG) __builtin_amdgcn_sched_barrier(0);
      }
      __builtin_amdgcn_s_setprio(0);
    }
  }
  __syncthreads();
}


template <class RowOff>
DI void gemm_rem(const bf16_t* __restrict__ A, RowOff rowoff, int a_kstride, const bf16_t* __restrict__ Bt, int ldb, int n0,
                 int nk, f32x16& acc, char* smem) {
  constexpr int PITCH = 272, STAGE = (64 + 128) * PITCH;
  const int nk2 = nk >> 1;
  const int tid = threadIdx.x, lane = tid & 63, wid = __builtin_amdgcn_readfirstlane(tid >> 6);
  const int r = lane & 31, h = lane >> 5;
  const int wm = wid >> 2, wn = wid & 3;
  const int lrow = tid >> 3, c8 = tid & 7;
  const bf16_t* ap = A + rowoff(lrow) + c8 * 8;
  const bf16_t* bp = Bt + (size_t)(n0 + lrow) * ldb + c8 * 8;
  bf16x8 ra[2][2], rb0[2][2], rb1[2][2];
  auto gload = [&](int k2, int s) {
#pragma unroll
    for (int hf = 0; hf < 2; ++hf) {
      const int kt = 2 * k2 + hf;
      ra[s][hf] = *(const bf16x8*)(ap + (size_t)kt * a_kstride);
      rb0[s][hf] = *(const bf16x8*)(bp + kt * 64);
      rb1[s][hf] = *(const bf16x8*)(bp + (size_t)64 * ldb + kt * 64);
    }
  };
  auto sstore = [&](int st, int s) {
    char* as = smem + st * STAGE;
#pragma unroll
    for (int hf = 0; hf < 2; ++hf) {
      *(bf16x8*)(as + lrow * PITCH + hf * 128 + c8 * 16) = ra[s][hf];
      *(bf16x8*)(as + (64 + lrow) * PITCH + hf * 128 + c8 * 16) = rb0[s][hf];
      *(bf16x8*)(as + (128 + lrow) * PITCH + hf * 128 + c8 * 16) = rb1[s][hf];
    }
  };
  auto compute = [&](int k2) {
    const char* as = smem + (k2 & 1) * STAGE + (wm * 32 + r) * PITCH + h * 16;
    const char* bs = smem + (k2 & 1) * STAGE + (64 + wn * 32 + r) * PITCH + h * 16;
#pragma unroll
    for (int ks = 0; ks < 8; ++ks) {
      const bf16x8 bf = *(const bf16x8*)(bs + ks * 32);
      const bf16x8 af = *(const bf16x8*)(as + ks * 32);
      acc = mfma32(bf, af, acc);
    }
  };
  gload(0, 0);
  gload(1, 1);
  sstore(0, 0);
  __syncthreads();
#pragma unroll 1
  for (int k2 = 0; k2 < nk2; k2 += 2) {
    if (k2 + 2 < nk2) gload(k2 + 2, 0);
    __builtin_amdgcn_sched_barrier(0);
    compute(k2);
    __builtin_amdgcn_sched_barrier(0);
    sstore(1, 1);
    __syncthreads();
    if (k2 + 3 < nk2) gload(k2 + 3, 1);
    __builtin_amdgcn_sched_barrier(0);
    compute(k2 + 1);
    __builtin_amdgcn_sched_barrier(0);
    if (k2 + 2 < nk2) sstore(0, 0);
    __syncthreads();
  }
}

template <int TM, int TN>
DI void zero_acc(f32x16 (&acc)[TM][TN]) {
#pragma unroll
  for (int a = 0; a < TM; ++a)
#pragma unroll
    for (int b = 0; b < TN; ++b)
#pragma unroll
      for (int i = 0; i < 16; ++i) acc[a][b][i] = 0.f;
}

DI int inproj_src_col(int n) {
  if (n < 1536) return n;
  if (n < 2048) return 1960 + (n - 1536);
  if (n < 2176) return 2472 + (n - 2048);
  if (n < 2304) return 2600 + (n - 2176);
  if (n < 2560) return 1544 + (n - 2304);
  if (n < 2688) return 1800 + (n - 2560);
  if (n < 2720) return 1928 + (n - 2688);
  if (n < 2728) return 1536 + (n - 2720);
  return -1;
}
DI void conv_mat(const float* __restrict__ src, int ldsrc, int K, int Np, const float* __restrict__ gain, int map,
                 bf16_t* __restrict__ dst, int& base, char* smem) {
  float* tl = (float*)smem;
  const int tk = K / 64, tn = Np / 64, nt = tk * tn;
  const int G = gridDim.x;
  int start = (int)(((long)blockIdx.x - base) % G);
  if (start < 0) start += G;
  const int tid = threadIdx.x;
  const int lk = tid >> 4, n4 = (tid & 15) * 4;
  const int sn = tid >> 3, k8 = (tid & 7) * 8;
  auto issue = [&](int t, f32x4& a, f32x4& b) {
    const int k0 = (t % tk) * 64, n0 = (t / tk) * 64;
    const int nn = n0 + n4;
    int sc;
    if (map == 0) sc = nn;
    else if (map == 1) sc = inproj_src_col(nn);
    else if (map == 2) sc = 2728 + nn;
    else sc = (nn >> 6) * 32 + (nn & 31) + ((nn & 32) ? DFF : 0);
    a = f32x4{0.f, 0.f, 0.f, 0.f};
    b = a;
    if (sc >= 0) {
      a = *(const f32x4*)(src + (size_t)(k0 + lk) * ldsrc + sc);
      b = *(const f32x4*)(src + (size_t)(k0 + lk + 32) * ldsrc + sc);
    }
    if (gain) {
      const float g0 = gain[k0 + lk], g1 = gain[k0 + lk + 32];
#pragma unroll
      for (int j = 0; j < 4; ++j) { a[j] *= g0; b[j] *= g1; }
    }
  };
  f32x4 ca, cb2;
  int t = start;
  if (t < nt) issue(t, ca, cb2);
  while (t < nt) {
#pragma unroll
    for (int j = 0; j < 4; ++j) {
      tl[(n4 + j) * 65 + lk] = ca[j];
      tl[(n4 + j) * 65 + lk + 32] = cb2[j];
    }
    __syncthreads();
    const int tnx = t + G;
    f32x4 na, nb;
    if (tnx < nt) issue(tnx, na, nb);
    {
      const int k0 = (t % tk) * 64, n0 = (t / tk) * 64;
      float v[8];
#pragma unroll
      for (int j = 0; j < 8; ++j) v[j] = tl[sn * 65 + k8 + j];
      *(uint4*)(dst + (size_t)(n0 + sn) * K + k0 + k8) = make_uint4(pk2(v[0], v[1]), pk2(v[2], v[3]), pk2(v[4], v[5]), pk2(v[6], v[7]));
    }
    __syncthreads();
    ca = na; cb2 = nb;
    t = tnx;
  }
  base += nt;
}
DI void convert_layer(const Params& p, int l, char* smem) {
  unsigned char* ws = p.ws;
  int base = 0;
  const float* w_in = p.in[3] + (size_t)l * 1024 * 5800;
  conv_mat(w_in, 5800, 1024, NIN, p.in[2] + l * 1024, 1, (bf16_t*)(ws + OFF_WIN), base, smem);
  conv_mat(w_in, 5800, 1024, 3072, p.in[2] + l * 1024, 2, (bf16_t*)(ws + OFF_WG), base, smem);
  conv_mat(p.in[8] + (size_t)l * 256 * 768, 768, 256, 768, p.in[7] + l * 256, 0, (bf16_t*)(ws + OFF_WQUP), base, smem);
  conv_mat(p.in[10] + (size_t)l * 128 * 1024, 1024, 128, 1024, p.in[9] + l * 128, 0, (bf16_t*)(ws + OFF_WKVUP), base, smem);
  for (int n = 0; n < 3; ++n)
    conv_mat(p.in[16] + ((size_t)l * 3 + n) * 512 * 1024, 1024, 512, 1024, nullptr, 0,
             (bf16_t*)(ws + OFF_WBR) + (size_t)n * 1024 * 512, base, smem);
  conv_mat(p.in[17] + (size_t)l * 1024 * 1024, 1024, 1024, 1024, nullptr, 0, (bf16_t*)(ws + OFF_WO), base, smem);
  conv_mat(p.in[19] + (size_t)l * 1024 * 5632, 5632, 1024, 5632, p.in[18] + l * 1024, 3, (bf16_t*)(ws + OFF_WUP), base, smem);
  conv_mat(p.in[22] + (size_t)l * 2816 * 1024, 1024, 2816, 1024, nullptr, 0, (bf16_t*)(ws + OFF_WDN), base, smem);
}

DI void phase_init(const Params& p) {
  unsigned char* ws = p.ws;
  const int tid = threadIdx.x, lane = tid & 63, wid = tid >> 6;
  const int gw = blockIdx.x * 8 + wid, nw = gridDim.x * 8;
  const int gt = blockIdx.x * NTHREADS + tid, ntot = gridDim.x * NTHREADS;
  float* ss = (float*)(ws + OFF_SS);
  bf16_t* hb = (bf16_t*)(ws + OFF_HB);
  for (int m = gw; m < T; m += nw) {
    int b = m / L, pos = m - b * L;
    const float* src = pos < 16 ? p.in[1] + pos * D : p.in[0] + ((size_t)(b * SEQ + pos - 16)) * D;
    float* dsth = hrow(p, b, pos);
    float s = 0.f;
#pragma unroll
    for (int i = 0; i < 4; ++i) {
      int c = (i * 64 + lane) * 4;
      f32x4 v = *(const f32x4*)(src + c);
      *(f32x4*)(dsth + c) = v;
      *(uint2*)(hb + (size_t)m * D + c) = pk4(v[0], v[1], v[2], v[3]);
      s += v[0] * v[0] + v[1] * v[1] + v[2] * v[2] + v[3] * v[3];
    }
#pragma unroll
    for (int o = 32; o >= 1; o >>= 1) s += __shfl_xor(s, o);
    if (lane == 0) ss[m] = s;
  }
  for (int i = gt; i < 7 * T; i += ntot) ss[T + i] = 0.f;
  if (gt < 64) ((unsigned*)(ws + OFF_CTR))[gt] = 0u;
  for (int i = gt; i < 3456; i += ntot) ((unsigned*)(ws + OFF_XBAR))[i] = 0u;
  float* rc = (float*)(ws + OFF_ROPE);
  float* rsn = rc + L * 16;
  for (int i = gt; i < L * 16; i += ntot) {
    int pos = i >> 4, c = i & 15;
    double ang = (double)pos * ROPE_FREQ[c];
    double k = rint(ang * 0.15915494309189535);
    double x = ang - k * 6.283185307179586476925;
    double x2 = x * x;
    double sn = 0.0, cs = 0.0;
    double ts = x, tc = 1.0;
#pragma unroll 1
    for (int n = 0; n < 15; ++n) {
      sn += ts;
      cs += tc;
      tc = -tc * x2 / (double)((2 * n + 1) * (2 * n + 2));
      ts = -ts * x2 / (double)((2 * n + 2) * (2 * n + 3));
    }
    rc[i] = (float)cs;
    rsn[i] = (float)sn;
  }
}


struct TileIter {
  int xcd, loc, nloc, per, nt, i;
  bool xmode;
  DI TileIter(int ntiles) {
    nt = ntiles;
    xmode = (gridDim.x & 7) == 0;
    if (xmode) { xcd = blockIdx.x & 7; loc = blockIdx.x >> 3; nloc = gridDim.x >> 3; per = (ntiles + 7) >> 3; i = loc; }
    else { xcd = 0; loc = blockIdx.x; nloc = gridDim.x; per = ntiles; i = loc; }
  }
  DI int next() {
    if (i >= per) return -1;
    const int t = xcd * per + i;
    i += nloc;
    return t < nt ? t : -1;
  }
};

DI void phase_inproj(const Params& p, int l, char* smem) {
  unsigned char* ws = p.ws;
  const bf16_t* hb = (const bf16_t*)(ws + OFF_HB);
  const bf16_t* W = (const bf16_t*)(ws + OFF_WIN);
  const float* ss1 = (const float*)(ws + OFF_SS) + (size_t)(l * 2) * T;
  float* ss_cq = (float*)(ws + OFF_SS) + (size_t)(4 + l) * T;
  float* ss_ckv = (float*)(ws + OFF_SS) + (size_t)(6 + l) * T;
  float* ss_kr = (float*)(ws + OFF_SSKR);
  const int lane = threadIdx.x & 63, wid = __builtin_amdgcn_readfirstlane(threadIdx.x >> 6), r = lane & 31, h = lane >> 5, wm = wid >> 2, wn = wid & 3;
  constexpr int NT = NIN / 256, MT = (T + 255) / 256;
  TileIter tit(NT * MT);
  for (int t = tit.next(); t >= 0; t = tit.next()) {
    const int nt = t % NT, mt = t / NT;
    const int m0 = mt * 256, n0 = nt * 256;
    f32x16 acc[4][2];
    zero_acc(acc);
    gemm_main<2, 4, 4, 2>(hb, [&](int row) { return min(m0 + row, T - 1) * D; }, 64, W, D, n0, D / 64, T - m0, acc, smem);
    const int n0w = n0 + wn * 64;
#pragma unroll
    for (int tm = 0; tm < 4; ++tm) {
      const int m = m0 + wm * 128 + tm * 32 + r;
      const bool valid = m < T;
      const int mm = valid ? m : T - 1;
      const int b = mm / L, pos = mm - b * L;
      const float rs = rsqrtf(ss1[mm] * (1.f / 1024.f) + EPS);
#pragma unroll
      for (int tn = 0; tn < 2; ++tn)
#pragma unroll
        for (int i = 0; i < 16; ++i) acc[tm][tn][i] *= rs;
      float ssq = 0.f;
#pragma unroll
      for (int tn = 0; tn < 2; ++tn)
#pragma unroll
        for (int i = 0; i < 16; ++i) ssq += acc[tm][tn][i] * acc[tm][tn][i];
      if (n0w < 2304) {
        int kind, head, nh;
        const float* gain = nullptr;
        float scale = 1.f;
        bf16_t* dst;
        if (n0w < 512) { kind = 0; head = n0w >> 6; nh = 8; gain = p.in[5] + l * 64; scale = 0.125f * LOG2E; dst = (bf16_t*)(ws + A_QF); }
        else if (n0w < 1024) { kind = 0; head = (n0w - 512) >> 6; nh = 8; gain = p.in[6] + l * 64; dst = (bf16_t*)(ws + A_KF); }
        else if (n0w < 1536) { kind = 1; head = (n0w - 1024) >> 6; nh = 8; dst = (bf16_t*)(ws + A_VF); }
        else if (n0w < 2048) { kind = 0; head = (n0w - 1536) >> 6; nh = 8; gain = p.in[13] + l * 64; scale = 0.125f * LOG2E; dst = (bf16_t*)(ws + A_QS); }
        else if (n0w < 2176) { kind = 0; head = (n0w - 2048) >> 6; nh = 2; gain = p.in[14] + l * 64; dst = (bf16_t*)(ws + A_KS); }
        else { kind = 1; head = (n0w - 2176) >> 6; nh = 2; dst = (bf16_t*)(ws + A_VS); }
        if (kind == 0) {
          const float tot = xor32(ssq);
          const float rr = rsqrtf(tot * (1.f / 64.f) + EPS) * scale;
          bf16_t* drow = dst + ((size_t)(b * nh + head) * LP + pos) * 64;
#pragma unroll
          for (int tn = 0; tn < 2; ++tn)
#pragma unroll
            for (int g4 = 0; g4 < 4; ++g4) {
              const int d = tn * 32 + 8 * g4 + 4 * h;
              const f32x4 gv = *(const f32x4*)(gain + d);
              uint2 o = pk4(acc[tm][tn][4 * g4] * rr * gv[0], acc[tm][tn][4 * g4 + 1] * rr * gv[1],
                            acc[tm][tn][4 * g4 + 2] * rr * gv[2], acc[tm][tn][4 * g4 + 3] * rr * gv[3]);
              if (valid) *(uint2*)(drow + d) = o;
            }
        } else {
          bf16_t* dcol = dst + ((size_t)(b * nh + head) * 64) * LP + pos;
          if (valid) {
#pragma unroll
            for (int tn = 0; tn < 2; ++tn)
#pragma unroll
              for (int i = 0; i < 16; ++i) {
                const int d = tn * 32 + (i & 3) + 8 * (i >> 2) + 4 * h;
                dcol[(size_t)d * LP] = f2bf(acc[tm][tn][i]);
              }
          }
        }
      } else if (n0w < 2688) {
        bf16_t* dst;
        float* ssd;
        int ld, c0;
        if (n0w < 2560) { dst = (bf16_t*)(ws + A_CQ); ssd = ss_cq; ld = 256; c0 = n0w - 2304; }
        else { dst = (bf16_t*)(ws + A_CKV); ssd = ss_ckv; ld = 128; c0 = n0w - 2560; }
        const float tot = xor32(ssq);
        if (valid) {
#pragma unroll
          for (int tn = 0; tn < 2; ++tn)
#pragma unroll
            for (int g4 = 0; g4 < 4; ++g4) {
              const int d = c0 + tn * 32 + 8 * g4 + 4 * h;
              *(uint2*)(dst + (size_t)m * ld + d) =
                  pk4(acc[tm][tn][4 * g4], acc[tm][tn][4 * g4 + 1], acc[tm][tn][4 * g4 + 2], acc[tm][tn][4 * g4 + 3]);
            }
          if (h == 0) atomicAdd(ssd + m, tot);
        }
      } else if (n0w == 2688) {
        float s0 = 0.f;
#pragma unroll
        for (int i = 0; i < 16; ++i) s0 += acc[tm][0][i] * acc[tm][0][i];
        s0 = xor32(s0);
        if (valid) {
          bf16_t* kr = (bf16_t*)(ws + OFF_KR) + (size_t)m * 32;
#pragma unroll
          for (int g4 = 0; g4 < 4; ++g4)
            *(uint2*)(kr + 8 * g4 + 4 * h) =
                pk4(acc[tm][0][4 * g4], acc[tm][0][4 * g4 + 1], acc[tm][0][4 * g4 + 2], acc[tm][0][4 * g4 + 3]);
          if (h == 0) ss_kr[m] = s0;
          float* lf = (float*)(ws + OFF_LF) + (size_t)m * 8 + 4 * h;
          f32x4 o;
#pragma unroll
          for (int j = 0; j < 4; ++j) {
            float x = acc[tm][1][j] + p.in[4][l * 8 + 4 * h + j];
            o[j] = fminf(x, 0.f) - log1pf(__expf(-fabsf(x)));
          }
          *(f32x4*)lf = o;
        }
      }
    }
  }
}

DI void phase_mla_up(const Params& p, int l, char* smem) {
  unsigned char* ws = p.ws;
  const int lane = threadIdx.x & 63, wid = __builtin_amdgcn_readfirstlane(threadIdx.x >> 6), r = lane & 31, h = lane >> 5;
  const float* rope_c = (const float*)(ws + OFF_ROPE);
  const float* rope_s = rope_c + L * 16;
  constexpr int MT = 64;
  {
    const bf16_t* A = (const bf16_t*)(ws + A_CQ);
    const bf16_t* W = (const bf16_t*)(ws + OFF_WQUP);
    const float* ssc = (const float*)(ws + OFF_SS) + (size_t)(4 + l) * T;
    const float* g = p.in[11] + l * 96;
    bf16_t* Qm = (bf16_t*)(ws + A_QM);
    const float qscale = 0.10206207261596575f * LOG2E;
    auto epi = [&](f32x16 (&acc)[1][3], int m, int head) {
      const int b = m / L, pos = m - b * L;
      const float rs = rsqrtf(ssc[m] * (1.f / 256.f) + EPS);
      float ssq = 0.f;
#pragma unroll
      for (int tn = 0; tn < 3; ++tn)
#pragma unroll
        for (int i = 0; i < 16; ++i) { acc[0][tn][i] *= rs; ssq += acc[0][tn][i] * acc[0][tn][i]; }
      ssq = xor32(ssq);
      const float rr = rsqrtf(ssq * (1.f / 96.f) + EPS);
      bf16_t* drow = Qm + ((size_t)(b * 8 + head) * LP + pos) * 96;
#pragma unroll
      for (int tn = 0; tn < 2; ++tn)
#pragma unroll
        for (int g4 = 0; g4 < 4; ++g4) {
          const int d = tn * 32 + 8 * g4 + 4 * h;
          const f32x4 gv = *(const f32x4*)(g + d);
          *(uint2*)(drow + d) = pk4(acc[0][tn][4 * g4] * rr * gv[0] * qscale, acc[0][tn][4 * g4 + 1] * rr * gv[1] * qscale,
                                    acc[0][tn][4 * g4 + 2] * rr * gv[2] * qscale, acc[0][tn][4 * g4 + 3] * rr * gv[3] * qscale);
        }
#pragma unroll
      for (int g4 = 0; g4 < 2; ++g4) {
        const int c = 8 * g4 + 4 * h;
        const f32x4 g1 = *(const f32x4*)(g + 64 + c);
        const f32x4 g2 = *(const f32x4*)(g + 80 + c);
        const f32x4 cs = *(const f32x4*)(rope_c + pos * 16 + c);
        const f32x4 sn = *(const f32x4*)(rope_s + pos * 16 + c);
        float o1[4], o2[4];
#pragma unroll
        for (int j = 0; j < 4; ++j) {
          float x1 = acc[0][2][4 * g4 + j] * rr * g1[j];
          float x2 = acc[0][2][4 * g4 + 8 + j] * rr * g2[j];
          o1[j] = (x1 * cs[j] - x2 * sn[j]) * qscale;
          o2[j] = (x2 * cs[j] + x1 * sn[j]) * qscale;
        }
        *(uint2*)(drow + 64 + c) = pk4(o1[0], o1[1], o1[2], o1[3]);
        *(uint2*)(drow + 80 + c) = pk4(o2[0], o2[1], o2[2], o2[3]);
      }
    };
    for (int t = blockIdx.x; t < 8 * MT; t += gridDim.x) {
      const int head = t % 8, mt = t / 8;
      const int m0 = mt * 256;
      f32x16 acc[1][3];
      zero_acc(acc);
      gemm_main<8, 1, 1, 3>(A, [&](int row) { return (m0 + row) * 256; }, 64, W, 256, head * 96, 4, 256, acc, smem);
      epi(acc, m0 + wid * 32 + r, head);
    }
    for (int nt = (int)blockIdx.x - 8; nt >= 0 && nt < 2; nt += gridDim.x) {
      const int wm = wid >> 2, wn = wid & 3;
      f32x16 acc[1][3];
      zero_acc(acc);
      gemm_main<2, 4, 1, 3>(A, [&](int row) { return min(16384 + row, T - 1) * 256; }, 64, W, 256, nt * 384, 4, 64, acc, smem);
      epi(acc, 16384 + wm * 32 + r, nt * 4 + wn);
    }
  }
  {
    const bf16_t* A = (const bf16_t*)(ws + A_CKV);
    const bf16_t* W = (const bf16_t*)(ws + OFF_WKVUP);
    const float* ssc = (const float*)(ws + OFF_SS) + (size_t)(6 + l) * T;
    const float* ss_kr = (const float*)(ws + OFF_SSKR);
    const bf16_t* krp = (const bf16_t*)(ws + OFF_KR);
    const float* g = p.in[12] + l * 96;
    bf16_t* Km = (bf16_t*)(ws + A_KM);
    bf16_t* Vm = (bf16_t*)(ws + A_VM);
    auto epi = [&](f32x16 (&a)[2], int m, int head, int part) {
      const int b = m / L, pos = m - b * L;
      const float rs = rsqrtf(ssc[m] * (1.f / 128.f) + EPS);
      float ssq = 0.f;
#pragma unroll
      for (int tn = 0; tn < 2; ++tn)
#pragma unroll
        for (int i = 0; i < 16; ++i) { a[tn][i] *= rs; ssq += a[tn][i] * a[tn][i]; }
      ssq = xor32(ssq);
      if (part == 0) {
        const float rr = rsqrtf((ssq + ss_kr[m]) * (1.f / 96.f) + EPS);
        bf16_t* drow = Km + ((size_t)(b * 8 + head) * LP + pos) * 96;
#pragma unroll
        for (int tn = 0; tn < 2; ++tn)
#pragma unroll
          for (int g4 = 0; g4 < 4; ++g4) {
            const int d = tn * 32 + 8 * g4 + 4 * h;
            const f32x4 gv = *(const f32x4*)(g + d);
            *(uint2*)(drow + d) = pk4(a[tn][4 * g4] * rr * gv[0], a[tn][4 * g4 + 1] * rr * gv[1], a[tn][4 * g4 + 2] * rr * gv[2],
                                      a[tn][4 * g4 + 3] * rr * gv[3]);
          }
        const int c0 = 8 * h;
        const bf16x8 k1 = *(const bf16x8*)(krp + (size_t)m * 32 + c0);
        const bf16x8 k2 = *(const bf16x8*)(krp + (size_t)m * 32 + 16 + c0);
        float o1[8], o2[8];
#pragma unroll
        for (int j = 0; j < 8; ++j) {
          float x1 = bf2f((bf16_t)k1[j]) * rr * g[64 + c0 + j];
          float x2 = bf2f((bf16_t)k2[j]) * rr * g[80 + c0 + j];
          float cs = rope_c[pos * 16 + c0 + j], sn = rope_s[pos * 16 + c0 + j];
          o1[j] = x1 * cs - x2 * sn;
          o2[j] = x2 * cs + x1 * sn;
        }
        *(uint4*)(drow + 64 + c0) = make_uint4(pk2(o1[0], o1[1]), pk2(o1[2], o1[3]), pk2(o1[4], o1[5]), pk2(o1[6], o1[7]));
        *(uint4*)(drow + 80 + c0) = make_uint4(pk2(o2[0], o2[1]), pk2(o2[2], o2[3]), pk2(o2[4], o2[5]), pk2(o2[6], o2[7]));
      } else {
        bf16_t* dcol = Vm + ((size_t)(b * 8 + head) * 64) * LP + pos;
#pragma unroll
        for (int tn = 0; tn < 2; ++tn)
#pragma unroll
          for (int i = 0; i < 16; ++i) {
            const int d = tn * 32 + (i & 3) + 8 * (i >> 2) + 4 * h;
            dcol[(size_t)d * LP] = f2bf(a[tn][i]);
          }
      }
    };
    {
      const int wm = wid >> 1, wn = wid & 1;
      for (int t = blockIdx.x; t < 8 * MT; t += gridDim.x) {
        const int head = t % 8, mt = t / 8;
        const int m0 = mt * 256;
        f32x16 acc[2][2];
        zero_acc(acc);
        gemm_main<4, 2, 2, 2>(A, [&](int row) { return (m0 + row) * 128; }, 64, W, 128, head * 128, 2, 256, acc, smem);
#pragma unroll
        for (int tm = 0; tm < 2; ++tm) epi(acc[tm], m0 + wm * 64 + tm * 32 + r, head, wn);
      }
    }
    for (int nt = (int)blockIdx.x - 16; nt >= 0 && nt < 4; nt += gridDim.x) {
      const int wm = wid >> 2, wn = wid & 3;
      f32x16 acc[1][2];
      zero_acc(acc);
      gemm_main<2, 4, 1, 2>(A, [&](int row) { return min(16384 + row, T - 1) * 128; }, 64, W, 128, nt * 256, 2, 64, acc, smem);
      epi(acc[0], 16384 + wm * 32 + r, nt * 2 + (wn >> 1), wn & 1);
    }
  }
  {
    const float* lf = (const float*)(ws + OFF_LF);
    float* cd = (float*)(ws + OFF_CDEC);
    float* wtot = (float*)smem;
    const int tid = threadIdx.x;
    for (int s = (int)blockIdx.x - 32; s >= 0 && s < 32; s += gridDim.x) {
      const int b = s >> 3, hd = s & 7;
      float v[9];
#pragma unroll
      for (int c = 0; c < 9; ++c) {
        const int pos = tid * 9 + c;
        v[c] = pos < L ? lf[((size_t)(b * L + pos)) * 8 + hd] : 0.f;
      }
#pragma unroll
      for (int c = 1; c < 9; ++c) v[c] += v[c - 1];
      float tot = v[8];
#pragma unroll
      for (int o = 1; o < 64; o <<= 1) {
        float u = __shfl_up(tot, o);
        if (lane >= o) tot += u;
      }
      __syncthreads();
      if (lane == 63) wtot[wid] = tot;
      __syncthreads();
      float base = tot - v[8];
      for (int w = 0; w < wid; ++w) base += wtot[w];
#pragma unroll
      for (int c = 0; c < 9; ++c) {
        const int pos = tid * 9 + c;
        if (pos < L) cd[(size_t)s * LP + pos] = v[c] + base;
      }
    }
  }
}

template <int DK, int MODE>
DI void attn_item(bf16_t* Qs, const bf16_t* __restrict__ Ks, const bf16_t* __restrict__ Vt, const float* __restrict__ cdec,
                  int q0, int q_end, float slope2, float sink2, char* smem) {
  constexpr int KROW = (DK + 8) * 2;
  constexpr int KSZ = 64 * KROW;
  constexpr int VSZ = 64 * 136;
  constexpr int STAGE = KSZ + VSZ + 256;
  constexpr int NKC = DK / 8;
  constexpr int NKT = 64 * NKC;
  constexpr int NKL = (NKT + 511) / 512;
  constexpr int NS = DK / 16;
  const int tid = threadIdx.x, lane = tid & 63, w = __builtin_amdgcn_readfirstlane(tid >> 6), r = lane & 31, h = lane >> 5;
  const int qi = q0 + w * 32 + r;
  const bool wave_on = q0 + w * 32 < q_end;
  bf16x8 qf[NS];
#pragma unroll
  for (int s = 0; s < NS; ++s) qf[s] = *(const bf16x8*)(Qs + (size_t)qi * DK + s * 16 + 8 * h);
  const int kt_hi = (q_end - 1) >> 6;
  int t_lo = 0, ntiles;
  if (MODE == 2) { t_lo = max(1, (q0 - 127) >> 6); ntiles = 1 + max(0, kt_hi - t_lo + 1); }
  else ntiles = kt_hi + 1;
  auto tile_of = [&](int j) { return MODE == 2 ? (j == 0 ? 0 : t_lo + j - 1) : j; };

  bf16x8 rk[NKL], rv;
  float rc = 0.f;
  auto gload = [&](int tile) {
    const int k0 = tile * 64;
#pragma unroll
    for (int i = 0; i < NKL; ++i) {
      const int c = tid + i * 512, row = c / NKC, cc = c % NKC;
      if (NKT % 512 == 0 || c < NKT) rk[i] = *(const bf16x8*)(Ks + (size_t)(k0 + row) * DK + cc * 8);
    }
    {
      const int row = tid >> 3, cc = tid & 7;
      rv = *(const bf16x8*)(Vt + (size_t)row * LP + k0 + cc * 8);
    }
    if (MODE == 0 && tid < 64) rc = cdec[k0 + tid] * LOG2E;
  };
  auto sstore = [&](int s) {
    char* kb = smem + s * STAGE;
    char* vb = kb + KSZ;
#pragma unroll
    for (int i = 0; i < NKL; ++i) {
      const int c = tid + i * 512, row = c / NKC, cc = c % NKC;
      if (NKT % 512 == 0 || c < NKT) *(bf16x8*)(kb + row * KROW + cc * 16) = rk[i];
    }
    {
      const int row = tid >> 3, cc = tid & 7;
      s16x4 lo = {rv[0], rv[1], rv[2], rv[3]}, hi = {rv[4], rv[5], rv[6], rv[7]};
      *(s16x4*)(vb + row * 136 + cc * 16) = lo;
      *(s16x4*)(vb + row * 136 + cc * 16 + 8) = hi;
    }
    if (MODE == 0 && tid < 64) *(float*)(vb + VSZ + tid * 4) = rc;
  };

  f32x16 o[2];
#pragma unroll
  for (int i = 0; i < 16; ++i) { o[0][i] = 0.f; o[1][i] = 0.f; }
  float m_run = -1e30f, l_run = 0.f;

  gload(tile_of(0));
  sstore(0);
#pragma unroll
  for (int s = 0; s < NS; ++s) asm volatile("" ::"v"(qf[s]));
  __syncthreads();
  for (int j = 0; j < ntiles; ++j) {
    if (j + 1 < ntiles) gload(tile_of(j + 1));
    __builtin_amdgcn_sched_barrier(0);
    const int k0 = tile_of(j) * 64;
    const char* kb = smem + (j & 1) * STAGE;
    const char* vb = kb + KSZ;
    bool active = wave_on && (k0 <= q0 + w * 32 + 31);
    if (MODE == 2) active = active && (k0 == 0 || k0 + 63 >= q0 + w * 32 - 127);
    if (active) {
      f32x16 s[2];
#pragma unroll
      for (int kt = 0; kt < 2; ++kt) {
#pragma unroll
        for (int i = 0; i < 16; ++i) s[kt][i] = 0.f;
#pragma unroll
        for (int ks = 0; ks < NS; ++ks) {
          bf16x8 kf = *(const bf16x8*)(kb + (kt * 32 + r) * KROW + ks * 32 + h * 16);
          s[kt] = mfma32(kf, qf[ks], s[kt]);
        }
      }
      const bool need_mask = (MODE == 2) || (k0 + 63 > q0 + w * 32);
      float mx = -1e30f;
      if (MODE == 0 || MODE == 2) {
#pragma unroll
        for (int kt = 0; kt < 2; ++kt)
#pragma unroll
          for (int g4 = 0; g4 < 4; ++g4) {
            const int kj0 = k0 + kt * 32 + 8 * g4 + 4 * h;
            f32x4 ck;
            if (MODE == 0) ck = *(const f32x4*)(vb + VSZ + (kt * 32 + 8 * g4 + 4 * h) * 4);
#pragma unroll
            for (int jj = 0; jj < 4; ++jj) {
              if (MODE == 0) s[kt][4 * g4 + jj] -= ck[jj];
              if (MODE == 2) s[kt][4 * g4 + jj] -= slope2 * (float)(qi - kj0 - jj);
            }
          }
      }
      if (__builtin_amdgcn_readfirstlane((int)need_mask)) {
#pragma unroll
        for (int kt = 0; kt < 2; ++kt)
#pragma unroll
          for (int i = 0; i < 16; ++i) {
            const int kj = k0 + kt * 32 + (i & 3) + 8 * (i >> 2) + 4 * h;
            bool ok = kj <= qi;
            if (MODE == 2) ok = ok && (kj < 16 || qi - kj < 128);
            s[kt][i] = ok ? s[kt][i] : -1e30f;
          }
        asm volatile("" ::: "memory");
      }
#pragma unroll
      for (int kt = 0; kt < 2; ++kt)
#pragma unroll
        for (int i = 0; i < 16; ++i) mx = fmaxf(mx, s[kt][i]);
      mx = max32(mx);
      const float m_new = fmaxf(m_run, mx);
      const float alpha = fexp2(m_run - m_new);
      m_run = m_new;
      float psum = 0.f;
#pragma unroll
      for (int kt = 0; kt < 2; ++kt)
#pragma unroll
        for (int i = 0; i < 16; ++i) {
          float pv = fexp2(s[kt][i] - m_new);
          s[kt][i] = pv;
          psum += pv;
        }
      l_run = l_run * alpha + psum;
#pragma unroll
      for (int i = 0; i < 16; ++i) { o[0][i] *= alpha; o[1][i] *= alpha; }
#pragma unroll
      for (int kt = 0; kt < 2; ++kt)
#pragma unroll
        for (int st = 0; st < 2; ++st) {
          unsigned pw[4];
#pragma unroll
          for (int u = 0; u < 4; ++u) pw[u] = pk2(s[kt][8 * st + 2 * u], s[kt][8 * st + 2 * u + 1]);
          uint4 pu = make_uint4(pw[0], pw[1], pw[2], pw[3]);
          const bf16x8 pf = __builtin_bit_cast(bf16x8, pu);
#pragma unroll
          for (int dt = 0; dt < 2; ++dt) {
            const char* va = vb + (dt * 32 + r) * 136 + (kt * 32 + 16 * st + 4 * h) * 2;
            const s16x4 lo = *(const s16x4*)va;
            const s16x4 hi = *(const s16x4*)(va + 16);
            const bf16x8 vf = {lo[0], lo[1], lo[2], lo[3], hi[0], hi[1], hi[2], hi[3]};
            o[dt] = mfma32(vf, pf, o[dt]);
          }
        }
    }
    __builtin_amdgcn_sched_barrier(0);
    if (j + 1 < ntiles) sstore((j + 1) & 1);
    __syncthreads();
  }
  float lt = xor32(l_run);
  if (MODE == 2) lt += fexp2(sink2 - m_run);
  const float inv = 1.f / lt;
  if (qi < q_end) {
    bf16_t* orow = Qs + (size_t)qi * DK;
#pragma unroll
    for (int dt = 0; dt < 2; ++dt)
#pragma unroll
      for (int g4 = 0; g4 < 4; ++g4) {
        const int d = dt * 32 + 8 * g4 + 4 * h;
        *(uint2*)(orow + d) = pk4(o[dt][4 * g4] * inv, o[dt][4 * g4 + 1] * inv, o[dt][4 * g4 + 2] * inv, o[dt][4 * g4 + 3] * inv);
      }
  }
}

DI int next_item(unsigned* ctr, int* sidx) {
  if (threadIdx.x == 0) *sidx = (int)atomicAdd(ctr, 1u);
  __syncthreads();
  const int idx = *sidx;
  __syncthreads();
  return idx;
}
DI void phase_attn(const Params& p, int l, char* smem) {
  unsigned char* ws = p.ws;
  unsigned* ctr = (unsigned*)(ws + OFF_CTR) + l * 4;
  int* sidx = (int*)(smem + 147456);
  constexpr int NQT = 17, NIT = 32 * NQT;
#pragma unroll 1
  while (true) {
    const int idx = next_item(ctr, sidx);
    if (idx >= NIT) break;
    const int qt = NQT - 1 - (idx >> 5), bh = idx & 31;
    const int q0 = qt == 0 ? 0 : 16 + 256 * (qt - 1), q_end = qt == 0 ? 16 : q0 + 256;
    attn_item<64, 0>((bf16_t*)(ws + A_QF) + (size_t)bh * LP * 64, (const bf16_t*)(ws + A_KF) + (size_t)bh * LP * 64,
                     (const bf16_t*)(ws + A_VF) + (size_t)bh * 64 * LP, (const float*)(ws + OFF_CDEC) + (size_t)bh * LP, q0, q_end,
                     0.f, 0.f, smem);
  }
#pragma unroll 1
  while (true) {
    const int idx = next_item(ctr + 1, sidx);
    if (idx >= NIT) break;
    const int qt = NQT - 1 - (idx >> 5), bh = idx & 31;
    const int q0 = qt == 0 ? 0 : 16 + 256 * (qt - 1), q_end = qt == 0 ? 16 : q0 + 256;
    attn_item<96, 1>((bf16_t*)(ws + A_QM) + (size_t)bh * LP * 96, (const bf16_t*)(ws + A_KM) + (size_t)bh * LP * 96,
                     (const bf16_t*)(ws + A_VM) + (size_t)bh * 64 * LP, nullptr, q0, q_end, 0.f, 0.f, smem);
  }
#pragma unroll 1
  while (true) {
    const int idx = next_item(ctr + 2, sidx);
    if (idx >= NIT) break;
    const int qt = idx >> 5, bh = idx & 31, b = bh >> 3, hq = bh & 7, hk = hq >> 2;
    const int q0 = qt == 0 ? 0 : 16 + 256 * (qt - 1), q_end = qt == 0 ? 16 : q0 + 256;
    const float slope2 = fexp2(-(float)(hq + 1)) * LOG2E;
    const float sink2 = p.in[15][l * 8 + hq] * LOG2E;
    attn_item<64, 2>((bf16_t*)(ws + A_QS) + (size_t)bh * LP * 64, (const bf16_t*)(ws + A_KS) + (size_t)(b * 2 + hk) * LP * 64,
                     (const bf16_t*)(ws + A_VS) + (size_t)(b * 2 + hk) * 64 * LP, nullptr, q0, q_end, slope2, sink2, smem);
  }
}

DI void phase_merge(const Params& p, int l, char* smem) {
  unsigned char* ws = p.ws;
  const bf16_t* hb = (const bf16_t*)(ws + OFF_HB);
  const bf16_t* Wg = (const bf16_t*)(ws + OFF_WG);
  const bf16_t* Wb = (const bf16_t*)(ws + OFF_WBR);
  const float* ss1 = (const float*)(ws + OFF_SS) + (size_t)(l * 2) * T;
  bf16_t* merged = (bf16_t*)(ws + A_MERGED);
  const int lane = threadIdx.x & 63, wid = __builtin_amdgcn_readfirstlane(threadIdx.x >> 6), r = lane & 31, h = lane >> 5, wm = wid >> 1, wn = wid & 1;
  constexpr int NT = 8, MT = 64;
  TileIter tit(NT * MT);
  for (int t = tit.next(); t >= 0; t = tit.next()) {
    const int nt = t % NT, mt = t / NT;
    const int m0 = mt * 256, n0 = nt * 128;
    float rs[2];
#pragma unroll
    for (int tm = 0; tm < 2; ++tm) rs[tm] = rsqrtf(ss1[min(m0 + wm * 64 + tm * 32 + r, T - 1)] * (1.f / 1024.f) + EPS);
#pragma unroll 1
    for (int n = 0; n < 3; ++n) {
      f32x16 acc[2][2];
      zero_acc(acc);
      gemm_main<4, 2, 2, 2, false>(hb, [&](int row) { return min(m0 + row, T - 1) * D; }, 64, Wg + (size_t)n * 1024 * 1024, D, n0, D / 64,
                            T - m0, acc, smem);
      unsigned gp[2][2][8];
#pragma unroll
      for (int tm = 0; tm < 2; ++tm)
#pragma unroll
      for (int tn = 0; tn < 2; ++tn)
#pragma unroll
        for (int u = 0; u < 8; ++u) {
          float a = __builtin_amdgcn_rcpf(1.f + __expf(-acc[tm][tn][2 * u] * rs[tm]));
          float bq = __builtin_amdgcn_rcpf(1.f + __expf(-acc[tm][tn][2 * u + 1] * rs[tm]));
          gp[tm][tn][u] = pk2(a, bq);
        }
      zero_acc(acc);
      const bf16_t* Ab;
      int rstride, kstride;
      if (n == 0) { Ab = (const bf16_t*)(ws + A_QF); rstride = 64; kstride = LP * 64; }
      else if (n == 1) { Ab = (const bf16_t*)(ws + A_QM); rstride = 96; kstride = LP * 96; }
      else { Ab = (const bf16_t*)(ws + A_QS); rstride = 64; kstride = LP * 64; }
      gemm_main<4, 2, 2, 2, false>(Ab, [&](int row) {
        int mr = min(m0 + row, T - 1);
        int b = mr / L, pos = mr - b * L;
        return (b * 8 * LP + pos) * rstride; }, kstride, Wb + (size_t)n * 1024 * 512, 512, n0, 8, T - m0, acc, smem);
#pragma unroll
      for (int tm = 0; tm < 2; ++tm) {
        const int m = m0 + wm * 64 + tm * 32 + r;
        if (m < T) {
#pragma unroll
          for (int tn = 0; tn < 2; ++tn)
#pragma unroll
            for (int g4 = 0; g4 < 4; ++g4) {
              const int col = n0 + wn * 64 + tn * 32 + 8 * g4 + 4 * h;
              uint2* dst = (uint2*)(merged + (size_t)m * D + col);
              uint2 old = make_uint2(0u, 0u);
              if (n > 0) old = *dst;
              const unsigned g0 = gp[tm][tn][2 * g4], g1 = gp[tm][tn][2 * g4 + 1];
              float f0 = __uint_as_float(g0 << 16) * acc[tm][tn][4 * g4] + __uint_as_float(old.x << 16);
              float f1 = __uint_as_float(g0 & 0xffff0000u) * acc[tm][tn][4 * g4 + 1] + __uint_as_float(old.x & 0xffff0000u);
              float f2 = __uint_as_float(g1 << 16) * acc[tm][tn][4 * g4 + 2] + __uint_as_float(old.y << 16);
              float f3 = __uint_as_float(g1 & 0xffff0000u) * acc[tm][tn][4 * g4 + 3] + __uint_as_float(old.y & 0xffff0000u);
              *dst = pk4(f0, f1, f2, f3);
            }
        }
      }
    }
  }
  {
    const int wm1 = wid >> 2, wn1 = wid & 3;
    for (int nt = blockIdx.x; nt < 8; nt += gridDim.x) {
      const int m0 = 16384, n0 = nt * 128;
      const int m = m0 + wm1 * 32 + r;
      const float rs1 = rsqrtf(ss1[m] * (1.f / 1024.f) + EPS);
#pragma unroll 1
      for (int n = 0; n < 3; ++n) {
        f32x16 acc[1][1];
        zero_acc(acc);
        gemm_rem(hb, [&](int row) { return min(m0 + row, T - 1) * D; }, 64, Wg + (size_t)n * 1024 * 1024, D, n0, D / 64, acc[0][0], smem);
        unsigned gp[8];
#pragma unroll
        for (int u = 0; u < 8; ++u)
          gp[u] = pk2(__builtin_amdgcn_rcpf(1.f + __expf(-acc[0][0][2 * u] * rs1)), __builtin_amdgcn_rcpf(1.f + __expf(-acc[0][0][2 * u + 1] * rs1)));
        zero_acc(acc);
        const bf16_t* Ab;
        int rstride, kstride;
        if (n == 0) { Ab = (const bf16_t*)(ws + A_QF); rstride = 64; kstride = LP * 64; }
        else if (n == 1) { Ab = (const bf16_t*)(ws + A_QM); rstride = 96; kstride = LP * 96; }
        else { Ab = (const bf16_t*)(ws + A_QS); rstride = 64; kstride = LP * 64; }
        gemm_rem(Ab, [&](int row) {
          int mr = min(m0 + row, T - 1);
          int b = mr / L, pos = mr - b * L;
          return (b * 8 * LP + pos) * rstride; }, kstride, Wb + (size_t)n * 1024 * 512, 512, n0, 8, acc[0][0], smem);
#pragma unroll
        for (int g4 = 0; g4 < 4; ++g4) {
          const int col = n0 + wn1 * 32 + 8 * g4 + 4 * h;
          uint2* dst = (uint2*)(merged + (size_t)m * D + col);
          uint2 old = make_uint2(0u, 0u);
          if (n > 0) old = *dst;
          const unsigned g0 = gp[2 * g4], g1 = gp[2 * g4 + 1];
          float f0 = __uint_as_float(g0 << 16) * acc[0][0][4 * g4] + __uint_as_float(old.x << 16);
          float f1 = __uint_as_float(g0 & 0xffff0000u) * acc[0][0][4 * g4 + 1] + __uint_as_float(old.x & 0xffff0000u);
          float f2 = __uint_as_float(g1 << 16) * acc[0][0][4 * g4 + 2] + __uint_as_float(old.y << 16);
          float f3 = __uint_as_float(g1 & 0xffff0000u) * acc[0][0][4 * g4 + 3] + __uint_as_float(old.y & 0xffff0000u);
          *dst = pk4(f0, f1, f2, f3);
        }
      }
    }
  }
}


DI void stage_half(const f32x16 (&acc)[4][2], int hp, int wm, int wn, int r, int h, const float (&rowscale)[4], float* stg) {
  if ((wn >> 1) == hp) {
#pragma unroll
    for (int tm = 0; tm < 4; ++tm) {
      float* srow = stg + (wm * 128 + tm * 32 + r) * 132 + (wn & 1) * 64 + 4 * h;
#pragma unroll
      for (int tn = 0; tn < 2; ++tn)
#pragma unroll
        for (int g4 = 0; g4 < 4; ++g4) {
          f32x4 v = {acc[tm][tn][4 * g4] * rowscale[tm], acc[tm][tn][4 * g4 + 1] * rowscale[tm],
                     acc[tm][tn][4 * g4 + 2] * rowscale[tm], acc[tm][tn][4 * g4 + 3] * rowscale[tm]};
          *(f32x4*)(srow + tn * 32 + 8 * g4) = v;
        }
    }
  }
}

DI void phase_resid(const Params& p, const bf16_t* A, int K, const bf16_t* W, float* ss_next, bool last, char* smem) {
  unsigned char* ws = p.ws;
  bf16_t* hb = (bf16_t*)(ws + OFF_HB);
  const int tid = threadIdx.x, lane = tid & 63, wid = __builtin_amdgcn_readfirstlane(tid >> 6), r = lane & 31, h = lane >> 5, wm = wid >> 2, wn = wid & 3;
  constexpr int NT = 4, MT = 64;
  float* stg = (float*)smem;
  TileIter tit(NT * MT);
  for (int t = tit.next(); t >= 0; t = tit.next()) {
    const int nt = t % NT, mt = t / NT;
    const int m0 = mt * 256, n0 = nt * 256;
    f32x16 acc[4][2];
    zero_acc(acc);
    gemm_main<2, 4, 4, 2>(A, [&](int row) { return min(m0 + row, T - 1) * K; }, 64, W, K, n0, K / 64, T - m0, acc, smem);
    const float ones[4] = {1.f, 1.f, 1.f, 1.f};
#pragma unroll 1
    for (int hp = 0; hp < 2; ++hp) {
      const int chunk = tid & 15;
      const int col = n0 + hp * 128 + chunk * 8;
      f32x4 h0[2], h1[2];
      auto hptr = [&](int it) {
        const int m = m0 + (tid >> 4) + 32 * it;
        const int b = m / L, pos = m - b * L;
        return hrow(p, b, pos) + col;
      };
      auto issue = [&](int bt) {
#pragma unroll
        for (int q = 0; q < 2; ++q) {
          const float* hp_ = hptr(bt * 2 + q);
          h0[q] = *(const f32x4*)hp_;
          h1[q] = *(const f32x4*)(hp_ + 4);
        }
      };
      auto process = [&](int bt) {
#pragma unroll
        for (int q = 0; q < 2; ++q) {
          const int row = (tid >> 4) + 32 * (bt * 2 + q);
          const int m = m0 + row;
          float* hp_ = hptr(bt * 2 + q);
          const f32x4 a0 = *(const f32x4*)(stg + row * 132 + chunk * 8);
          const f32x4 a1 = *(const f32x4*)(stg + row * 132 + chunk * 8 + 4);
          f32x4 v0, v1;
          float ssq = 0.f;
#pragma unroll
          for (int j = 0; j < 4; ++j) {
            v0[j] = a0[j] + h0[q][j];
            v1[j] = a1[j] + h1[q][j];
            ssq += v0[j] * v0[j] + v1[j] * v1[j];
          }
          *(f32x4*)hp_ = v0;
          *(f32x4*)(hp_ + 4) = v1;
          if (!last) {
            *(uint4*)(hb + (size_t)m * D + col) = make_uint4(pk2(v0[0], v0[1]), pk2(v0[2], v0[3]), pk2(v1[0], v1[1]), pk2(v1[2], v1[3]));
            ssq += __shfl_xor(ssq, 8);
            ssq += __shfl_xor(ssq, 4);
            ssq += __shfl_xor(ssq, 2);
            ssq += __shfl_xor(ssq, 1);
            if (chunk == 0) atomicAdd(ss_next + m, ssq);
          }
        }
      };
      issue(0);
      stage_half(acc, hp, wm, wn, r, h, ones, stg);
      __syncthreads();
      process(0);
#pragma unroll
      for (int bt = 1; bt < 4; ++bt) {
        __builtin_amdgcn_sched_barrier(0);
        issue(bt);
        process(bt);
      }
      __syncthreads();
    }
  }
  for (int nt = blockIdx.x; nt < 8; nt += gridDim.x) {
    const int m0 = 16384, n0 = nt * 128;
    f32x16 acc[1][1];
    zero_acc(acc);
    gemm_rem(A, [&](int row) { return min(m0 + row, T - 1) * K; }, 64, W, K, n0, K / 64, acc[0][0], smem);
    const int m = m0 + wm * 32 + r;
    const int b = m / L, pos = m - b * L;
    float* hr = hrow(p, b, pos);
    float ssq = 0.f;
    f32x4 hv[4];
#pragma unroll
    for (int g4 = 0; g4 < 4; ++g4) hv[g4] = *(const f32x4*)(hr + n0 + wn * 32 + 8 * g4 + 4 * h);
#pragma unroll
    for (int g4 = 0; g4 < 4; ++g4) {
      const int col = n0 + wn * 32 + 8 * g4 + 4 * h;
      f32x4 v;
#pragma unroll
      for (int j = 0; j < 4; ++j) { v[j] = hv[g4][j] + acc[0][0][4 * g4 + j]; ssq += v[j] * v[j]; }
      *(f32x4*)(hr + col) = v;
      if (!last) *(uint2*)(hb + (size_t)m * D + col) = pk4(v[0], v[1], v[2], v[3]);
    }
    ssq = xor32(ssq);
    if (!last && h == 0) atomicAdd(ss_next + m, ssq);
  }
}

DI void phase_up(const Params& p, int l, char* smem) {
  unsigned char* ws = p.ws;
  const bf16_t* hb = (const bf16_t*)(ws + OFF_HB);
  const bf16_t* W = (const bf16_t*)(ws + OFF_WUP);
  const float* ss2 = (const float*)(ws + OFF_SS) + (size_t)(l * 2 + 1) * T;
  const float* cw = p.in[20] + (size_t)l * 3 * 5632;
  const float* cb = p.in[21] + (size_t)l * 5632;
  bf16_t* act = (bf16_t*)(ws + A_ACT);
  const int tid = threadIdx.x, lane = tid & 63, wid = __builtin_amdgcn_readfirstlane(tid >> 6), r = lane & 31, h = lane >> 5, wm = wid >> 2, wn = wid & 3;
  constexpr int NT = 5632 / 256, MT = (T + 253) / 254;
  float* stg = (float*)smem;
  TileIter tit(NT * MT);
  for (int t = tit.next(); t >= 0; t = tit.next()) {
    const int nt = t % NT, mt = t / NT;
    const int mbase = mt * 254 - 2, n0 = nt * 256;
    f32x16 acc[4][2];
    zero_acc(acc);
    float rsv[4];
#pragma unroll
    for (int tm = 0; tm < 4; ++tm) rsv[tm] = ss2[min(max(mbase + wm * 128 + tm * 32 + r, 0), T - 1)];
    gemm_main<2, 4, 4, 2>(hb, [&](int row) { return min(max(mbase + row, 0), T - 1) * D; }, 64, W, D, n0, D / 64, T - mbase, acc,
                          smem);
#pragma unroll
    for (int tm = 0; tm < 4; ++tm) rsv[tm] = rsqrtf(rsv[tm] * (1.f / 1024.f) + EPS);
#pragma unroll 1
    for (int hp = 0; hp < 2; ++hp) {
      const int chunk = tid & 15, grp = chunk >> 3, jl0 = (chunk & 7) * 4;
      const int jg0 = (n0 / 64 + hp * 2 + grp) * 32 + jl0;
      f32x4 wg[3], wv[3];
#pragma unroll
      for (int i = 0; i < 3; ++i) {
        wg[i] = *(const f32x4*)(cw + i * 5632 + jg0);
        wv[i] = *(const f32x4*)(cw + i * 5632 + DFF + jg0);
      }
      const f32x4 bg = *(const f32x4*)(cb + jg0), bv = *(const f32x4*)(cb + DFF + jg0);
      stage_half(acc, hp, wm, wn, r, h, rsv, stg);
      __syncthreads();
      {
        const float* sgc = stg + grp * 64 + jl0;
#pragma unroll 2
        for (int it = 0; it < 8; ++it) {
          const int row = 2 + (tid >> 4) + 32 * it;
          const int gm = mbase + row;
          if (row < 256 && gm < T) {
            const int b = gm / L, pos = gm - b * L;
            const float* s0 = sgc + row * 132;
            const f32x4 g0 = *(const f32x4*)(s0), v0 = *(const f32x4*)(s0 + 32);
            const f32x4 g1 = *(const f32x4*)(s0 - 132), v1 = *(const f32x4*)(s0 - 132 + 32);
            const f32x4 g2 = *(const f32x4*)(s0 - 264), v2 = *(const f32x4*)(s0 - 264 + 32);
            float o[4];
#pragma unroll
            for (int j = 0; j < 4; ++j) {
              float a = bg[j] + wg[2][j] * g0[j], c = bv[j] + wv[2][j] * v0[j];
              if (pos >= 1) { a += wg[1][j] * g1[j]; c += wv[1][j] * v1[j]; }
              if (pos >= 2) { a += wg[0][j] * g2[j]; c += wv[0][j] * v2[j]; }
              o[j] = a * __builtin_amdgcn_rcpf(1.f + __expf(-a)) * c;
            }
            *(uint2*)(act + (size_t)gm * DFF + jg0) = pk4(o[0], o[1], o[2], o[3]);
          }
        }
      }
      __syncthreads();
    }
  }
}

#define XB_TMO      128
#define XB_XCNT(j)  (256  + 64 * (j))
#define XB_XSUB(j)  (1280 + 64 * (j))
#define XB_XGEN(j)  (2304 + 64 * (j))
#define XB_TOP      3328
#define XB_TOPGEN   3392
#define XB_SPIN_CAP (1u << 22)
DI unsigned xb_ld(unsigned* p) { return __hip_atomic_load(p, __ATOMIC_RELAXED, __HIP_MEMORY_SCOPE_AGENT); }
DI unsigned xb_add(unsigned* p, unsigned v) { return __hip_atomic_fetch_add(p, v, __ATOMIC_RELAXED, __HIP_MEMORY_SCOPE_AGENT); }
DI unsigned xb_xcc_id() { return (unsigned)__builtin_amdgcn_s_getreg((3 << 11) | 20) & 0xFu; }
#define XB_SPIN(cond, bar) do { unsigned _sp = 0; while (cond) { __builtin_amdgcn_s_sleep(1); \
    if ((++_sp & 255u) == 0u) { if (xb_ld(&(bar)[XB_TMO])) break; if (_sp > XB_SPIN_CAP) { atomicAdd(&(bar)[XB_TMO], 1u); break; } } } } while (0)
DI void xcd_barrier_complete(unsigned* bar, unsigned x, unsigned& nloc, unsigned& nx) {
  const unsigned G = gridDim.x;
  unsigned sum, cnt, mine, sp = 0u;
  for (;;) {
    sum = 0u; cnt = 0u; mine = 0u;
#pragma unroll
    for (unsigned j = 0; j < 16; ++j) { const unsigned c = xb_ld(&bar[XB_XCNT(j)]); sum += c; cnt += (c > 0u) ? 1u : 0u; mine = (j == x) ? c : mine; }
    if (sum == G) break;
    __builtin_amdgcn_s_sleep(1);
    if ((++sp & 255u) == 0u) { if (xb_ld(&bar[XB_TMO])) break; if (sp > XB_SPIN_CAP) { atomicAdd(&bar[XB_TMO], 1u); break; } }
  }
  nloc = mine > 0u ? mine : 1u; nx = cnt > 0u ? cnt : 1u;
}
DI void xcd_barrier(unsigned* bar, unsigned x, volatile unsigned* st) {
  asm volatile("s_waitcnt vmcnt(0)" ::: "memory");
  __syncthreads();
  if (threadIdx.x == 0) {
    __builtin_amdgcn_s_waitcnt(0);
    unsigned nloc = st[0], nx = st[1];
    if (nloc == 0u) { xcd_barrier_complete(bar, x, nloc, nx); st[0] = nloc; st[1] = nx; }
    const unsigned old = xb_add(&bar[XB_XSUB(x)], 1u);
    const unsigned gen = old / nloc;
    if (old + 1u == (gen + 1u) * nloc) {
      __builtin_amdgcn_fence(__ATOMIC_RELEASE, "agent");
      asm volatile("s_waitcnt vmcnt(0)" ::: "memory");
      const unsigned og = xb_add(&bar[XB_TOP], 1u);
      const unsigned tg = og / nx;
      if (og + 1u == (tg + 1u) * nx) xb_add(&bar[XB_TOPGEN], 1u);
      else XB_SPIN(xb_ld(&bar[XB_TOPGEN]) == tg, bar);
      __builtin_amdgcn_fence(__ATOMIC_ACQUIRE, "agent");
      xb_add(&bar[XB_XGEN(x)], 1u);
      asm volatile("s_waitcnt vmcnt(0)" ::: "memory");
    } else {
      XB_SPIN(xb_ld(&bar[XB_XGEN(x)]) == gen, bar);
      __builtin_amdgcn_fence(__ATOMIC_ACQUIRE, "agent");
      asm volatile("s_waitcnt vmcnt(0)" ::: "memory");
    }
  }
  __syncthreads();
}

constexpr int NPHASES = 16;
__global__ void __launch_bounds__(NTHREADS, 2) mega_kernel(Params p) {
  __shared__ __attribute__((aligned(16))) char smem[SMEM_BYTES];
  cg::grid_group grid = cg::this_grid();
  unsigned char* ws = p.ws;
  int ph = 0;
  __shared__ __attribute__((aligned(16))) unsigned xb_st[4];
  unsigned* xbar = (unsigned*)(ws + OFF_XBAR);
  const unsigned xb_x = xb_xcc_id();
  if (threadIdx.x < 4) xb_st[threadIdx.x] = 0u;
#define RUN(body)                                   \
  {                                                 \
    if (ph >= p.ph_lo && ph < p.ph_hi) {            \
      body;                                         \
      if (ph + 1 < p.ph_hi) {                       \
        if (ph == 0) {                              \
          grid.sync();                              \
          if (threadIdx.x == 0) (void)xb_add(&xbar[XB_XCNT(xb_x)], 1u); \
        } else xcd_barrier(xbar, xb_x, xb_st);      \
      }                                             \
    }                                               \
    ++ph;                                           \
  }
  RUN(convert_layer(p, 0, smem); phase_init(p));
#define LAYER(l)                                                                                          \
  RUN(phase_inproj(p, l, smem));                                                                          \
  RUN(phase_mla_up(p, l, smem));                                                                          \
  RUN(phase_attn(p, l, smem));                                                                            \
  RUN(phase_merge(p, l, smem));                                                                           \
  RUN(phase_resid(p, (const bf16_t*)(ws + A_MERGED), 1024, (const bf16_t*)(ws + OFF_WO),                  \
                  (float*)(ws + OFF_SS) + (size_t)(l * 2 + 1) * T, false, smem));                         \
  RUN(phase_up(p, l, smem));                                                                              \
  RUN(phase_resid(p, (const bf16_t*)(ws + A_ACT), DFF, (const bf16_t*)(ws + OFF_WDN),                     \
                  (float*)(ws + OFF_SS) + (size_t)((l + 1) * 2) * T, l == 1, smem));
  LAYER(0)
  RUN(convert_layer(p, 1, smem));
  LAYER(1)
#undef LAYER
#undef RUN
}

extern "C" void kernel_launch(void* const* d_in, const int* in_sizes, int n_in, void* d_out, int out_size, void* d_ws,
                              size_t ws_size, hipStream_t stream) {
  static int grid_blocks = 0;
  if (!grid_blocks) {
    int dev = 0, cus = 0, per_cu = 0;
    hipGetDevice(&dev);
    hipDeviceGetAttribute(&cus, hipDeviceAttributeMultiprocessorCount, dev);
    hipOccupancyMaxActiveBlocksPerMultiprocessor(&per_cu, mega_kernel, NTHREADS, 0);
    if (per_cu < 1) per_cu = 1;
    if (per_cu > 1) per_cu = 1;
    grid_blocks = cus * per_cu;
    if (ws_size < A_END) fprintf(stderr, "workspace too small: %zu < %zu\n", ws_size, (size_t)A_END);
  }
  Params p{};
  for (int i = 0; i < 23; ++i) p.in[i] = (const float*)d_in[i];
  p.out = (float*)d_out;
  p.ws = (unsigned char*)d_ws;
  p.ph_lo = 0;
  p.ph_hi = NPHASES;
  void* args[] = {&p};
  hipError_t e = hipLaunchCooperativeKernel((void*)mega_kernel, dim3(grid_blocks), dim3(NTHREADS), args, 0, stream);
  if (e != hipSuccess) fprintf(stderr, "cooperative launch failed: %s (grid %d)\n", hipGetErrorString(e), grid_blocks);
}
```

```cpp
#include <hip/hip_runtime.h>
#include <hip/hip_cooperative_groups.h>
#include <cstdio>
namespace cg = cooperative_groups;

#define DI __device__ __forceinline__
typedef __attribute__((ext_vector_type(8))) short bf16x8;
typedef __attribute__((ext_vector_type(4))) short s16x4;
typedef __attribute__((ext_vector_type(16))) float f32x16;
typedef __attribute__((ext_vector_type(4))) float f32x4;
typedef __attribute__((ext_vector_type(2))) float f32x2;
typedef __attribute__((ext_vector_type(2))) __bf16 bf16x2_t;
typedef unsigned short bf16_t;

constexpr int D = 1024, NBATCH = 4, SEQ = 4096, L = 4112, T = NBATCH * L  , LP = 4224;
constexpr int DFF = 2816;
constexpr int NIN = 2816;
constexpr float EPS = 1e-6f;
constexpr float LOG2E = 1.4426950408889634f;
constexpr int NTHREADS = 512;
constexpr int SMEM_BYTES = 147456 + 64;

constexpr size_t OFF_WIN = 0;
constexpr size_t OFF_WG = OFF_WIN + (size_t)NIN * 1024 * 2;
constexpr size_t OFF_WQUP = OFF_WG + (size_t)3072 * 1024 * 2;
constexpr size_t OFF_WKVUP = OFF_WQUP + (size_t)768 * 256 * 2;
constexpr size_t OFF_WBR = OFF_WKVUP + (size_t)1024 * 128 * 2;
constexpr size_t OFF_WO = OFF_WBR + (size_t)3 * 1024 * 512 * 2;
constexpr size_t OFF_WUP = OFF_WO + (size_t)1024 * 1024 * 2;
constexpr size_t OFF_WDN = OFF_WUP + (size_t)5632 * 1024 * 2;
constexpr size_t OFF_HB = OFF_WDN + (size_t)1024 * 2816 * 2;
constexpr size_t OFF_SS = OFF_HB + (size_t)T * 1024 * 2;
constexpr size_t OFF_SSKR = OFF_SS + (size_t)8 * T * 4;
constexpr size_t OFF_ROPE = OFF_SSKR + (size_t)T * 4;
constexpr size_t OFF_LF = OFF_ROPE + (size_t)L * 32 * 4;
constexpr size_t OFF_CDEC = OFF_LF + (size_t)T * 8 * 4;
constexpr size_t OFF_HMETA = OFF_CDEC + (size_t)32 * LP * 4;
constexpr size_t OFF_KR = OFF_HMETA + (size_t)64 * 1024 * 4;
constexpr size_t OFF_CTR = OFF_KR + (size_t)T * 32 * 2;
constexpr size_t OFF_XBAR = OFF_CTR + 256;
constexpr size_t OFF_ARENA = OFF_XBAR + 3456 * 4 + 128;
constexpr size_t SZ64 = (size_t)NBATCH * 8 * LP * 64 * 2;
constexpr size_t SZ96 = (size_t)NBATCH * 8 * LP * 96 * 2;
constexpr size_t SZKS = (size_t)NBATCH * 2 * LP * 64 * 2;
constexpr size_t A_QF = OFF_ARENA;
constexpr size_t A_QS = A_QF + SZ64;
constexpr size_t A_QM = A_QS + SZ64;
constexpr size_t A_KF = A_QM + SZ96;
constexpr size_t A_VF = A_KF + SZ64;
constexpr size_t A_KS = A_VF + SZ64;
constexpr size_t A_VS = A_KS + SZKS;
constexpr size_t A_KM = A_VS + SZKS;
constexpr size_t A_VM = A_KM + SZ96;
constexpr size_t A_CQ = A_VM + SZ64;
constexpr size_t A_CKV = A_CQ + (size_t)T * 256 * 2;
constexpr size_t A_END = A_CKV + (size_t)T * 128 * 2;
constexpr size_t A_MERGED = A_KF;
constexpr size_t A_ACT = OFF_ARENA;
static_assert((size_t)T * 1024 * 2 <= 2 * SZ64, "merged alias");
static_assert(A_END <= (size_t)256 * 1024 * 1024, "workspace");
static_assert(A_ACT + (size_t)T * 2816 * 2 <= A_END, "act alias");

struct Params {
  const float* in[23];
  float* out;
  unsigned char* ws;
  int ph_lo, ph_hi;
};

__device__ const double ROPE_FREQ[16] = {1.0, 0.5623413251903491, 0.31622776601683794, 0.1778279410038923, 0.1, 0.05623413251903491,
  0.03162277660168379, 0.01778279410038923, 0.01, 0.005623413251903491, 0.0031622776601683794, 0.0017782794100389228, 0.001,
  0.0005623413251903491, 0.00031622776601683794, 0.00017782794100389227};

DI unsigned pk2(float a, float b) {
  f32x2 v = {a, b};
  bf16x2_t r = __builtin_convertvector(v, bf16x2_t);
  return __builtin_bit_cast(unsigned, r);
}
DI uint2 pk4(float a, float b, float c, float d) { return make_uint2(pk2(a, b), pk2(c, d)); }
DI bf16_t f2bf(float v) { return (bf16_t)(pk2(v, 0.f) & 0xffffu); }
DI float bf2f(bf16_t v) { return __uint_as_float(((unsigned)v) << 16); }
DI float xor32(float v) {
  const auto r = __builtin_amdgcn_permlane32_swap(__float_as_uint(v), __float_as_uint(v), false, false);
  return __uint_as_float(r[0]) + __uint_as_float(r[1]);
}
DI float max32(float v) {
  const auto r = __builtin_amdgcn_permlane32_swap(__float_as_uint(v), __float_as_uint(v), false, false);
  return fmaxf(__uint_as_float(r[0]), __uint_as_float(r[1]));
}
DI float fexp2(float x) { return __builtin_amdgcn_exp2f(x); }
DI f32x16 mfma32(bf16x8 a, bf16x8 b, f32x16 c) { return __builtin_amdgcn_mfma_f32_32x32x16_bf16(a, b, c, 0, 0, 0); }
DI float* hrow(const Params& p, int b, int pos) {
  return pos >= 16 ? p.out + ((size_t)(b * SEQ + pos - 16)) * D : (float*)(p.ws + OFF_HMETA) + (size_t)(b * 16 + pos) * D;
}

template <int WM, int WN, int TM, int TN, bool LOWREG = false, class RowOff>
DI void gemm_main(const bf16_t* __restrict__ A, RowOff rowoff, int a_kstride, const bf16_t* __restrict__ Bt, int ldb, int n0,
                  int nk, int mvalid, f32x16 (&acc)[TM][TN], char* smem) {
  static_assert(WM * WN == 8, "8 waves");
  constexpr int BM = WM * TM * 32, BN = WN * TN * 32;
  constexpr int NA = (BM + 63) / 64, NB = (BN + 63) / 64;
  constexpr int STAGE = (BM + BN) * 144;
  static_assert(2 * STAGE <= 147456, "smem");
  const int tid = threadIdx.x, lane = tid & 63, wid = __builtin_amdgcn_readfirstlane(tid >> 6);
  const int r = lane & 31, h = lane >> 5;
  const int wm = wid / WN, wn = wid % WN;
  const int lrow = tid >> 3, c8 = tid & 7;
  int aoff[NA];
#pragma unroll
  for (int i = 0; i < NA; ++i) aoff[i] = rowoff(min(lrow + 64 * i, BM - 1)) + c8 * 8;
  const bf16_t* bptr = Bt + (size_t)(n0 + lrow) * ldb + c8 * 8;
  bf16x8 ra0[NA], rb0[NB];
  auto gload = [&](int kt, bf16x8 (&ra)[NA], bf16x8 (&rb)[NB]) {
#pragma unroll
    for (int i = 0; i < NA; ++i) ra[i] = *(const bf16x8*)(A + aoff[i] + (size_t)kt * a_kstride);
#pragma unroll
    for (int i = 0; i < NB; ++i)
      if (BN % 64 == 0 || lrow + 64 * i < BN) rb[i] = *(const bf16x8*)(bptr + (size_t)(64 * i) * ldb + kt * 64);
  };
  auto sstore = [&](int s, bf16x8 (&ra)[NA], bf16x8 (&rb)[NB]) {
    char* as = smem + s * STAGE;
    char* bs = as + BM * 144;
#pragma unroll
    for (int i = 0; i < NA; ++i)
      if (BM % 64 == 0 || lrow + 64 * i < BM) *(bf16x8*)(as + (lrow + 64 * i) * 144 + c8 * 16) = ra[i];
#pragma unroll
    for (int i = 0; i < NB; ++i)
      if (BN % 64 == 0 || lrow + 64 * i < BN) *(bf16x8*)(bs + (lrow + 64 * i) * 144 + c8 * 16) = rb[i];
  };
  const int ntm = min(TM, max(0, (mvalid - wm * TM * 32 + 31) >> 5));
  gload(0, ra0, rb0);
  sstore(0, ra0, rb0);
  if (nk > 1) gload(1, ra0, rb0);
#pragma unroll 1
  for (int kt = 0; kt < nk; ++kt) {
    __syncthreads();
    if (kt + 1 < nk) sstore((kt + 1) & 1, ra0, rb0);
    __builtin_amdgcn_sched_barrier(0);
    if (kt + 2 < nk) gload(kt + 2, ra0, rb0);
    __builtin_amdgcn_sched_barrier(0);
    const char* as = smem + (kt & 1) * STAGE + (wm * TM * 32 + r) * 144 + h * 16;
    const char* bs = smem + (kt & 1) * STAGE + BM * 144 + (wn * TN * 32 + r) * 144 + h * 16;
    if (ntm > 0) {
      __builtin_amdgcn_s_setprio(1);
#pragma unroll
      for (int ks = 0; ks < 4; ++ks) {
        bf16x8 af[TM], bf[TN];
#pragma unroll
        for (int tn = 0; tn < TN; ++tn) bf[tn] = *(const bf16x8*)(bs + tn * 32 * 144 + ks * 32);
#pragma unroll
        for (int tm = 0; tm < TM; ++tm) af[tm] = *(const bf16x8*)(as + tm * 32 * 144 + ks * 32);
#pragma unroll
        for (int tm = 0; tm < TM; ++tm)
#pragma unroll
          for (int tn = 0; tn < TN; ++tn) acc[tm][tn] = mfma32(bf[tn], af[tm], acc[tm][tn]);
        if (LOWREG) __builtin_amdgcn_sched_barrier(0);
      }
      __builtin_amdgcn_s_setprio(0);
    }
  }
  __syncthreads();
}


template <class RowOff>
DI void gemm_rem(const bf16_t* __restrict__ A, RowOff rowoff, int a_kstride, const bf16_t* __restrict__ Bt, int ldb, int n0,
                 int nk, f32x16& acc, char* smem) {
  constexpr int PITCH = 272, STAGE = (64 + 128) * PITCH;
  const int nk2 = nk >> 1;
  const int tid = threadIdx.x, lane = tid & 63, wid = __builtin_amdgcn_readfirstlane(tid >> 6);
  const int r = lane & 31, h = lane >> 5;
  const int wm = wid >> 2, wn = wid & 3;
  const int lrow = tid >> 3, c8 = tid & 7;
  const bf16_t* ap = A + rowoff(lrow) + c8 * 8;
  const bf16_t* bp = Bt + (size_t)(n0 + lrow) * ldb + c8 * 8;
  bf16x8 ra[2][2], rb0[2][2], rb1[2][2];
  auto gload = [&](int k2, int s) {
#pragma unroll
    for (int hf = 0; hf < 2; ++hf) {
      const int kt = 2 * k2 + hf;
      ra[s][hf] = *(const bf16x8*)(ap + (size_t)kt * a_kstride);
      rb0[s][hf] = *(const bf16x8*)(bp + kt * 64);
      rb1[s][hf] = *(const bf16x8*)(bp + (size_t)64 * ldb + kt * 64);
    }
  };
  auto sstore = [&](int st, int s) {
    char* as = smem + st * STAGE;
#pragma unroll
    for (int hf = 0; hf < 2; ++hf) {
      *(bf16x8*)(as + lrow * PITCH + hf * 128 + c8 * 16) = ra[s][hf];
      *(bf16x8*)(as + (64 + lrow) * PITCH + hf * 128 + c8 * 16) = rb0[s][hf];
      *(bf16x8*)(as + (128 + lrow) * PITCH + hf * 128 + c8 * 16) = rb1[s][hf];
    }
  };
  auto compute = [&](int k2) {
    const char* as = smem + (k2 & 1) * STAGE + (wm * 32 + r) * PITCH + h * 16;
    const char* bs = smem + (k2 & 1) * STAGE + (64 + wn * 32 + r) * PITCH + h * 16;
#pragma unroll
    for (int ks = 0; ks < 8; ++ks) {
      const bf16x8 bf = *(const bf16x8*)(bs + ks * 32);
      const bf16x8 af = *(const bf16x8*)(as + ks * 32);
      acc = mfma32(bf, af, acc);
    }
  };
  gload(0, 0);
  gload(1, 1);
  sstore(0, 0);
  __syncthreads();
#pragma unroll 1
  for (int k2 = 0; k2 < nk2; k2 += 2) {
    if (k2 + 2 < nk2) gload(k2 + 2, 0);
    __builtin_amdgcn_sched_barrier(0);
    compute(k2);
    __builtin_amdgcn_sched_barrier(0);
    sstore(1, 1);
    __syncthreads();
    if (k2 + 3 < nk2) gload(k2 + 3, 1);
    __builtin_amdgcn_sched_barrier(0);
    compute(k2 + 1);
    __builtin_amdgcn_sched_barrier(0);
    if (k2 + 2 < nk2) sstore(0, 0);
    __syncthreads();
  }
}

template <int TM, int TN>
DI void zero_acc(f32x16 (&acc)[TM][TN]) {
#pragma unroll
  for (int a = 0; a < TM; ++a)
#pragma unroll
    for (int b = 0; b < TN; ++b)
#pragma unroll
      for (int i = 0; i < 16; ++i) acc[a][b][i] = 0.f;
}

DI int inproj_src_col(int n) {
  if (n < 1536) return n;
  if (n < 2048) return 1960 + (n - 1536);
  if (n < 2176) return 2472 + (n - 2048);
  if (n < 2304) return 2600 + (n - 2176);
  if (n < 2560) return 1544 + (n - 2304);
  if (n < 2688) return 1800 + (n - 2560);
  if (n < 2720) return 1928 + (n - 2688);
  if (n < 2728) return 1536 + (n - 2720);
  return -1;
}
DI void conv_mat(const float* __restrict__ src, int ldsrc, int K, int Np, const float* __restrict__ gain, int map,
                 bf16_t* __restrict__ dst, int& base, char* smem) {
  float* tl = (float*)smem;
  const int tk = K / 64, tn = Np / 64, nt = tk * tn;
  const int G = gridDim.x;
  int start = (int)(((long)blockIdx.x - base) % G);
  if (start < 0) start += G;
  const int tid = threadIdx.x;
  const int lk = tid >> 4, n4 = (tid & 15) * 4;
  const int sn = tid >> 3, k8 = (tid & 7) * 8;
  auto issue = [&](int t, f32x4& a, f32x4& b) {
    const int k0 = (t % tk) * 64, n0 = (t / tk) * 64;
    const int nn = n0 + n4;
    int sc;
    if (map == 0) sc = nn;
    else if (map == 1) sc = inproj_src_col(nn);
    else if (map == 2) sc = 2728 + nn;
    else sc = (nn >> 6) * 32 + (nn & 31) + ((nn & 32) ? DFF : 0);
    a = f32x4{0.f, 0.f, 0.f, 0.f};
    b = a;
    if (sc >= 0) {
      a = *(const f32x4*)(src + (size_t)(k0 + lk) * ldsrc + sc);
      b = *(const f32x4*)(src + (size_t)(k0 + lk + 32) * ldsrc + sc);
    }
    if (gain) {
      const float g0 = gain[k0 + lk], g1 = gain[k0 + lk + 32];
#pragma unroll
      for (int j = 0; j < 4; ++j) { a[j] *= g0; b[j] *= g1; }
    }
  };
  f32x4 ca, cb2;
  int t = start;
  if (t < nt) issue(t, ca, cb2);
  while (t < nt) {
#pragma unroll
    for (int j = 0; j < 4; ++j) {
      tl[(n4 + j) * 65 + lk] = ca[j];
      tl[(n4 + j) * 65 + lk + 32] = cb2[j];
    }
    __syncthreads();
    const int tnx = t + G;
    f32x4 na, nb;
    if (tnx < nt) issue(tnx, na, nb);
    {
      const int k0 = (t % tk) * 64, n0 = (t / tk) * 64;
      float v[8];
#pragma unroll
      for (int j = 0; j < 8; ++j) v[j] = tl[sn * 65 + k8 + j];
      *(uint4*)(dst + (size_t)(n0 + sn) * K + k0 + k8) = make_uint4(pk2(v[0], v[1]), pk2(v[2], v[3]), pk2(v[4], v[5]), pk2(v[6], v[7]));
    }
    __syncthreads();
    ca = na; cb2 = nb;
    t = tnx;
  }
  base += nt;
}
DI void convert_layer(const Params& p, int l, char* smem) {
  unsigned char* ws = p.ws;
  int base = 0;
  const float* w_in = p.in[3] + (size_t)l * 1024 * 5800;
  conv_mat(w_in, 5800, 1024, NIN, p.in[2] + l * 1024, 1, (bf16_t*)(ws + OFF_WIN), base, smem);
  conv_mat(w_in, 5800, 1024, 3072, p.in[2] + l * 1024, 2, (bf16_t*)(ws + OFF_WG), base, smem);
  conv_mat(p.in[8] + (size_t)l * 256 * 768, 768, 256, 768, p.in[7] + l * 256, 0, (bf16_t*)(ws + OFF_WQUP), base, smem);
  conv_mat(p.in[10] + (size_t)l * 128 * 1024, 1024, 128, 1024, p.in[9] + l * 128, 0, (bf16_t*)(ws + OFF_WKVUP), base, smem);
  for (int n = 0; n < 3; ++n)
    conv_mat(p.in[16] + ((size_t)l * 3 + n) * 512 * 1024, 1024, 512, 1024, nullptr, 0,
             (bf16_t*)(ws + OFF_WBR) + (size_t)n * 1024 * 512, base, smem);
  conv_mat(p.in[17] + (size_t)l * 1024 * 1024, 1024, 1024, 1024, nullptr, 0, (bf16_t*)(ws + OFF_WO), base, smem);
  conv_mat(p.in[19] + (size_t)l * 1024 * 5632, 5632, 1024, 5632, p.in[18] + l * 1024, 3, (bf16_t*)(ws + OFF_WUP), base, smem);
  conv_mat(p.in[22] + (size_t)l * 2816 * 1024, 1024, 2816, 1024, nullptr, 0, (bf16_t*)(ws + OFF_WDN), base, smem);
}

DI void phase_init(const Params& p) {
  unsigned char* ws = p.ws;
  const int tid = threadIdx.x, lane = tid & 63, wid = tid >> 6;
  const int gw = blockIdx.x * 8 + wid, nw = gridDim.x * 8;
  const int gt = blockIdx.x * NTHREADS + tid, ntot = gridDim.x * NTHREADS;
  float* ss = (float*)(ws + OFF_SS);
  bf16_t* hb = (bf16_t*)(ws + OFF_HB);
  for (int m = gw; m < T; m += nw) {
    int b = m / L, pos = m - b * L;
    const float* src = pos < 16 ? p.in[1] + pos * D : p.in[0] + ((size_t)(b * SEQ + pos - 16)) * D;
    float* dsth = hrow(p, b, pos);
    float s = 0.f;
#pragma unroll
    for (int i = 0; i < 4; ++i) {
      int c = (i * 64 + lane) * 4;
      f32x4 v = *(const f32x4*)(src + c);
      *(f32x4*)(dsth + c) = v;
      *(uint2*)(hb + (size_t)m * D + c) = pk4(v[0], v[1], v[2], v[3]);
      s += v[0] * v[0] + v[1] * v[1] + v[2] * v[2] + v[3] * v[3];
    }
#pragma unroll
    for (int o = 32; o >= 1; o >>= 1) s += __shfl_xor(s, o);
    if (lane == 0) ss[m] = s;
  }
  for (int i = gt; i < 7 * T; i += ntot) ss[T + i] = 0.f;
  if (gt < 64) ((unsigned*)(ws + OFF_CTR))[gt] = 0u;
  for (int i = gt; i < 3456; i += ntot) ((unsigned*)(ws + OFF_XBAR))[i] = 0u;
  float* rc = (float*)(ws + OFF_ROPE);
  float* rsn = rc + L * 16;
  for (int i = gt; i < L * 16; i += ntot) {
    int pos = i >> 4, c = i & 15;
    double ang = (double)pos * ROPE_FREQ[c];
    double k = rint(ang * 0.15915494309189535);
    double x = ang - k * 6.283185307179586476925;
    double x2 = x * x;
    double sn = 0.0, cs = 0.0;
    double ts = x, tc = 1.0;
#pragma unroll 1
    for (int n = 0; n < 15; ++n) {
      sn += ts;
      cs += tc;
      tc = -tc * x2 / (double)((2 * n + 1) * (2 * n + 2));
      ts = -ts * x2 / (double)((2 * n + 2) * (2 * n + 3));
    }
    rc[i] = (float)cs;
    rsn[i] = (float)sn;
  }
}


struct TileIter {
  int xcd, loc, nloc, per, nt, i;
  bool xmode;
  DI TileIter(int ntiles) {
    nt = ntiles;
    xmode = (gridDim.x & 7) == 0;
    if (xmode) { xcd = blockIdx.x & 7; loc = blockIdx.x >> 3; nloc = gridDim.x >> 3; per = (ntiles + 7) >> 3; i = loc; }
    else { xcd = 0; loc = blockIdx.x; nloc = gridDim.x; per = ntiles; i = loc; }
  }
  DI int next() {
    if (i >= per) return -1;
    const int t = xcd * per + i;
    i += nloc;
    return t < nt ? t : -1;
  }
};

DI void phase_inproj(const Params& p, int l, char* smem) {
  unsigned char* ws = p.ws;
  const bf16_t* hb = (const bf16_t*)(ws + OFF_HB);
  const bf16_t* W = (const bf16_t*)(ws + OFF_WIN);
  const float* ss1 = (const float*)(ws + OFF_SS) + (size_t)(l * 2) * T;
  float* ss_cq = (float*)(ws + OFF_SS) + (size_t)(4 + l) * T;
  float* ss_ckv = (float*)(ws + OFF_SS) + (size_t)(6 + l) * T;
  float* ss_kr = (float*)(ws + OFF_SSKR);
  const int lane = threadIdx.x & 63, wid = __builtin_amdgcn_readfirstlane(threadIdx.x >> 6), r = lane & 31, h = lane >> 5, wm = wid >> 2, wn = wid & 3;
  constexpr int NT = NIN / 256, MT = (T + 255) / 256;
  TileIter tit(NT * MT);
  for (int t = tit.next(); t >= 0; t = tit.next()) {
    const int nt = t % NT, mt = t / NT;
    const int m0 = mt * 256, n0 = nt * 256;
    f32x16 acc[4][2];
    zero_acc(acc);
    gemm_main<2, 4, 4, 2>(hb, [&](int row) { return min(m0 + row, T - 1) * D; }, 64, W, D, n0, D / 64, T - m0, acc, smem);
    const int n0w = n0 + wn * 64;
#pragma unroll
    for (int tm = 0; tm < 4; ++tm) {
      const int m = m0 + wm * 128 + tm * 32 + r;
      const bool valid = m < T;
      const int mm = valid ? m : T - 1;
      const int b = mm / L, pos = mm - b * L;
      const float rs = rsqrtf(ss1[mm] * (1.f / 1024.f) + EPS);
#pragma unroll
      for (int tn = 0; tn < 2; ++tn)
#pragma unroll
        for (int i = 0; i < 16; ++i) acc[tm][tn][i] *= rs;
      float ssq = 0.f;
#pragma unroll
      for (int tn = 0; tn < 2; ++tn)
#pragma unroll
        for (int i = 0; i < 16; ++i) ssq += acc[tm][tn][i] * acc[tm][tn][i];
      if (n0w < 2304) {
        int kind, head, nh;
        const float* gain = nullptr;
        float scale = 1.f;
        bf16_t* dst;
        if (n0w < 512) { kind = 0; head = n0w >> 6; nh = 8; gain = p.in[5] + l * 64; scale = 0.125f * LOG2E; dst = (bf16_t*)(ws + A_QF); }
        else if (n0w < 1024) { kind = 0; head = (n0w - 512) >> 6; nh = 8; gain = p.in[6] + l * 64; dst = (bf16_t*)(ws + A_KF); }
        else if (n0w < 1536) { kind = 1; head = (n0w - 1024) >> 6; nh = 8; dst = (bf16_t*)(ws + A_VF); }
        else if (n0w < 2048) { kind = 0; head = (n0w - 1536) >> 6; nh = 8; gain = p.in[13] + l * 64; scale = 0.125f * LOG2E; dst = (bf16_t*)(ws + A_QS); }
        else if (n0w < 2176) { kind = 0; head = (n0w - 2048) >> 6; nh = 2; gain = p.in[14] + l * 64; dst = (bf16_t*)(ws + A_KS); }
        else { kind = 1; head = (n0w - 2176) >> 6; nh = 2; dst = (bf16_t*)(ws + A_VS); }
        if (kind == 0) {
          const float tot = xor32(ssq);
          const float rr = rsqrtf(tot * (1.f / 64.f) + EPS) * scale;
          bf16_t* drow = dst + ((size_t)(b * nh + head) * LP + pos) * 64;
#pragma unroll
          for (int tn = 0; tn < 2; ++tn)
#pragma unroll
            for (int g4 = 0; g4 < 4; ++g4) {
              const int d = tn * 32 + 8 * g4 + 4 * h;
              const f32x4 gv = *(const f32x4*)(gain + d);
              uint2 o = pk4(acc[tm][tn][4 * g4] * rr * gv[0], acc[tm][tn][4 * g4 + 1] * rr * gv[1],
                            acc[tm][tn][4 * g4 + 2] * rr * gv[2], acc[tm][tn][4 * g4 + 3] * rr * gv[3]);
              if (valid) *(uint2*)(drow + d) = o;
            }
        } else {
          bf16_t* dcol = dst + ((size_t)(b * nh + head) * 64) * LP + pos;
          if (valid) {
#pragma unroll
            for (int tn = 0; tn < 2; ++tn)
#pragma unroll
              for (int i = 0; i < 16; ++i) {
                const int d = tn * 32 + (i & 3) + 8 * (i >> 2) + 4 * h;
                dcol[(size_t)d * LP] = f2bf(acc[tm][tn][i]);
              }
          }
        }
      } else if (n0w < 2688) {
        bf16_t* dst;
        float* ssd;
        int ld, c0;
        if (n0w < 2560) { dst = (bf16_t*)(ws + A_CQ); ssd = ss_cq; ld = 256; c0 = n0w - 2304; }
        else { dst = (bf16_t*)(ws + A_CKV); ssd = ss_ckv; ld = 128; c0 = n0w - 2560; }
        const float tot = xor32(ssq);
        if (valid) {
#pragma unroll
          for (int tn = 0; tn < 2; ++tn)
#pragma unroll
            for (int g4 = 0; g4 < 4; ++g4) {
              const int d = c0 + tn * 32 + 8 * g4 + 4 * h;
              *(uint2*)(dst + (size_t)m * ld + d) =
                  pk4(acc[tm][tn][4 * g4], acc[tm][tn][4 * g4 + 1], acc[tm][tn][4 * g4 + 2], acc[tm][tn][4 * g4 + 3]);
            }
          if (h == 0) atomicAdd(ssd + m, tot);
        }
      } else if (n0w == 2688) {
        float s0 = 0.f;
#pragma unroll
        for (int i = 0; i < 16; ++i) s0 += acc[tm][0][i] * acc[tm][0][i];
        s0 = xor32(s0);
        if (valid) {
          bf16_t* kr = (bf16_t*)(ws + OFF_KR) + (size_t)m * 32;
#pragma unroll
          for (int g4 = 0; g4 < 4; ++g4)
            *(uint2*)(kr + 8 * g4 + 4 * h) =
                pk4(acc[tm][0][4 * g4], acc[tm][0][4 * g4 + 1], acc[tm][0][4 * g4 + 2], acc[tm][0][4 * g4 + 3]);
          if (h == 0) ss_kr[m] = s0;
          float* lf = (float*)(ws + OFF_LF) + (size_t)m * 8 + 4 * h;
          f32x4 o;
#pragma unroll
          for (int j = 0; j < 4; ++j) {
            float x = acc[tm][1][j] + p.in[4][l * 8 + 4 * h + j];
            o[j] = fminf(x, 0.f) - log1pf(__expf(-fabsf(x)));
          }
          *(f32x4*)lf = o;
        }
      }
    }
  }
}

DI void phase_mla_up(const Params& p, int l, char* smem) {
  unsigned char* ws = p.ws;
  const int lane = threadIdx.x & 63, wid = __builtin_amdgcn_readfirstlane(threadIdx.x >> 6), r = lane & 31, h = lane >> 5;
  const float* rope_c = (const float*)(ws + OFF_ROPE);
  const float* rope_s = rope_c + L * 16;
  constexpr int MT = 64;
  {
    const bf16_t* A = (const bf16_t*)(ws + A_CQ);
    const bf16_t* W = (const bf16_t*)(ws + OFF_WQUP);
    const float* ssc = (const float*)(ws + OFF_SS) + (size_t)(4 + l) * T;
    const float* g = p.in[11] + l * 96;
    bf16_t* Qm = (bf16_t*)(ws + A_QM);
    const float qscale = 0.10206207261596575f * LOG2E;
    auto epi = [&](f32x16 (&acc)[1][3], int m, int head) {
      const int b = m / L, pos = m - b * L;
      const float rs = rsqrtf(ssc[m] * (1.f / 256.f) + EPS);
      float ssq = 0.f;
#pragma unroll
      for (int tn = 0; tn < 3; ++tn)
#pragma unroll
        for (int i = 0; i < 16; ++i) { acc[0][tn][i] *= rs; ssq += acc[0][tn][i] * acc[0][tn][i]; }
      ssq = xor32(ssq);
      const float rr = rsqrtf(ssq * (1.f / 96.f) + EPS);
      bf16_t* drow = Qm + ((size_t)(b * 8 + head) * LP + pos) * 96;
#pragma unroll
      for (int tn = 0; tn < 2; ++tn)
#pragma unroll
        for (int g4 = 0; g4 < 4; ++g4) {
          const int d = tn * 32 + 8 * g4 + 4 * h;
          const f32x4 gv = *(const f32x4*)(g + d);
          *(uint2*)(drow + d) = pk4(acc[0][tn][4 * g4] * rr * gv[0] * qscale, acc[0][tn][4 * g4 + 1] * rr * gv[1] * qscale,
                                    acc[0][tn][4 * g4 + 2] * rr * gv[2] * qscale, acc[0][tn][4 * g4 + 3] * rr * gv[3] * qscale);
        }
#pragma unroll
      for (int g4 = 0; g4 < 2; ++g4) {
        const int c = 8 * g4 + 4 * h;
        const f32x4 g1 = *(const f32x4*)(g + 64 + c);
        const f32x4 g2 = *(const f32x4*)(g + 80 + c);
        const f32x4 cs = *(const f32x4*)(rope_c + pos * 16 + c);
        const f32x4 sn = *(const f32x4*)(rope_s + pos * 16 + c);
        float o1[4], o2[4];
#pragma unroll
        for (int j = 0; j < 4; ++j) {
          float x1 = acc[0][2][4 * g4 + j] * rr * g1[j];
          float x2 = acc[0][2][4 * g4 + 8 + j] * rr * g2[j];
          o1[j] = (x1 * cs[j] - x2 * sn[j]) * qscale;
          o2[j] = (x2 * cs[j] + x1 * sn[j]) * qscale;
        }
        *(uint2*)(drow + 64 + c) = pk4(o1[0], o1[1], o1[2], o1[3]);
        *(uint2*)(drow + 80 + c) = pk4(o2[0], o2[1], o2[2], o2[3]);
      }
    };
    for (int t = blockIdx.x; t < 8 * MT; t += gridDim.x) {
      const int head = t % 8, mt = t / 8;
      const int m0 = mt * 256;
      f32x16 acc[1][3];
      zero_acc(acc);
      gemm_main<8, 1, 1, 3>(A, [&](int row) { return (m0 + row) * 256; }, 64, W, 256, head * 96, 4, 256, acc, smem);
      epi(acc, m0 + wid * 32 + r, head);
    }
    for (int nt = (int)blockIdx.x - 8; nt >= 0 && nt < 2; nt += gridDim.x) {
      const int wm = wid >> 2, wn = wid & 3;
      f32x16 acc[1][3];
      zero_acc(acc);
      gemm_main<2, 4, 1, 3>(A, [&](int row) { return min(16384 + row, T - 1) * 256; }, 64, W, 256, nt * 384, 4, 64, acc, smem);
      epi(acc, 16384 + wm * 32 + r, nt * 4 + wn);
    }
  }
  {
    const bf16_t* A = (const bf16_t*)(ws + A_CKV);
    const bf16_t* W = (const bf16_t*)(ws + OFF_WKVUP);
    const float* ssc = (const float*)(ws + OFF_SS) + (size_t)(6 + l) * T;
    const float* ss_kr = (const float*)(ws + OFF_SSKR);
    const bf16_t* krp = (const bf16_t*)(ws + OFF_KR);
    const float* g = p.in[12] + l * 96;
    bf16_t* Km = (bf16_t*)(ws + A_KM);
    bf16_t* Vm = (bf16_t*)(ws + A_VM);
    auto epi = [&](f32x16 (&a)[2], int m, int head, int part) {
      const int b = m / L, pos = m - b * L;
      const float rs = rsqrtf(ssc[m] * (1.f / 128.f) + EPS);
      float ssq = 0.f;
#pragma unroll
      for (int tn = 0; tn < 2; ++tn)
#pragma unroll
        for (int i = 0; i < 16; ++i) { a[tn][i] *= rs; ssq += a[tn][i] * a[tn][i]; }
      ssq = xor32(ssq);
      if (part == 0) {
        const float rr = rsqrtf((ssq + ss_kr[m]) * (1.f / 96.f) + EPS);
        bf16_t* drow = Km + ((size_t)(b * 8 + head) * LP + pos) * 96;
#pragma unroll
        for (int tn = 0; tn < 2; ++tn)
#pragma unroll
          for (int g4 = 0; g4 < 4; ++g4) {
            const int d = tn * 32 + 8 * g4 + 4 * h;
            const f32x4 gv = *(const f32x4*)(g + d);
            *(uint2*)(drow + d) = pk4(a[tn][4 * g4] * rr * gv[0], a[tn][4 * g4 + 1] * rr * gv[1], a[tn][4 * g4 + 2] * rr * gv[2],
                                      a[tn][4 * g4 + 3] * rr * gv[3]);
          }
        const int c0 = 8 * h;
        const bf16x8 k1 = *(const bf16x8*)(krp + (size_t)m * 32 + c0);
        const bf16x8 k2 = *(const bf16x8*)(krp + (size_t)m * 32 + 16 + c0);
        float o1[8], o2[8];
#pragma unroll
        for (int j = 0; j < 8; ++j) {
          float x1 = bf2f((bf16_t)k1[j]) * rr * g[64 + c0 + j];
          float x2 = bf2f((bf16_t)k2[j]) * rr * g[80 + c0 + j];
          float cs = rope_c[pos * 16 + c0 + j], sn = rope_s[pos * 16 + c0 + j];
          o1[j] = x1 * cs - x2 * sn;
          o2[j] = x2 * cs + x1 * sn;
        }
        *(uint4*)(drow + 64 + c0) = make_uint4(pk2(o1[0], o1[1]), pk2(o1[2], o1[3]), pk2(o1[4], o1[5]), pk2(o1[6], o1[7]));
        *(uint4*)(drow + 80 + c0) = make_uint4(pk2(o2[0], o2[1]), pk2(o2[2], o2[3]), pk2(o2[4], o2[5]), pk2(o2[6], o2[7]));
      } else {
        bf16_t* dcol = Vm + ((size_t)(b * 8 + head) * 64) * LP + pos;
#pragma unroll
        for (int tn = 0; tn < 2; ++tn)
#pragma unroll
          for (int i = 0; i < 16; ++i) {
            const int d = tn * 32 + (i & 3) + 8 * (i >> 2) + 4 * h;
            dcol[(size_t)d * LP] = f2bf(a[tn][i]);
          }
      }
    };
    {
      const int wm = wid >> 1, wn = wid & 1;
      for (int t = blockIdx.x; t < 8 * MT; t += gridDim.x) {
        const int head = t % 8, mt = t / 8;
        const int m0 = mt * 256;
        f32x16 acc[2][2];
        zero_acc(acc);
        gemm_main<4, 2, 2, 2>(A, [&](int row) { return (m0 + row) * 128; }, 64, W, 128, head * 128, 2, 256, acc, smem);
#pragma unroll
        for (int tm = 0; tm < 2; ++tm) epi(acc[tm], m0 + wm * 64 + tm * 32 + r, head, wn);
      }
    }
    for (int nt = (int)blockIdx.x - 16; nt >= 0 && nt < 4; nt += gridDim.x) {
      const int wm = wid >> 2, wn = wid & 3;
      f32x16 acc[1][2];
      zero_acc(acc);
      gemm_main<2, 4, 1, 2>(A, [&](int row) { return min(16384 + row, T - 1) * 128; }, 64, W, 128, nt * 256, 2, 64, acc, smem);
      epi(acc[0], 16384 + wm * 32 + r, nt * 2 + (wn >> 1), wn & 1);
    }
  }
  {
    const float* lf = (const float*)(ws + OFF_LF);
    float* cd = (float*)(ws + OFF_CDEC);
    float* wtot = (float*)smem;
    const int tid = threadIdx.x;
    for (int s = (int)blockIdx.x - 32; s >= 0 && s < 32; s += gridDim.x) {
      const int b = s >> 3, hd = s & 7;
      float v[9];
#pragma unroll
      for (int c = 0; c < 9; ++c) {
        const int pos = tid * 9 + c;
        v[c] = pos < L ? lf[((size_t)(b * L + pos)) * 8 + hd] : 0.f;
      }
#pragma unroll
      for (int c = 1; c < 9; ++c) v[c] += v[c - 1];
      float tot = v[8];
#pragma unroll
      for (int o = 1; o < 64; o <<= 1) {
        float u = __shfl_up(tot, o);
        if (lane >= o) tot += u;
      }
      __syncthreads();
      if (lane == 63) wtot[wid] = tot;
      __syncthreads();
      float base = tot - v[8];
      for (int w = 0; w < wid; ++w) base += wtot[w];
#pragma unroll
      for (int c = 0; c < 9; ++c) {
        const int pos = tid * 9 + c;
        if (pos < L) cd[(size_t)s * LP + pos] = v[c] + base;
      }
    }
  }
}

template <int DK, int MODE>
DI void attn_item(bf16_t* Qs, const bf16_t* __restrict__ Ks, const bf16_t* __restrict__ Vt, const float* __restrict__ cdec,
                  int q0, int q_end, float slope2, float sink2, char* smem) {
  constexpr int KROW = (DK + 8) * 2;
  constexpr int KSZ = 64 * KROW;
  constexpr int VSZ = 64 * 136;
  constexpr int STAGE = KSZ + VSZ + 256;
  constexpr int NKC = DK / 8;
  constexpr int NKT = 64 * NKC;
  constexpr int NKL = (NKT + 511) / 512;
  constexpr int NS = DK / 16;
  const int tid = threadIdx.x, lane = tid & 63, w = __builtin_amdgcn_readfirstlane(tid >> 6), r = lane & 31, h = lane >> 5;
  const int qi = q0 + w * 32 + r;
  const bool wave_on = q0 + w * 32 < q_end;
  bf16x8 qf[NS];
#pragma unroll
  for (int s = 0; s < NS; ++s) qf[s] = *(const bf16x8*)(Qs + (size_t)qi * DK + s * 16 + 8 * h);
  const int kt_hi = (q_end - 1) >> 6;
  int t_lo = 0, ntiles;
  if (MODE == 2) { t_lo = max(1, (q0 - 127) >> 6); ntiles = 1 + max(0, kt_hi - t_lo + 1); }
  else ntiles = kt_hi + 1;
  auto tile_of = [&](int j) { return MODE == 2 ? (j == 0 ? 0 : t_lo + j - 1) : j; };

  bf16x8 rk[NKL], rv;
  float rc = 0.f;
  auto gload = [&](int tile) {
    const int k0 = tile * 64;
#pragma unroll
    for (int i = 0; i < NKL; ++i) {
      const int c = tid + i * 512, row = c / NKC, cc = c % NKC;
      if (NKT % 512 == 0 || c < NKT) rk[i] = *(const bf16x8*)(Ks + (size_t)(k0 + row) * DK + cc * 8);
    }
    {
      const int row = tid >> 3, cc = tid & 7;
      rv = *(const bf16x8*)(Vt + (size_t)row * LP + k0 + cc * 8);
    }
    if (MODE == 0 && tid < 64) rc = cdec[k0 + tid] * LOG2E;
  };
  auto sstore = [&](int s) {
    char* kb = smem + s * STAGE;
    char* vb = kb + KSZ;
#pragma unroll
    for (int i = 0; i < NKL; ++i) {
      const int c = tid + i * 512, row = c / NKC, cc = c % NKC;
      if (NKT % 512 == 0 || c < NKT) *(bf16x8*)(kb + row * KROW + cc * 16) = rk[i];
    }
    {
      const int row = tid >> 3, cc = tid & 7;
      s16x4 lo = {rv[0], rv[1], rv[2], rv[3]}, hi = {rv[4], rv[5], rv[6], rv[7]};
      *(s16x4*)(vb + row * 136 + cc * 16) = lo;
      *(s16x4*)(vb + row * 136 + cc * 16 + 8) = hi;
    }
    if (MODE == 0 && tid < 64) *(float*)(vb + VSZ + tid * 4) = rc;
  };

  f32x16 o[2];
#pragma unroll
  for (int i = 0; i < 16; ++i) { o[0][i] = 0.f; o[1][i] = 0.f; }
  float m_run = -1e30f, l_run = 0.f;

  gload(tile_of(0));
  sstore(0);
#pragma unroll
  for (int s = 0; s < NS; ++s) asm volatile("" ::"v"(qf[s]));
  __syncthreads();
  for (int j = 0; j < ntiles; ++j) {
    if (j + 1 < ntiles) gload(tile_of(j + 1));
    __builtin_amdgcn_sched_barrier(0);
    const int k0 = tile_of(j) * 64;
    const char* kb = smem + (j & 1) * STAGE;
    const char* vb = kb + KSZ;
    bool active = wave_on && (k0 <= q0 + w * 32 + 31);
    if (MODE == 2) active = active && (k0 == 0 || k0 + 63 >= q0 + w * 32 - 127);
    if (active) {
      f32x16 s[2];
#pragma unroll
      for (int kt = 0; kt < 2; ++kt) {
#pragma unroll
        for (int i = 0; i < 16; ++i) s[kt][i] = 0.f;
#pragma unroll
        for (int ks = 0; ks < NS; ++ks) {
          bf16x8 kf = *(const bf16x8*)(kb + (kt * 32 + r) * KROW + ks * 32 + h * 16);
          s[kt] = mfma32(kf, qf[ks], s[kt]);
        }
      }
      const bool need_mask = (MODE == 2) || (k0 + 63 > q0 + w * 32);
      float mx = -1e30f;
      if (MODE == 0 || MODE == 2) {
#pragma unroll
        for (int kt = 0; kt < 2; ++kt)
#pragma unroll
          for (int g4 = 0; g4 < 4; ++g4) {
            const int kj0 = k0 + kt * 32 + 8 * g4 + 4 * h;
            f32x4 ck;
            if (MODE == 0) ck = *(const f32x4*)(vb + VSZ + (kt * 32 + 8 * g4 + 4 * h) * 4);
#pragma unroll
            for (int jj = 0; jj < 4; ++jj) {
              if (MODE == 0) s[kt][4 * g4 + jj] -= ck[jj];
              if (MODE == 2) s[kt][4 * g4 + jj] -= slope2 * (float)(qi - kj0 - jj);
            }
          }
      }
      if (__builtin_amdgcn_readfirstlane((int)need_mask)) {
#pragma unroll
        for (int kt = 0; kt < 2; ++kt)
#pragma unroll
          for (int i = 0; i < 16; ++i) {
            const int kj = k0 + kt * 32 + (i & 3) + 8 * (i >> 2) + 4 * h;
            bool ok = kj <= qi;
            if (MODE == 2) ok = ok && (kj < 16 || qi - kj < 128);
            s[kt][i] = ok ? s[kt][i] : -1e30f;
          }
        asm volatile("" ::: "memory");
      }
#pragma unroll
      for (int kt = 0; kt < 2; ++kt)
#pragma unroll
        for (int i = 0; i < 16; ++i) mx = fmaxf(mx, s[kt][i]);
      mx = max32(mx);
      const float m_new = fmaxf(m_run, mx);
      const float alpha = fexp2(m_run - m_new);
      m_run = m_new;
      float psum = 0.f;
#pragma unroll
      for (int kt = 0; kt < 2; ++kt)
#pragma unroll
        for (int i = 0; i < 16; ++i) {
          float pv = fexp2(s[kt][i] - m_new);
          s[kt][i] = pv;
          psum += pv;
        }
      l_run = l_run * alpha + psum;
      if (__builtin_amdgcn_ballot_w64(alpha != 1.f) != 0ull) {
#pragma unroll
        for (int i = 0; i < 16; ++i) { o[0][i] *= alpha; o[1][i] *= alpha; }
      }
#pragma unroll
      for (int kt = 0; kt < 2; ++kt)
#pragma unroll
        for (int st = 0; st < 2; ++st) {
          unsigned pw[4];
#pragma unroll
          for (int u = 0; u < 4; ++u) pw[u] = pk2(s[kt][8 * st + 2 * u], s[kt][8 * st + 2 * u + 1]);
          uint4 pu = make_uint4(pw[0], pw[1], pw[2], pw[3]);
          const bf16x8 pf = __builtin_bit_cast(bf16x8, pu);
#pragma unroll
          for (int dt = 0; dt < 2; ++dt) {
            const char* va = vb + (dt * 32 + r) * 136 + (kt * 32 + 16 * st + 4 * h) * 2;
            const s16x4 lo = *(const s16x4*)va;
            const s16x4 hi = *(const s16x4*)(va + 16);
            const bf16x8 vf = {lo[0], lo[1], lo[2], lo[3], hi[0], hi[1], hi[2], hi[3]};
            o[dt] = mfma32(vf, pf, o[dt]);
          }
        }
    }
    __builtin_amdgcn_sched_barrier(0);
    if (j + 1 < ntiles) sstore((j + 1) & 1);
    __syncthreads();
  }
  float lt = xor32(l_run);
  if (MODE == 2) lt += fexp2(sink2 - m_run);
  const float inv = 1.f / lt;
  if (qi < q_end) {
    bf16_t* orow = Qs + (size_t)qi * DK;
#pragma unroll
    for (int dt = 0; dt < 2; ++dt)
#pragma unroll
      for (int g4 = 0; g4 < 4; ++g4) {
        const int d = dt * 32 + 8 * g4 + 4 * h;
        *(uint2*)(orow + d) = pk4(o[dt][4 * g4] * inv, o[dt][4 * g4 + 1] * inv, o[dt][4 * g4 + 2] * inv, o[dt][4 * g4 + 3] * inv);
      }
  }
}

DI int next_item(unsigned* ctr, int* sidx) {
  if (threadIdx.x == 0) *sidx = (int)atomicAdd(ctr, 1u);
  __syncthreads();
  const int idx = *sidx;
  __syncthreads();
  return idx;
}
DI void phase_attn(const Params& p, int l, char* smem) {
  unsigned char* ws = p.ws;
  unsigned* ctr = (unsigned*)(ws + OFF_CTR) + l * 4;
  int* sidx = (int*)(smem + 147456);
  constexpr int NQT = 17, NIT = 32 * NQT;
#pragma unroll 1
  while (true) {
    const int idx = next_item(ctr, sidx);
    if (idx >= NIT) break;
    const int qt = NQT - 1 - (idx >> 5), bh = idx & 31;
    const int q0 = qt == 0 ? 0 : 16 + 256 * (qt - 1), q_end = qt == 0 ? 16 : q0 + 256;
    attn_item<64, 0>((bf16_t*)(ws + A_QF) + (size_t)bh * LP * 64, (const bf16_t*)(ws + A_KF) + (size_t)bh * LP * 64,
                     (const bf16_t*)(ws + A_VF) + (size_t)bh * 64 * LP, (const float*)(ws + OFF_CDEC) + (size_t)bh * LP, q0, q_end,
                     0.f, 0.f, smem);
  }
#pragma unroll 1
  while (true) {
    const int idx = next_item(ctr + 1, sidx);
    if (idx >= NIT) break;
    const int qt = NQT - 1 - (idx >> 5), bh = idx & 31;
    const int q0 = qt == 0 ? 0 : 16 + 256 * (qt - 1), q_end = qt == 0 ? 16 : q0 + 256;
    attn_item<96, 1>((bf16_t*)(ws + A_QM) + (size_t)bh * LP * 96, (const bf16_t*)(ws + A_KM) + (size_t)bh * LP * 96,
                     (const bf16_t*)(ws + A_VM) + (size_t)bh * 64 * LP, nullptr, q0, q_end, 0.f, 0.f, smem);
  }
#pragma unroll 1
  while (true) {
    const int idx = next_item(ctr + 2, sidx);
    if (idx >= NIT) break;
    const int qt = idx >> 5, bh = idx & 31, b = bh >> 3, hq = bh & 7, hk = hq >> 2;
    const int q0 = qt == 0 ? 0 : 16 + 256 * (qt - 1), q_end = qt == 0 ? 16 : q0 + 256;
    const float slope2 = fexp2(-(float)(hq + 1)) * LOG2E;
    const float sink2 = p.in[15][l * 8 + hq] * LOG2E;
    attn_item<64, 2>((bf16_t*)(ws + A_QS) + (size_t)bh * LP * 64, (const bf16_t*)(ws + A_KS) + (size_t)(b * 2 + hk) * LP * 64,
                     (const bf16_t*)(ws + A_VS) + (size_t)(b * 2 + hk) * 64 * LP, nullptr, q0, q_end, slope2, sink2, smem);
  }
}

DI void phase_merge(const Params& p, int l, char* smem) {
  unsigned char* ws = p.ws;
  const bf16_t* hb = (const bf16_t*)(ws + OFF_HB);
  const bf16_t* Wg = (const bf16_t*)(ws + OFF_WG);
  const bf16_t* Wb = (const bf16_t*)(ws + OFF_WBR);
  const float* ss1 = (const float*)(ws + OFF_SS) + (size_t)(l * 2) * T;
  bf16_t* merged = (bf16_t*)(ws + A_MERGED);
  const int lane = threadIdx.x & 63, wid = __builtin_amdgcn_readfirstlane(threadIdx.x >> 6), r = lane & 31, h = lane >> 5, wm = wid >> 1, wn = wid & 1;
  constexpr int NT = 8, MT = 64;
  TileIter tit(NT * MT);
  for (int t = tit.next(); t >= 0; t = tit.next()) {
    const int nt = t % NT, mt = t / NT;
    const int m0 = mt * 256, n0 = nt * 128;
    float rs[2];
#pragma unroll
    for (int tm = 0; tm < 2; ++tm) rs[tm] = rsqrtf(ss1[min(m0 + wm * 64 + tm * 32 + r, T - 1)] * (1.f / 1024.f) + EPS);
#pragma unroll 1
    for (int n = 0; n < 3; ++n) {
      f32x16 acc[2][2];
      zero_acc(acc);
      gemm_main<4, 2, 2, 2, false>(hb, [&](int row) { return min(m0 + row, T - 1) * D; }, 64, Wg + (size_t)n * 1024 * 1024, D, n0, D / 64,
                            T - m0, acc, smem);
      unsigned gp[2][2][8];
#pragma unroll
      for (int tm = 0; tm < 2; ++tm)
#pragma unroll
      for (int tn = 0; tn < 2; ++tn)
#pragma unroll
        for (int u = 0; u < 8; ++u) {
          float a = __builtin_amdgcn_rcpf(1.f + __expf(-acc[tm][tn][2 * u] * rs[tm]));
          float bq = __builtin_amdgcn_rcpf(1.f + __expf(-acc[tm][tn][2 * u + 1] * rs[tm]));
          gp[tm][tn][u] = pk2(a, bq);
        }
      zero_acc(acc);
      const bf16_t* Ab;
      int rstride, kstride;
      if (n == 0) { Ab = (const bf16_t*)(ws + A_QF); rstride = 64; kstride = LP * 64; }
      else if (n == 1) { Ab = (const bf16_t*)(ws + A_QM); rstride = 96; kstride = LP * 96; }
      else { Ab = (const bf16_t*)(ws + A_QS); rstride = 64; kstride = LP * 64; }
      gemm_main<4, 2, 2, 2, false>(Ab, [&](int row) {
        int mr = min(m0 + row, T - 1);
        int b = mr / L, pos = mr - b * L;
        return (b * 8 * LP + pos) * rstride; }, kstride, Wb + (size_t)n * 1024 * 512, 512, n0, 8, T - m0, acc, smem);
#pragma unroll
      for (int tm = 0; tm < 2; ++tm) {
        const int m = m0 + wm * 64 + tm * 32 + r;
        if (m < T) {
#pragma unroll
          for (int tn = 0; tn < 2; ++tn)
#pragma unroll
            for (int g4 = 0; g4 < 4; ++g4) {
              const int col = n0 + wn * 64 + tn * 32 + 8 * g4 + 4 * h;
              uint2* dst = (uint2*)(merged + (size_t)m * D + col);
              uint2 old = make_uint2(0u, 0u);
              if (n > 0) old = *dst;
              const unsigned g0 = gp[tm][tn][2 * g4], g1 = gp[tm][tn][2 * g4 + 1];
              float f0 = __uint_as_float(g0 << 16) * acc[tm][tn][4 * g4] + __uint_as_float(old.x << 16);
              float f1 = __uint_as_float(g0 & 0xffff0000u) * acc[tm][tn][4 * g4 + 1] + __uint_as_float(old.x & 0xffff0000u);
              float f2 = __uint_as_float(g1 << 16) * acc[tm][tn][4 * g4 + 2] + __uint_as_float(old.y << 16);
              float f3 = __uint_as_float(g1 & 0xffff0000u) * acc[tm][tn][4 * g4 + 3] + __uint_as_float(old.y & 0xffff0000u);
              *dst = pk4(f0, f1, f2, f3);
            }
        }
      }
    }
  }
  {
    const int wm1 = wid >> 2, wn1 = wid & 3;
    for (int nt = blockIdx.x; nt < 8; nt += gridDim.x) {
      const int m0 = 16384, n0 = nt * 128;
      const int m = m0 + wm1 * 32 + r;
      const float rs1 = rsqrtf(ss1[m] * (1.f / 1024.f) + EPS);
#pragma unroll 1
      for (int n = 0; n < 3; ++n) {
        f32x16 acc[1][1];
        zero_acc(acc);
        gemm_rem(hb, [&](int row) { return min(m0 + row, T - 1) * D; }, 64, Wg + (size_t)n * 1024 * 1024, D, n0, D / 64, acc[0][0], smem);
        unsigned gp[8];
#pragma unroll
        for (int u = 0; u < 8; ++u)
          gp[u] = pk2(__builtin_amdgcn_rcpf(1.f + __expf(-acc[0][0][2 * u] * rs1)), __builtin_amdgcn_rcpf(1.f + __expf(-acc[0][0][2 * u + 1] * rs1)));
        zero_acc(acc);
        const bf16_t* Ab;
        int rstride, kstride;
        if (n == 0) { Ab = (const bf16_t*)(ws + A_QF); rstride = 64; kstride = LP * 64; }
        else if (n == 1) { Ab = (const bf16_t*)(ws + A_QM); rstride = 96; kstride = LP * 96; }
        else { Ab = (const bf16_t*)(ws + A_QS); rstride = 64; kstride = LP * 64; }
        gemm_rem(Ab, [&](int row) {
          int mr = min(m0 + row, T - 1);
          int b = mr / L, pos = mr - b * L;
          return (b * 8 * LP + pos) * rstride; }, kstride, Wb + (size_t)n * 1024 * 512, 512, n0, 8, acc[0][0], smem);
#pragma unroll
        for (int g4 = 0; g4 < 4; ++g4) {
          const int col = n0 + wn1 * 32 + 8 * g4 + 4 * h;
          uint2* dst = (uint2*)(merged + (size_t)m * D + col);
          uint2 old = make_uint2(0u, 0u);
          if (n > 0) old = *dst;
          const unsigned g0 = gp[2 * g4], g1 = gp[2 * g4 + 1];
          float f0 = __uint_as_float(g0 << 16) * acc[0][0][4 * g4] + __uint_as_float(old.x << 16);
          float f1 = __uint_as_float(g0 & 0xffff0000u) * acc[0][0][4 * g4 + 1] + __uint_as_float(old.x & 0xffff0000u);
          float f2 = __uint_as_float(g1 << 16) * acc[0][0][4 * g4 + 2] + __uint_as_float(old.y << 16);
          float f3 = __uint_as_float(g1 & 0xffff0000u) * acc[0][0][4 * g4 + 3] + __uint_as_float(old.y & 0xffff0000u);
          *dst = pk4(f0, f1, f2, f3);
        }
      }
    }
  }
}


DI void stage_half(const f32x16 (&acc)[4][2], int hp, int wm, int wn, int r, int h, const float (&rowscale)[4], float* stg) {
  if ((wn >> 1) == hp) {
#pragma unroll
    for (int tm = 0; tm < 4; ++tm) {
      float* srow = stg + (wm * 128 + tm * 32 + r) * 132 + (wn & 1) * 64 + 4 * h;
#pragma unroll
      for (int tn = 0; tn < 2; ++tn)
#pragma unroll
        for (int g4 = 0; g4 < 4; ++g4) {
          f32x4 v = {acc[tm][tn][4 * g4] * rowscale[tm], acc[tm][tn][4 * g4 + 1] * rowscale[tm],
                     acc[tm][tn][4 * g4 + 2] * rowscale[tm], acc[tm][tn][4 * g4 + 3] * rowscale[tm]};
          *(f32x4*)(srow + tn * 32 + 8 * g4) = v;
        }
    }
  }
}

DI void phase_resid(const Params& p, const bf16_t* A, int K, const bf16_t* W, float* ss_next, bool last, char* smem) {
  unsigned char* ws = p.ws;
  bf16_t* hb = (bf16_t*)(ws + OFF_HB);
  const int tid = threadIdx.x, lane = tid & 63, wid = __builtin_amdgcn_readfirstlane(tid >> 6), r = lane & 31, h = lane >> 5, wm = wid >> 2, wn = wid & 3;
  constexpr int NT = 4, MT = 64;
  float* stg = (float*)smem;
  TileIter tit(NT * MT);
  for (int t = tit.next(); t >= 0; t = tit.next()) {
    const int nt = t % NT, mt = t / NT;
    const int m0 = mt * 256, n0 = nt * 256;
    f32x16 acc[4][2];
    zero_acc(acc);
    gemm_main<2, 4, 4, 2>(A, [&](int row) { return min(m0 + row, T - 1) * K; }, 64, W, K, n0, K / 64, T - m0, acc, smem);
    const float ones[4] = {1.f, 1.f, 1.f, 1.f};
#pragma unroll 1
    for (int hp = 0; hp < 2; ++hp) {
      const int chunk = tid & 15;
      const int col = n0 + hp * 128 + chunk * 8;
      f32x4 h0[2], h1[2];
      auto hptr = [&](int it) {
        const int m = m0 + (tid >> 4) + 32 * it;
        const int b = m / L, pos = m - b * L;
        return hrow(p, b, pos) + col;
      };
      auto issue = [&](int bt) {
#pragma unroll
        for (int q = 0; q < 2; ++q) {
          const float* hp_ = hptr(bt * 2 + q);
          h0[q] = *(const f32x4*)hp_;
          h1[q] = *(const f32x4*)(hp_ + 4);
        }
      };
      auto process = [&](int bt) {
#pragma unroll
        for (int q = 0; q < 2; ++q) {
          const int row = (tid >> 4) + 32 * (bt * 2 + q);
          const int m = m0 + row;
          float* hp_ = hptr(bt * 2 + q);
          const f32x4 a0 = *(const f32x4*)(stg + row * 132 + chunk * 8);
          const f32x4 a1 = *(const f32x4*)(stg + row * 132 + chunk * 8 + 4);
          f32x4 v0, v1;
          float ssq = 0.f;
#pragma unroll
          for (int j = 0; j < 4; ++j) {
            v0[j] = a0[j] + h0[q][j];
            v1[j] = a1[j] + h1[q][j];
            ssq += v0[j] * v0[j] + v1[j] * v1[j];
          }
          *(f32x4*)hp_ = v0;
          *(f32x4*)(hp_ + 4) = v1;
          if (!last) {
            *(uint4*)(hb + (size_t)m * D + col) = make_uint4(pk2(v0[0], v0[1]), pk2(v0[2], v0[3]), pk2(v1[0], v1[1]), pk2(v1[2], v1[3]));
            ssq += __shfl_xor(ssq, 8);
            ssq += __shfl_xor(ssq, 4);
            ssq += __shfl_xor(ssq, 2);
            ssq += __shfl_xor(ssq, 1);
            if (chunk == 0) atomicAdd(ss_next + m, ssq);
          }
        }
      };
      issue(0);
      stage_half(acc, hp, wm, wn, r, h, ones, stg);
      __syncthreads();
      process(0);
#pragma unroll
      for (int bt = 1; bt < 4; ++bt) {
        __builtin_amdgcn_sched_barrier(0);
        issue(bt);
        process(bt);
      }
      __syncthreads();
    }
  }
  for (int nt = blockIdx.x; nt < 8; nt += gridDim.x) {
    const int m0 = 16384, n0 = nt * 128;
    f32x16 acc[1][1];
    zero_acc(acc);
    gemm_rem(A, [&](int row) { return min(m0 + row, T - 1) * K; }, 64, W, K, n0, K / 64, acc[0][0], smem);
    const int m = m0 + wm * 32 + r;
    const int b = m / L, pos = m - b * L;
    float* hr = hrow(p, b, pos);
    float ssq = 0.f;
    f32x4 hv[4];
#pragma unroll
    for (int g4 = 0; g4 < 4; ++g4) hv[g4] = *(const f32x4*)(hr + n0 + wn * 32 + 8 * g4 + 4 * h);
#pragma unroll
    for (int g4 = 0; g4 < 4; ++g4) {
      const int col = n0 + wn * 32 + 8 * g4 + 4 * h;
      f32x4 v;
#pragma unroll
      for (int j = 0; j < 4; ++j) { v[j] = hv[g4][j] + acc[0][0][4 * g4 + j]; ssq += v[j] * v[j]; }
      *(f32x4*)(hr + col) = v;
      if (!last) *(uint2*)(hb + (size_t)m * D + col) = pk4(v[0], v[1], v[2], v[3]);
    }
    ssq = xor32(ssq);
    if (!last && h == 0) atomicAdd(ss_next + m, ssq);
  }
}

DI void phase_up(const Params& p, int l, char* smem) {
  unsigned char* ws = p.ws;
  const bf16_t* hb = (const bf16_t*)(ws + OFF_HB);
  const bf16_t* W = (const bf16_t*)(ws + OFF_WUP);
  const float* ss2 = (const float*)(ws + OFF_SS) + (size_t)(l * 2 + 1) * T;
  const float* cw = p.in[20] + (size_t)l * 3 * 5632;
  const float* cb = p.in[21] + (size_t)l * 5632;
  bf16_t* act = (bf16_t*)(ws + A_ACT);
  const int tid = threadIdx.x, lane = tid & 63, wid = __builtin_amdgcn_readfirstlane(tid >> 6), r = lane & 31, h = lane >> 5, wm = wid >> 2, wn = wid & 3;
  constexpr int NT = 5632 / 256, MT = (T + 253) / 254;
  float* stg = (float*)smem;
  TileIter tit(NT * MT);
  for (int t = tit.next(); t >= 0; t = tit.next()) {
    const int nt = t % NT, mt = t / NT;
    const int mbase = mt * 254 - 2, n0 = nt * 256;
    f32x16 acc[4][2];
    zero_acc(acc);
    float rsv[4];
#pragma unroll
    for (int tm = 0; tm < 4; ++tm) rsv[tm] = ss2[min(max(mbase + wm * 128 + tm * 32 + r, 0), T - 1)];
    gemm_main<2, 4, 4, 2>(hb, [&](int row) { return min(max(mbase + row, 0), T - 1) * D; }, 64, W, D, n0, D / 64, T - mbase, acc,
                          smem);
#pragma unroll
    for (int tm = 0; tm < 4; ++tm) rsv[tm] = rsqrtf(rsv[tm] * (1.f / 1024.f) + EPS);
#pragma unroll 1
    for (int hp = 0; hp < 2; ++hp) {
      const int chunk = tid & 15, grp = chunk >> 3, jl0 = (chunk & 7) * 4;
      const int jg0 = (n0 / 64 + hp * 2 + grp) * 32 + jl0;
      f32x4 wg[3], wv[3];
#pragma unroll
      for (int i = 0; i < 3; ++i) {
        wg[i] = *(const f32x4*)(cw + i * 5632 + jg0);
        wv[i] = *(const f32x4*)(cw + i * 5632 + DFF + jg0);
      }
      const f32x4 bg = *(const f32x4*)(cb + jg0), bv = *(const f32x4*)(cb + DFF + jg0);
      stage_half(acc, hp, wm, wn, r, h, rsv, stg);
      __syncthreads();
      {
        const float* sgc = stg + grp * 64 + jl0;
#pragma unroll 2
        for (int it = 0; it < 8; ++it) {
          const int row = 2 + (tid >> 4) + 32 * it;
          const int gm = mbase + row;
          if (row < 256 && gm < T) {
            const int b = gm / L, pos = gm - b * L;
            const float* s0 = sgc + row * 132;
            const f32x4 g0 = *(const f32x4*)(s0), v0 = *(const f32x4*)(s0 + 32);
            const f32x4 g1 = *(const f32x4*)(s0 - 132), v1 = *(const f32x4*)(s0 - 132 + 32);
            const f32x4 g2 = *(const f32x4*)(s0 - 264), v2 = *(const f32x4*)(s0 - 264 + 32);
            float o[4];
#pragma unroll
            for (int j = 0; j < 4; ++j) {
              float a = bg[j] + wg[2][j] * g0[j], c = bv[j] + wv[2][j] * v0[j];
              if (pos >= 1) { a += wg[1][j] * g1[j]; c += wv[1][j] * v1[j]; }
              if (pos >= 2) { a += wg[0][j] * g2[j]; c += wv[0][j] * v2[j]; }
              o[j] = a * __builtin_amdgcn_rcpf(1.f + __expf(-a)) * c;
            }
            *(uint2*)(act + (size_t)gm * DFF + jg0) = pk4(o[0], o[1], o[2], o[3]);
          }
        }
      }
      __syncthreads();
    }
  }
}

#define XB_TMO      128
#define XB_XCNT(j)  (256  + 64 * (j))
#define XB_XSUB(j)  (1280 + 64 * (j))
#define XB_XGEN(j)  (2304 + 64 * (j))
#define XB_TOP      3328
#define XB_TOPGEN   3392
#define XB_SPIN_CAP (1u << 22)
DI unsigned xb_ld(unsigned* p) { return __hip_atomic_load(p, __ATOMIC_RELAXED, __HIP_MEMORY_SCOPE_AGENT); }
DI unsigned xb_add(unsigned* p, unsigned v) { return __hip_atomic_fetch_add(p, v, __ATOMIC_RELAXED, __HIP_MEMORY_SCOPE_AGENT); }
DI unsigned xb_xcc_id() { return (unsigned)__builtin_amdgcn_s_getreg((3 << 11) | 20) & 0xFu; }
#define XB_SPIN(cond, bar) do { unsigned _sp = 0; while (cond) { __builtin_amdgcn_s_sleep(1); \
    if ((++_sp & 255u) == 0u) { if (xb_ld(&(bar)[XB_TMO])) break; if (_sp > XB_SPIN_CAP) { atomicAdd(&(bar)[XB_TMO], 1u); break; } } } } while (0)
DI void xcd_barrier_complete(unsigned* bar, unsigned x, unsigned& nloc, unsigned& nx) {
  const unsigned G = gridDim.x;
  unsigned sum, cnt, mine, sp = 0u;
  for (;;) {
    sum = 0u; cnt = 0u; mine = 0u;
#pragma unroll
    for (unsigned j = 0; j < 16; ++j) { const unsigned c = xb_ld(&bar[XB_XCNT(j)]); sum += c; cnt += (c > 0u) ? 1u : 0u; mine = (j == x) ? c : mine; }
    if (sum == G) break;
    __builtin_amdgcn_s_sleep(1);
    if ((++sp & 255u) == 0u) { if (xb_ld(&bar[XB_TMO])) break; if (sp > XB_SPIN_CAP) { atomicAdd(&bar[XB_TMO], 1u); break; } }
  }
  nloc = mine > 0u ? mine : 1u; nx = cnt > 0u ? cnt : 1u;
}
DI void xcd_barrier(unsigned* bar, unsigned x, volatile unsigned* st) {
  asm volatile("s_waitcnt vmcnt(0)" ::: "memory");
  __syncthreads();
  if (threadIdx.x == 0) {
    __builtin_amdgcn_s_waitcnt(0);
    unsigned nloc = st[0], nx = st[1];
    if (nloc == 0u) { xcd_barrier_complete(bar, x, nloc, nx); st[0] = nloc; st[1] = nx; }
    const unsigned old = xb_add(&bar[XB_XSUB(x)], 1u);
    const unsigned gen = old / nloc;
    if (old + 1u == (gen + 1u) * nloc) {
      __builtin_amdgcn_fence(__ATOMIC_RELEASE, "agent");
      asm volatile("s_waitcnt vmcnt(0)" ::: "memory");
      const unsigned og = xb_add(&bar[XB_TOP], 1u);
      const unsigned tg = og / nx;
      if (og + 1u == (tg + 1u) * nx) xb_add(&bar[XB_TOPGEN], 1u);
      else XB_SPIN(xb_ld(&bar[XB_TOPGEN]) == tg, bar);
      __builtin_amdgcn_fence(__ATOMIC_ACQUIRE, "agent");
      xb_add(&bar[XB_XGEN(x)], 1u);
      asm volatile("s_waitcnt vmcnt(0)" ::: "memory");
    } else {
      XB_SPIN(xb_ld(&bar[XB_XGEN(x)]) == gen, bar);
      __builtin_amdgcn_fence(__ATOMIC_ACQUIRE, "agent");
      asm volatile("s_waitcnt vmcnt(0)" ::: "memory");
    }
  }
  __syncthreads();
}

constexpr int NPHASES = 16;
__global__ void __launch_bounds__(NTHREADS, 2) mega_kernel(Params p) {
  __shared__ __attribute__((aligned(16))) char smem[SMEM_BYTES];
  cg::grid_group grid = cg::this_grid();
  unsigned char* ws = p.ws;
  int ph = 0;
  __shared__ __attribute__((aligned(16))) unsigned xb_st[4];
  unsigned* xbar = (unsigned*)(ws + OFF_XBAR);
  const unsigned xb_x = xb_xcc_id();
  if (threadIdx.x < 4) xb_st[threadIdx.x] = 0u;
#define RUN(body)                                   \
  {                                                 \
    if (ph >= p.ph_lo && ph < p.ph_hi) {            \
      body;                                         \
      if (ph + 1 < p.ph_hi) {                       \
        if (ph == 0) {                              \
          grid.sync();                              \
          if (threadIdx.x == 0) (void)xb_add(&xbar[XB_XCNT(xb_x)], 1u); \
        } else xcd_barrier(xbar, xb_x, xb_st);      \
      }                                             \
    }                                               \
    ++ph;                                           \
  }
  RUN(convert_layer(p, 0, smem); phase_init(p));
#define LAYER(l)                                                                                          \
  RUN(phase_inproj(p, l, smem));                                                                          \
  RUN(phase_mla_up(p, l, smem));                                                                          \
  RUN(phase_attn(p, l, smem));                                                                            \
  RUN(phase_merge(p, l, smem));                                                                           \
  RUN(phase_resid(p, (const bf16_t*)(ws + A_MERGED), 1024, (const bf16_t*)(ws + OFF_WO),                  \
                  (float*)(ws + OFF_SS) + (size_t)(l * 2 + 1) * T, false, smem));                         \
  RUN(phase_up(p, l, smem));                                                                              \
  RUN(phase_resid(p, (const bf16_t*)(ws + A_ACT), DFF, (const bf16_t*)(ws + OFF_WDN),                     \
                  (float*)(ws + OFF_SS) + (size_t)((l + 1) * 2) * T, l == 1, smem));
  LAYER(0)
  RUN(convert_layer(p, 1, smem));
  LAYER(1)
#undef LAYER
#undef RUN
}

extern "C" void kernel_launch(void* const* d_in, const int* in_sizes, int n_in, void* d_out, int out_size, void* d_ws,
                              size_t ws_size, hipStream_t stream) {
  static int grid_blocks = 0;
  if (!grid_blocks) {
    int dev = 0, cus = 0, per_cu = 0;
    hipGetDevice(&dev);
    hipDeviceGetAttribute(&cus, hipDeviceAttributeMultiprocessorCount, dev);
    hipOccupancyMaxActiveBlocksPerMultiprocessor(&per_cu, mega_kernel, NTHREADS, 0);
    if (per_cu < 1) per_cu = 1;
    if (per_cu > 1) per_cu = 1;
    grid_blocks = cus * per_cu;
    if (ws_size < A_END) fprintf(stderr, "workspace too small: %zu < %zu\n", ws_size, (size_t)A_END);
  }
  Params p{};
  for (int i = 0; i < 23; ++i) p.in[i] = (const float*)d_in[i];
  p.out = (float*)d_out;
  p.ws = (unsigned char*)d_ws;
  p.ph_lo = 0;
  p.ph_hi = NPHASES;
  void* args[] = {&p};
  hipError_t e = hipLaunchCooperativeKernel((void*)mega_kernel, dim3(grid_blocks), dim3(NTHREADS), args, 0, stream);
  if (e != hipSuccess) fprintf(stderr, "cooperative launch failed: %s (grid %d)\n", hipGetErrorString(e), grid_blocks);
}
```

```cpp
#include <hip/hip_runtime.h>
#include <hip/hip_cooperative_groups.h>
#include <cstdio>
namespace cg = cooperative_groups;

#define DI __device__ __forceinline__
typedef __attribute__((ext_vector_type(8))) short bf16x8;
typedef __attribute__((ext_vector_type(4))) short s16x4;
typedef __attribute__((ext_vector_type(16))) float f32x16;
typedef __attribute__((ext_vector_type(4))) float f32x4;
typedef __attribute__((ext_vector_type(2))) float f32x2;
typedef __attribute__((ext_vector_type(2))) __bf16 bf16x2_t;
typedef unsigned short bf16_t;

constexpr int D = 1024, NBATCH = 4, SEQ = 4096, L = 4112, T = NBATCH * L  , LP = 4224;
constexpr int DFF = 2816;
constexpr int NIN = 2816;
constexpr float EPS = 1e-6f;
constexpr float LOG2E = 1.4426950408889634f;
constexpr int NTHREADS = 512;
constexpr int SMEM_BYTES = 147456 + 64;

constexpr size_t OFF_WIN = 0;
constexpr size_t OFF_WG = OFF_WIN + (size_t)NIN * 1024 * 2;
constexpr size_t OFF_WQUP = OFF_WG + (size_t)3072 * 1024 * 2;
constexpr size_t OFF_WKVUP = OFF_WQUP + (size_t)768 * 256 * 2;
constexpr size_t OFF_WBR = OFF_WKVUP + (size_t)1024 * 128 * 2;
constexpr size_t OFF_WO = OFF_WBR + (size_t)3 * 1024 * 512 * 2;
constexpr size_t OFF_WUP = OFF_WO + (size_t)1024 * 1024 * 2;
constexpr size_t OFF_WDN = OFF_WUP + (size_t)5632 * 1024 * 2;
constexpr size_t OFF_HB = OFF_WDN + (size_t)1024 * 2816 * 2;
constexpr size_t OFF_SS = OFF_HB + (size_t)T * 1024 * 2;
constexpr size_t OFF_SSKR = OFF_SS + (size_t)8 * T * 4;
constexpr size_t OFF_ROPE = OFF_SSKR + (size_t)T * 4;
constexpr size_t OFF_LF = OFF_ROPE + (size_t)L * 32 * 4;
constexpr size_t OFF_CDEC = OFF_LF + (size_t)T * 8 * 4;
constexpr size_t OFF_HMETA = OFF_CDEC + (size_t)32 * LP * 4;
constexpr size_t OFF_KR = OFF_HMETA + (size_t)64 * 1024 * 4;
constexpr size_t OFF_CTR = OFF_KR + (size_t)T * 32 * 2;
constexpr size_t OFF_XBAR = OFF_CTR + 256;
constexpr size_t OFF_ARENA = OFF_XBAR + 3456 * 4 + 128;
constexpr size_t SZ64 = (size_t)NBATCH * 8 * LP * 64 * 2;
constexpr size_t SZ96 = (size_t)NBATCH * 8 * LP * 96 * 2;
constexpr size_t SZKS = (size_t)NBATCH * 2 * LP * 64 * 2;
constexpr size_t A_QF = OFF_ARENA;
constexpr size_t A_QS = A_QF + SZ64;
constexpr size_t A_QM = A_QS + SZ64;
constexpr size_t A_KF = A_QM + SZ96;
constexpr size_t A_VF = A_KF + SZ64;
constexpr size_t A_KS = A_VF + SZ64;
constexpr size_t A_VS = A_KS + SZKS;
constexpr size_t A_KM = A_VS + SZKS;
constexpr size_t A_VM = A_KM + SZ96;
constexpr size_t A_CQ = A_VM + SZ64;
constexpr size_t A_CKV = A_CQ + (size_t)T * 256 * 2;
constexpr size_t A_END = A_CKV + (size_t)T * 128 * 2;
constexpr size_t A_MERGED = A_KF;
constexpr size_t A_ACT = OFF_ARENA;
static_assert((size_t)T * 1024 * 2 <= 2 * SZ64, "merged alias");
static_assert(A_END <= (size_t)256 * 1024 * 1024, "workspace");
static_assert(A_ACT + (size_t)T * 2816 * 2 <= A_END, "act alias");

struct Params {
  const float* in[23];
  float* out;
  unsigned char* ws;
  int ph_lo, ph_hi;
};

__device__ const double ROPE_FREQ[16] = {1.0, 0.5623413251903491, 0.31622776601683794, 0.1778279410038923, 0.1, 0.05623413251903491,
  0.03162277660168379, 0.01778279410038923, 0.01, 0.005623413251903491, 0.0031622776601683794, 0.0017782794100389228, 0.001,
  0.0005623413251903491, 0.00031622776601683794, 0.00017782794100389227};

DI unsigned pk2(float a, float b) {
  f32x2 v = {a, b};
  bf16x2_t r = __builtin_convertvector(v, bf16x2_t);
  return __builtin_bit_cast(unsigned, r);
}
DI uint2 pk4(float a, float b, float c, float d) { return make_uint2(pk2(a, b), pk2(c, d)); }
DI bf16_t f2bf(float v) { return (bf16_t)(pk2(v, 0.f) & 0xffffu); }
DI float bf2f(bf16_t v) { return __uint_as_float(((unsigned)v) << 16); }
DI float xor32(float v) {
  const auto r = __builtin_amdgcn_permlane32_swap(__float_as_uint(v), __float_as_uint(v), false, false);
  return __uint_as_float(r[0]) + __uint_as_float(r[1]);
}
DI float max32(float v) {
  const auto r = __builtin_amdgcn_permlane32_swap(__float_as_uint(v), __float_as_uint(v), false, false);
  return fmaxf(__uint_as_float(r[0]), __uint_as_float(r[1]));
}
DI float fexp2(float x) { return __builtin_amdgcn_exp2f(x); }
DI f32x16 mfma32(bf16x8 a, bf16x8 b, f32x16 c) { return __builtin_amdgcn_mfma_f32_32x32x16_bf16(a, b, c, 0, 0, 0); }
DI float* hrow(const Params& p, int b, int pos) {
  return pos >= 16 ? p.out + ((size_t)(b * SEQ + pos - 16)) * D : (float*)(p.ws + OFF_HMETA) + (size_t)(b * 16 + pos) * D;
}

template <int WM, int WN, int TM, int TN, bool LOWREG = false, class RowOff>
DI void gemm_main(const bf16_t* __restrict__ A, RowOff rowoff, int a_kstride, const bf16_t* __restrict__ Bt, int ldb, int n0,
                  int nk, int mvalid, f32x16 (&acc)[TM][TN], char* smem) {
  static_assert(WM * WN == 8, "8 waves");
  constexpr int BM = WM * TM * 32, BN = WN * TN * 32;
  constexpr int NA = (BM + 63) / 64, NB = (BN + 63) / 64;
  constexpr int STAGE = (BM + BN) * 144;
  static_assert(2 * STAGE <= 147456, "smem");
  const int tid = threadIdx.x, lane = tid & 63, wid = __builtin_amdgcn_readfirstlane(tid >> 6);
  const int r = lane & 31, h = lane >> 5;
  const int wm = wid / WN, wn = wid % WN;
  const int lrow = tid >> 3, c8 = tid & 7;
  int aoff[NA];
#pragma unroll
  for (int i = 0; i < NA; ++i) aoff[i] = rowoff(min(lrow + 64 * i, BM - 1)) + c8 * 8;
  const bf16_t* bptr = Bt + (size_t)(n0 + lrow) * ldb + c8 * 8;
  bf16x8 ra0[NA], rb0[NB];
  auto gload = [&](int kt, bf16x8 (&ra)[NA], bf16x8 (&rb)[NB]) {
#pragma unroll
    for (int i = 0; i < NA; ++i) ra[i] = *(const bf16x8*)(A + aoff[i] + (size_t)kt * a_kstride);
#pragma unroll
    for (int i = 0; i < NB; ++i)
      if (BN % 64 == 0 || lrow + 64 * i < BN) rb[i] = *(const bf16x8*)(bptr + (size_t)(64 * i) * ldb + kt * 64);
  };
  auto sstore = [&](int s, bf16x8 (&ra)[NA], bf16x8 (&rb)[NB]) {
    char* as = smem + s * STAGE;
    char* bs = as + BM * 144;
#pragma unroll
    for (int i = 0; i < NA; ++i)
      if (BM % 64 == 0 || lrow + 64 * i < BM) *(bf16x8*)(as + (lrow + 64 * i) * 144 + c8 * 16) = ra[i];
#pragma unroll
    for (int i = 0; i < NB; ++i)
      if (BN % 64 == 0 || lrow + 64 * i < BN) *(bf16x8*)(bs + (lrow + 64 * i) * 144 + c8 * 16) = rb[i];
  };
  const int ntm = min(TM, max(0, (mvalid - wm * TM * 32 + 31) >> 5));
  auto half_a = [&](int kt) {
    if (kt + 1 < nk) {
      char* as = smem + ((kt + 1) & 1) * STAGE;
#pragma unroll
      for (int i = 0; i < NA; ++i)
        if (BM % 64 == 0 || lrow + 64 * i < BM) *(bf16x8*)(as + (lrow + 64 * i) * 144 + c8 * 16) = ra0[i];
    }
    if (kt + 2 < nk) {
#pragma unroll
      for (int i = 0; i < NA; ++i) ra0[i] = *(const bf16x8*)(A + aoff[i] + (size_t)(kt + 2) * a_kstride);
    }
  };
  auto half_b = [&](int kt) {
    if (kt + 1 < nk) {
      char* bs = smem + ((kt + 1) & 1) * STAGE + BM * 144;
#pragma unroll
      for (int i = 0; i < NB; ++i)
        if (BN % 64 == 0 || lrow + 64 * i < BN) *(bf16x8*)(bs + (lrow + 64 * i) * 144 + c8 * 16) = rb0[i];
    }
    if (kt + 2 < nk) {
#pragma unroll
      for (int i = 0; i < NB; ++i)
        if (BN % 64 == 0 || lrow + 64 * i < BN) rb0[i] = *(const bf16x8*)(bptr + (size_t)(64 * i) * ldb + (kt + 2) * 64);
    }
  };
  auto mm = [&](const char* as, const char* bs, int ks) {
    bf16x8 af[TM], bf[TN];
#pragma unroll
    for (int tn = 0; tn < TN; ++tn) bf[tn] = *(const bf16x8*)(bs + tn * 32 * 144 + ks * 32);
#pragma unroll
    for (int tm = 0; tm < TM; ++tm) af[tm] = *(const bf16x8*)(as + tm * 32 * 144 + ks * 32);
#pragma unroll
    for (int tm = 0; tm < TM; ++tm)
#pragma unroll
      for (int tn = 0; tn < TN; ++tn) acc[tm][tn] = mfma32(bf[tn], af[tm], acc[tm][tn]);
  };
  gload(0, ra0, rb0);
  sstore(0, ra0, rb0);
  if (nk > 1) gload(1, ra0, rb0);
#pragma unroll 1
  for (int kt = 0; kt < nk; ++kt) {
    __syncthreads();
    const char* as = smem + (kt & 1) * STAGE + (wm * TM * 32 + r) * 144 + h * 16;
    const char* bs = smem + (kt & 1) * STAGE + BM * 144 + (wn * TN * 32 + r) * 144 + h * 16;
    __builtin_amdgcn_s_setprio(1);
    mm(as, bs, 0);
    __builtin_amdgcn_s_setprio(0);
    __builtin_amdgcn_sched_barrier(0);
    half_a(kt);
    __builtin_amdgcn_sched_barrier(0);
    __builtin_amdgcn_s_setprio(1);
    mm(as, bs, 1);
    mm(as, bs, 2);
    __builtin_amdgcn_s_setprio(0);
    __builtin_amdgcn_sched_barrier(0);
    half_b(kt);
    __builtin_amdgcn_sched_barrier(0);
    __builtin_amdgcn_s_setprio(1);
    mm(as, bs, 3);
    __builtin_amdgcn_s_setprio(0);
  }
  __syncthreads();
}


template <class RowOff>
DI void gemm_rem(const bf16_t* __restrict__ A, RowOff rowoff, int a_kstride, const bf16_t* __restrict__ Bt, int ldb, int n0,
                 int nk, f32x16& acc, char* smem) {
  constexpr int PITCH = 272, STAGE = (64 + 128) * PITCH;
  const int nk2 = nk >> 1;
  const int tid = threadIdx.x, lane = tid & 63, wid = __builtin_amdgcn_readfirstlane(tid >> 6);
  const int r = lane & 31, h = lane >> 5;
  const int wm = wid >> 2, wn = wid & 3;
  const int lrow = tid >> 3, c8 = tid & 7;
  const bf16_t* ap = A + rowoff(lrow) + c8 * 8;
  const bf16_t* bp = Bt + (size_t)(n0 + lrow) * ldb + c8 * 8;
  bf16x8 ra[2][2], rb0[2][2], rb1[2][2];
  auto gload = [&](int k2, int s) {
#pragma unroll
    for (int hf = 0; hf < 2; ++hf) {
      const int kt = 2 * k2 + hf;
      ra[s][hf] = *(const bf16x8*)(ap + (size_t)kt * a_kstride);
      rb0[s][hf] = *(const bf16x8*)(bp + kt * 64);
      rb1[s][hf] = *(const bf16x8*)(bp + (size_t)64 * ldb + kt * 64);
    }
  };
  auto sstore = [&](int st, int s) {
    char* as = smem + st * STAGE;
#pragma unroll
    for (int hf = 0; hf < 2; ++hf) {
      *(bf16x8*)(as + lrow * PITCH + hf * 128 + c8 * 16) = ra[s][hf];
      *(bf16x8*)(as + (64 + lrow) * PITCH + hf * 128 + c8 * 16) = rb0[s][hf];
      *(bf16x8*)(as + (128 + lrow) * PITCH + hf * 128 + c8 * 16) = rb1[s][hf];
    }
  };
  auto compute = [&](int k2) {
    const char* as = smem + (k2 & 1) * STAGE + (wm * 32 + r) * PITCH + h * 16;
    const char* bs = smem + (k2 & 1) * STAGE + (64 + wn * 32 + r) * PITCH + h * 16;
#pragma unroll
    for (int ks = 0; ks < 8; ++ks) {
      const bf16x8 bf = *(const bf16x8*)(bs + ks * 32);
      const bf16x8 af = *(const bf16x8*)(as + ks * 32);
      acc = mfma32(bf, af, acc);
    }
  };
  gload(0, 0);
  gload(1, 1);
  sstore(0, 0);
  __syncthreads();
#pragma unroll 1
  for (int k2 = 0; k2 < nk2; k2 += 2) {
    if (k2 + 2 < nk2) gload(k2 + 2, 0);
    __builtin_amdgcn_sched_barrier(0);
    compute(k2);
    __builtin_amdgcn_sched_barrier(0);
    sstore(1, 1);
    __syncthreads();
    if (k2 + 3 < nk2) gload(k2 + 3, 1);
    __builtin_amdgcn_sched_barrier(0);
    compute(k2 + 1);
    __builtin_amdgcn_sched_barrier(0);
    if (k2 + 2 < nk2) sstore(0, 0);
    __syncthreads();
  }
}

template <int TM, int TN>
DI void zero_acc(f32x16 (&acc)[TM][TN]) {
#pragma unroll
  for (int a = 0; a < TM; ++a)
#pragma unroll
    for (int b = 0; b < TN; ++b)
#pragma unroll
      for (int i = 0; i < 16; ++i) acc[a][b][i] = 0.f;
}

DI int inproj_src_col(int n) {
  if (n < 1536) return n;
  if (n < 2048) return 1960 + (n - 1536);
  if (n < 2176) return 2472 + (n - 2048);
  if (n < 2304) return 2600 + (n - 2176);
  if (n < 2560) return 1544 + (n - 2304);
  if (n < 2688) return 1800 + (n - 2560);
  if (n < 2720) return 1928 + (n - 2688);
  if (n < 2728) return 1536 + (n - 2720);
  return -1;
}
DI void conv_mat(const float* __restrict__ src, int ldsrc, int K, int Np, const float* __restrict__ gain, int map,
                 bf16_t* __restrict__ dst, int& base, char* smem) {
  float* tl = (float*)smem;
  const int tk = K / 64, tn = Np / 64, nt = tk * tn;
  const int G = gridDim.x;
  int start = (int)(((long)blockIdx.x - base) % G);
  if (start < 0) start += G;
  const int tid = threadIdx.x;
  const int lk = tid >> 4, n4 = (tid & 15) * 4;
  const int sn = tid >> 3, k8 = (tid & 7) * 8;
  auto issue = [&](int t, f32x4& a, f32x4& b) {
    const int k0 = (t % tk) * 64, n0 = (t / tk) * 64;
    const int nn = n0 + n4;
    int sc;
    if (map == 0) sc = nn;
    else if (map == 1) sc = inproj_src_col(nn);
    else if (map == 2) sc = 2728 + nn;
    else sc = (nn >> 6) * 32 + (nn & 31) + ((nn & 32) ? DFF : 0);
    a = f32x4{0.f, 0.f, 0.f, 0.f};
    b = a;
    if (sc >= 0) {
      a = *(const f32x4*)(src + (size_t)(k0 + lk) * ldsrc + sc);
      b = *(const f32x4*)(src + (size_t)(k0 + lk + 32) * ldsrc + sc);
    }
    if (gain) {
      const float g0 = gain[k0 + lk], g1 = gain[k0 + lk + 32];
#pragma unroll
      for (int j = 0; j < 4; ++j) { a[j] *= g0; b[j] *= g1; }
    }
  };
  f32x4 ca, cb2;
  int t = start;
  if (t < nt) issue(t, ca, cb2);
  while (t < nt) {
#pragma unroll
    for (int j = 0; j < 4; ++j) {
      tl[(n4 + j) * 65 + lk] = ca[j];
      tl[(n4 + j) * 65 + lk + 32] = cb2[j];
    }
    __syncthreads();
    const int tnx = t + G;
    f32x4 na, nb;
    if (tnx < nt) issue(tnx, na, nb);
    {
      const int k0 = (t % tk) * 64, n0 = (t / tk) * 64;
      float v[8];
#pragma unroll
      for (int j = 0; j < 8; ++j) v[j] = tl[sn * 65 + k8 + j];
      *(uint4*)(dst + (size_t)(n0 + sn) * K + k0 + k8) = make_uint4(pk2(v[0], v[1]), pk2(v[2], v[3]), pk2(v[4], v[5]), pk2(v[6], v[7]));
    }
    __syncthreads();
    ca = na; cb2 = nb;
    t = tnx;
  }
  base += nt;
}
DI void convert_layer(const Params& p, int l, char* smem) {
  unsigned char* ws = p.ws;
  int base = 0;
  const float* w_in = p.in[3] + (size_t)l * 1024 * 5800;
  conv_mat(w_in, 5800, 1024, NIN, p.in[2] + l * 1024, 1, (bf16_t*)(ws + OFF_WIN), base, smem);
  conv_mat(w_in, 5800, 1024, 3072, p.in[2] + l * 1024, 2, (bf16_t*)(ws + OFF_WG), base, smem);
  conv_mat(p.in[8] + (size_t)l * 256 * 768, 768, 256, 768, p.in[7] + l * 256, 0, (bf16_t*)(ws + OFF_WQUP), base, smem);
  conv_mat(p.in[10] + (size_t)l * 128 * 1024, 1024, 128, 1024, p.in[9] + l * 128, 0, (bf16_t*)(ws + OFF_WKVUP), base, smem);
  for (int n = 0; n < 3; ++n)
    conv_mat(p.in[16] + ((size_t)l * 3 + n) * 512 * 1024, 1024, 512, 1024, nullptr, 0,
             (bf16_t*)(ws + OFF_WBR) + (size_t)n * 1024 * 512, base, smem);
  conv_mat(p.in[17] + (size_t)l * 1024 * 1024, 1024, 1024, 1024, nullptr, 0, (bf16_t*)(ws + OFF_WO), base, smem);
  conv_mat(p.in[19] + (size_t)l * 1024 * 5632, 5632, 1024, 5632, p.in[18] + l * 1024, 3, (bf16_t*)(ws + OFF_WUP), base, smem);
  conv_mat(p.in[22] + (size_t)l * 2816 * 1024, 1024, 2816, 1024, nullptr, 0, (bf16_t*)(ws + OFF_WDN), base, smem);
}

DI void phase_init(const Params& p) {
  unsigned char* ws = p.ws;
  const int tid = threadIdx.x, lane = tid & 63, wid = tid >> 6;
  const int gw = blockIdx.x * 8 + wid, nw = gridDim.x * 8;
  const int gt = blockIdx.x * NTHREADS + tid, ntot = gridDim.x * NTHREADS;
  float* ss = (float*)(ws + OFF_SS);
  bf16_t* hb = (bf16_t*)(ws + OFF_HB);
  for (int m = gw; m < T; m += nw) {
    int b = m / L, pos = m - b * L;
    const float* src = pos < 16 ? p.in[1] + pos * D : p.in[0] + ((size_t)(b * SEQ + pos - 16)) * D;
    float* dsth = hrow(p, b, pos);
    float s = 0.f;
#pragma unroll
    for (int i = 0; i < 4; ++i) {
      int c = (i * 64 + lane) * 4;
      f32x4 v = *(const f32x4*)(src + c);
      *(f32x4*)(dsth + c) = v;
      *(uint2*)(hb + (size_t)m * D + c) = pk4(v[0], v[1], v[2], v[3]);
      s += v[0] * v[0] + v[1] * v[1] + v[2] * v[2] + v[3] * v[3];
    }
#pragma unroll
    for (int o = 32; o >= 1; o >>= 1) s += __shfl_xor(s, o);
    if (lane == 0) ss[m] = s;
  }
  for (int i = gt; i < 7 * T; i += ntot) ss[T + i] = 0.f;
  if (gt < 64) ((unsigned*)(ws + OFF_CTR))[gt] = 0u;
  for (int i = gt; i < 3456; i += ntot) ((unsigned*)(ws + OFF_XBAR))[i] = 0u;
  float* rc = (float*)(ws + OFF_ROPE);
  float* rsn = rc + L * 16;
  for (int i = gt; i < L * 16; i += ntot) {
    int pos = i >> 4, c = i & 15;
    double ang = (double)pos * ROPE_FREQ[c];
    double k = rint(ang * 0.15915494309189535);
    double x = ang - k * 6.283185307179586476925;
    double x2 = x * x;
    double sn = 0.0, cs = 0.0;
    double ts = x, tc = 1.0;
#pragma unroll 1
    for (int n = 0; n < 15; ++n) {
      sn += ts;
      cs += tc;
      tc = -tc * x2 / (double)((2 * n + 1) * (2 * n + 2));
      ts = -ts * x2 / (double)((2 * n + 2) * (2 * n + 3));
    }
    rc[i] = (float)cs;
    rsn[i] = (float)sn;
  }
}


struct TileIter {
  int xcd, loc, nloc, per, nt, i;
  bool xmode;
  DI TileIter(int ntiles) {
    nt = ntiles;
    xmode = (gridDim.x & 7) == 0;
    if (xmode) { xcd = blockIdx.x & 7; loc = blockIdx.x >> 3; nloc = gridDim.x >> 3; per = (ntiles + 7) >> 3; i = loc; }
    else { xcd = 0; loc = blockIdx.x; nloc = gridDim.x; per = ntiles; i = loc; }
  }
  DI int next() {
    if (i >= per) return -1;
    const int t = xcd * per + i;
    i += nloc;
    return t < nt ? t : -1;
  }
};

DI void phase_inproj(const Params& p, int l, char* smem) {
  unsigned char* ws = p.ws;
  const bf16_t* hb = (const bf16_t*)(ws + OFF_HB);
  const bf16_t* W = (const bf16_t*)(ws + OFF_WIN);
  const float* ss1 = (const float*)(ws + OFF_SS) + (size_t)(l * 2) * T;
  float* ss_cq = (float*)(ws + OFF_SS) + (size_t)(4 + l) * T;
  float* ss_ckv = (float*)(ws + OFF_SS) + (size_t)(6 + l) * T;
  float* ss_kr = (float*)(ws + OFF_SSKR);
  const int lane = threadIdx.x & 63, wid = __builtin_amdgcn_readfirstlane(threadIdx.x >> 6), r = lane & 31, h = lane >> 5, wm = wid >> 2, wn = wid & 3;
  constexpr int NT = NIN / 256, MT = (T + 255) / 256;
  TileIter tit(NT * MT);
  for (int t = tit.next(); t >= 0; t = tit.next()) {
    const int nt = t % NT, mt = t / NT;
    const int m0 = mt * 256, n0 = nt * 256;
    f32x16 acc[4][2];
    zero_acc(acc);
    gemm_main<2, 4, 4, 2>(hb, [&](int row) { return min(m0 + row, T - 1) * D; }, 64, W, D, n0, D / 64, T - m0, acc, smem);
    const int n0w = n0 + wn * 64;
#pragma unroll
    for (int tm = 0; tm < 4; ++tm) {
      const int m = m0 + wm * 128 + tm * 32 + r;
      const bool valid = m < T;
      const int mm = valid ? m : T - 1;
      const int b = mm / L, pos = mm - b * L;
      const float rs = rsqrtf(ss1[mm] * (1.f / 1024.f) + EPS);
#pragma unroll
      for (int tn = 0; tn < 2; ++tn)
#pragma unroll
        for (int i = 0; i < 16; ++i) acc[tm][tn][i] *= rs;
      float ssq = 0.f;
#pragma unroll
      for (int tn = 0; tn < 2; ++tn)
#pragma unroll
        for (int i = 0; i < 16; ++i) ssq += acc[tm][tn][i] * acc[tm][tn][i];
      if (n0w < 2304) {
        int kind, head, nh;
        const float* gain = nullptr;
        float scale = 1.f;
        bf16_t* dst;
        if (n0w < 512) { kind = 0; head = n0w >> 6; nh = 8; gain = p.in[5] + l * 64; scale = 0.125f * LOG2E; dst = (bf16_t*)(ws + A_QF); }
        else if (n0w < 1024) { kind = 0; head = (n0w - 512) >> 6; nh = 8; gain = p.in[6] + l * 64; dst = (bf16_t*)(ws + A_KF); }
        else if (n0w < 1536) { kind = 1; head = (n0w - 1024) >> 6; nh = 8; dst = (bf16_t*)(ws + A_VF); }
        else if (n0w < 2048) { kind = 0; head = (n0w - 1536) >> 6; nh = 8; gain = p.in[13] + l * 64; scale = 0.125f * LOG2E; dst = (bf16_t*)(ws + A_QS); }
        else if (n0w < 2176) { kind = 0; head = (n0w - 2048) >> 6; nh = 2; gain = p.in[14] + l * 64; dst = (bf16_t*)(ws + A_KS); }
        else { kind = 1; head = (n0w - 2176) >> 6; nh = 2; dst = (bf16_t*)(ws + A_VS); }
        if (kind == 0) {
          const float tot = xor32(ssq);
          const float rr = rsqrtf(tot * (1.f / 64.f) + EPS) * scale;
          bf16_t* drow = dst + ((size_t)(b * nh + head) * LP + pos) * 64;
#pragma unroll
          for (int tn = 0; tn < 2; ++tn)
#pragma unroll
            for (int g4 = 0; g4 < 4; ++g4) {
              const int d = tn * 32 + 8 * g4 + 4 * h;
              const f32x4 gv = *(const f32x4*)(gain + d);
              uint2 o = pk4(acc[tm][tn][4 * g4] * rr * gv[0], acc[tm][tn][4 * g4 + 1] * rr * gv[1],
                            acc[tm][tn][4 * g4 + 2] * rr * gv[2], acc[tm][tn][4 * g4 + 3] * rr * gv[3]);
              if (valid) *(uint2*)(drow + d) = o;
            }
        } else {
          bf16_t* dcol = dst + ((size_t)(b * nh + head) * 64) * LP + pos;
          if (valid) {
#pragma unroll
            for (int tn = 0; tn < 2; ++tn)
#pragma unroll
              for (int i = 0; i < 16; ++i) {
                const int d = tn * 32 + (i & 3) + 8 * (i >> 2) + 4 * h;
                dcol[(size_t)d * LP] = f2bf(acc[tm][tn][i]);
              }
          }
        }
      } else if (n0w < 2688) {
        bf16_t* dst;
        float* ssd;
        int ld, c0;
        if (n0w < 2560) { dst = (bf16_t*)(ws + A_CQ); ssd = ss_cq; ld = 256; c0 = n0w - 2304; }
        else { dst = (bf16_t*)(ws + A_CKV); ssd = ss_ckv; ld = 128; c0 = n0w - 2560; }
        const float tot = xor32(ssq);
        if (valid) {
#pragma unroll
          for (int tn = 0; tn < 2; ++tn)
#pragma unroll
            for (int g4 = 0; g4 < 4; ++g4) {
              const int d = c0 + tn * 32 + 8 * g4 + 4 * h;
              *(uint2*)(dst + (size_t)m * ld + d) =
                  pk4(acc[tm][tn][4 * g4], acc[tm][tn][4 * g4 + 1], acc[tm][tn][4 * g4 + 2], acc[tm][tn][4 * g4 + 3]);
            }
          if (h == 0) atomicAdd(ssd + m, tot);
        }
      } else if (n0w == 2688) {
        float s0 = 0.f;
#pragma unroll
        for (int i = 0; i < 16; ++i) s0 += acc[tm][0][i] * acc[tm][0][i];
        s0 = xor32(s0);
        if (valid) {
          bf16_t* kr = (bf16_t*)(ws + OFF_KR) + (size_t)m * 32;
#pragma unroll
          for (int g4 = 0; g4 < 4; ++g4)
            *(uint2*)(kr + 8 * g4 + 4 * h) =
                pk4(acc[tm][0][4 * g4], acc[tm][0][4 * g4 + 1], acc[tm][0][4 * g4 + 2], acc[tm][0][4 * g4 + 3]);
          if (h == 0) ss_kr[m] = s0;
          float* lf = (float*)(ws + OFF_LF) + (size_t)m * 8 + 4 * h;
          f32x4 o;
#pragma unroll
          for (int j = 0; j < 4; ++j) {
            float x = acc[tm][1][j] + p.in[4][l * 8 + 4 * h + j];
            o[j] = fminf(x, 0.f) - log1pf(__expf(-fabsf(x)));
          }
          *(f32x4*)lf = o;
        }
      }
    }
  }
}

DI void phase_mla_up(const Params& p, int l, char* smem) {
  unsigned char* ws = p.ws;
  const int lane = threadIdx.x & 63, wid = __builtin_amdgcn_readfirstlane(threadIdx.x >> 6), r = lane & 31, h = lane >> 5;
  const float* rope_c = (const float*)(ws + OFF_ROPE);
  const float* rope_s = rope_c + L * 16;
  constexpr int MT = 64;
  {
    const bf16_t* A = (const bf16_t*)(ws + A_CQ);
    const bf16_t* W = (const bf16_t*)(ws + OFF_WQUP);
    const float* ssc = (const float*)(ws + OFF_SS) + (size_t)(4 + l) * T;
    const float* g = p.in[11] + l * 96;
    bf16_t* Qm = (bf16_t*)(ws + A_QM);
    const float qscale = 0.10206207261596575f * LOG2E;
    auto epi = [&](f32x16 (&acc)[1][3], int m, int head) {
      const int b = m / L, pos = m - b * L;
      const float rs = rsqrtf(ssc[m] * (1.f / 256.f) + EPS);
      float ssq = 0.f;
#pragma unroll
      for (int tn = 0; tn < 3; ++tn)
#pragma unroll
        for (int i = 0; i < 16; ++i) { acc[0][tn][i] *= rs; ssq += acc[0][tn][i] * acc[0][tn][i]; }
      ssq = xor32(ssq);
      const float rr = rsqrtf(ssq * (1.f / 96.f) + EPS);
      bf16_t* drow = Qm + ((size_t)(b * 8 + head) * LP + pos) * 96;
#pragma unroll
      for (int tn = 0; tn < 2; ++tn)
#pragma unroll
        for (int g4 = 0; g4 < 4; ++g4) {
          const int d = tn * 32 + 8 * g4 + 4 * h;
          const f32x4 gv = *(const f32x4*)(g + d);
          *(uint2*)(drow + d) = pk4(acc[0][tn][4 * g4] * rr * gv[0] * qscale, acc[0][tn][4 * g4 + 1] * rr * gv[1] * qscale,
                                    acc[0][tn][4 * g4 + 2] * rr * gv[2] * qscale, acc[0][tn][4 * g4 + 3] * rr * gv[3] * qscale);
        }
#pragma unroll
      for (int g4 = 0; g4 < 2; ++g4) {
        const int c = 8 * g4 + 4 * h;
        const f32x4 g1 = *(const f32x4*)(g + 64 + c);
        const f32x4 g2 = *(const f32x4*)(g + 80 + c);
        const f32x4 cs = *(const f32x4*)(rope_c + pos * 16 + c);
        const f32x4 sn = *(const f32x4*)(rope_s + pos * 16 + c);
        float o1[4], o2[4];
#pragma unroll
        for (int j = 0; j < 4; ++j) {
          float x1 = acc[0][2][4 * g4 + j] * rr * g1[j];
          float x2 = acc[0][2][4 * g4 + 8 + j] * rr * g2[j];
          o1[j] = (x1 * cs[j] - x2 * sn[j]) * qscale;
          o2[j] = (x2 * cs[j] + x1 * sn[j]) * qscale;
        }
        *(uint2*)(drow + 64 + c) = pk4(o1[0], o1[1], o1[2], o1[3]);
        *(uint2*)(drow + 80 + c) = pk4(o2[0], o2[1], o2[2], o2[3]);
      }
    };
    for (int t = blockIdx.x; t < 8 * MT; t += gridDim.x) {
      const int head = t % 8, mt = t / 8;
      const int m0 = mt * 256;
      f32x16 acc[1][3];
      zero_acc(acc);
      gemm_main<8, 1, 1, 3>(A, [&](int row) { return (m0 + row) * 256; }, 64, W, 256, head * 96, 4, 256, acc, smem);
      epi(acc, m0 + wid * 32 + r, head);
    }
    for (int nt = (int)blockIdx.x - 8; nt >= 0 && nt < 2; nt += gridDim.x) {
      const int wm = wid >> 2, wn = wid & 3;
      f32x16 acc[1][3];
      zero_acc(acc);
      gemm_main<2, 4, 1, 3>(A, [&](int row) { return min(16384 + row, T - 1) * 256; }, 64, W, 256, nt * 384, 4, 64, acc, smem);
      epi(acc, 16384 + wm * 32 + r, nt * 4 + wn);
    }
  }
  {
    const bf16_t* A = (const bf16_t*)(ws + A_CKV);
    const bf16_t* W = (const bf16_t*)(ws + OFF_WKVUP);
    const float* ssc = (const float*)(ws + OFF_SS) + (size_t)(6 + l) * T;
    const float* ss_kr = (const float*)(ws + OFF_SSKR);
    const bf16_t* krp = (const bf16_t*)(ws + OFF_KR);
    const float* g = p.in[12] + l * 96;
    bf16_t* Km = (bf16_t*)(ws + A_KM);
    bf16_t* Vm = (bf16_t*)(ws + A_VM);
    auto epi = [&](f32x16 (&a)[2], int m, int head, int part) {
      const int b = m / L, pos = m - b * L;
      const float rs = rsqrtf(ssc[m] * (1.f / 128.f) + EPS);
      float ssq = 0.f;
#pragma unroll
      for (int tn = 0; tn < 2; ++tn)
#pragma unroll
        for (int i = 0; i < 16; ++i) { a[tn][i] *= rs; ssq += a[tn][i] * a[tn][i]; }
      ssq = xor32(ssq);
      if (part == 0) {
        const float rr = rsqrtf((ssq + ss_kr[m]) * (1.f / 96.f) + EPS);
        bf16_t* drow = Km + ((size_t)(b * 8 + head) * LP + pos) * 96;
#pragma unroll
        for (int tn = 0; tn < 2; ++tn)
#pragma unroll
          for (int g4 = 0; g4 < 4; ++g4) {
            const int d = tn * 32 + 8 * g4 + 4 * h;
            const f32x4 gv = *(const f32x4*)(g + d);
            *(uint2*)(drow + d) = pk4(a[tn][4 * g4] * rr * gv[0], a[tn][4 * g4 + 1] * rr * gv[1], a[tn][4 * g4 + 2] * rr * gv[2],
                                      a[tn][4 * g4 + 3] * rr * gv[3]);
          }
        const int c0 = 8 * h;
        const bf16x8 k1 = *(const bf16x8*)(krp + (size_t)m * 32 + c0);
        const bf16x8 k2 = *(const bf16x8*)(krp + (size_t)m * 32 + 16 + c0);
        float o1[8], o2[8];
#pragma unroll
        for (int j = 0; j < 8; ++j) {
          float x1 = bf2f((bf16_t)k1[j]) * rr * g[64 + c0 + j];
          float x2 = bf2f((bf16_t)k2[j]) * rr * g[80 + c0 + j];
          float cs = rope_c[pos * 16 + c0 + j], sn = rope_s[pos * 16 + c0 + j];
          o1[j] = x1 * cs - x2 * sn;
          o2[j] = x2 * cs + x1 * sn;
        }
        *(uint4*)(drow + 64 + c0) = make_uint4(pk2(o1[0], o1[1]), pk2(o1[2], o1[3]), pk2(o1[4], o1[5]), pk2(o1[6], o1[7]));
        *(uint4*)(drow + 80 + c0) = make_uint4(pk2(o2[0], o2[1]), pk2(o2[2], o2[3]), pk2(o2[4], o2[5]), pk2(o2[6], o2[7]));
      } else {
        bf16_t* dcol = Vm + ((size_t)(b * 8 + head) * 64) * LP + pos;
#pragma unroll
        for (int tn = 0; tn < 2; ++tn)
#pragma unroll
          for (int i = 0; i < 16; ++i) {
            const int d = tn * 32 + (i & 3) + 8 * (i >> 2) + 4 * h;
            dcol[(size_t)d * LP] = f2bf(a[tn][i]);
          }
      }
    };
    {
      const int wm = wid >> 1, wn = wid & 1;
      for (int t = blockIdx.x; t < 8 * MT; t += gridDim.x) {
        const int head = t % 8, mt = t / 8;
        const int m0 = mt * 256;
        f32x16 acc[2][2];
        zero_acc(acc);
        gemm_main<4, 2, 2, 2>(A, [&](int row) { return (m0 + row) * 128; }, 64, W, 128, head * 128, 2, 256, acc, smem);
#pragma unroll
        for (int tm = 0; tm < 2; ++tm) epi(acc[tm], m0 + wm * 64 + tm * 32 + r, head, wn);
      }
    }
    for (int nt = (int)blockIdx.x - 16; nt >= 0 && nt < 4; nt += gridDim.x) {
      const int wm = wid >> 2, wn = wid & 3;
      f32x16 acc[1][2];
      zero_acc(acc);
      gemm_main<2, 4, 1, 2>(A, [&](int row) { return min(16384 + row, T - 1) * 128; }, 64, W, 128, nt * 256, 2, 64, acc, smem);
      epi(acc[0], 16384 + wm * 32 + r, nt * 2 + (wn >> 1), wn & 1);
    }
  }
  {
    const float* lf = (const float*)(ws + OFF_LF);
    float* cd = (float*)(ws + OFF_CDEC);
    float* wtot = (float*)smem;
    const int tid = threadIdx.x;
    for (int s = (int)blockIdx.x - 32; s >= 0 && s < 32; s += gridDim.x) {
      const int b = s >> 3, hd = s & 7;
      float v[9];
#pragma unroll
      for (int c = 0; c < 9; ++c) {
        const int pos = tid * 9 + c;
        v[c] = pos < L ? lf[((size_t)(b * L + pos)) * 8 + hd] : 0.f;
      }
#pragma unroll
      for (int c = 1; c < 9; ++c) v[c] += v[c - 1];
      float tot = v[8];
#pragma unroll
      for (int o = 1; o < 64; o <<= 1) {
        float u = __shfl_up(tot, o);
        if (lane >= o) tot += u;
      }
      __syncthreads();
      if (lane == 63) wtot[wid] = tot;
      __syncthreads();
      float base = tot - v[8];
      for (int w = 0; w < wid; ++w) base += wtot[w];
#pragma unroll
      for (int c = 0; c < 9; ++c) {
        const int pos = tid * 9 + c;
        if (pos < L) cd[(size_t)s * LP + pos] = v[c] + base;
      }
    }
  }
}

template <int DK, int MODE>
DI void attn_item(bf16_t* Qs, const bf16_t* __restrict__ Ks, const bf16_t* __restrict__ Vt, const float* __restrict__ cdec,
                  int q0, int q_end, float slope2, float sink2, char* smem) {
  constexpr int KROW = (DK + 8) * 2;
  constexpr int KSZ = 64 * KROW;
  constexpr int VSZ = 64 * 136;
  constexpr int STAGE = KSZ + VSZ + 256;
  constexpr int NKC = DK / 8;
  constexpr int NKT = 64 * NKC;
  constexpr int NKL = (NKT + 511) / 512;
  constexpr int NS = DK / 16;
  const int tid = threadIdx.x, lane = tid & 63, w = __builtin_amdgcn_readfirstlane(tid >> 6), r = lane & 31, h = lane >> 5;
  const int qi = q0 + w * 32 + r;
  const bool wave_on = q0 + w * 32 < q_end;
  bf16x8 qf[NS];
#pragma unroll
  for (int s = 0; s < NS; ++s) qf[s] = *(const bf16x8*)(Qs + (size_t)qi * DK + s * 16 + 8 * h);
  const int kt_hi = (q_end - 1) >> 6;
  int t_lo = 0, ntiles;
  if (MODE == 2) { t_lo = max(1, (q0 - 127) >> 6); ntiles = 1 + max(0, kt_hi - t_lo + 1); }
  else ntiles = kt_hi + 1;
  auto tile_of = [&](int j) { return MODE == 2 ? (j == 0 ? 0 : t_lo + j - 1) : j; };

  bf16x8 rk[NKL], rv;
  float rc = 0.f;
  auto gload = [&](int tile) {
    const int k0 = tile * 64;
#pragma unroll
    for (int i = 0; i < NKL; ++i) {
      const int c = tid + i * 512, row = c / NKC, cc = c % NKC;
      if (NKT % 512 == 0 || c < NKT) rk[i] = *(const bf16x8*)(Ks + (size_t)(k0 + row) * DK + cc * 8);
    }
    {
      const int row = tid >> 3, cc = tid & 7;
      rv = *(const bf16x8*)(Vt + (size_t)row * LP + k0 + cc * 8);
    }
    if (MODE == 0 && tid < 64) rc = cdec[k0 + tid] * LOG2E;
  };
  auto sstore = [&](int s) {
    char* kb = smem + s * STAGE;
    char* vb = kb + KSZ;
#pragma unroll
    for (int i = 0; i < NKL; ++i) {
      const int c = tid + i * 512, row = c / NKC, cc = c % NKC;
      if (NKT % 512 == 0 || c < NKT) *(bf16x8*)(kb + row * KROW + cc * 16) = rk[i];
    }
    {
      const int row = tid >> 3, cc = tid & 7;
      s16x4 lo = {rv[0], rv[1], rv[2], rv[3]}, hi = {rv[4], rv[5], rv[6], rv[7]};
      *(s16x4*)(vb + row * 136 + cc * 16) = lo;
      *(s16x4*)(vb + row * 136 + cc * 16 + 8) = hi;
    }
    if (MODE == 0 && tid < 64) *(float*)(vb + VSZ + tid * 4) = rc;
  };

  f32x16 o[2];
#pragma unroll
  for (int i = 0; i < 16; ++i) { o[0][i] = 0.f; o[1][i] = 0.f; }
  float m_run = -1e30f, l_run = 0.f;

  gload(tile_of(0));
  sstore(0);
#pragma unroll
  for (int s = 0; s < NS; ++s) asm volatile("" ::"v"(qf[s]));
  __syncthreads();
  for (int j = 0; j < ntiles; ++j) {
    if (j + 1 < ntiles) gload(tile_of(j + 1));
    __builtin_amdgcn_sched_barrier(0);
    const int k0 = tile_of(j) * 64;
    const char* kb = smem + (j & 1) * STAGE;
    const char* vb = kb + KSZ;
    bool active = wave_on && (k0 <= q0 + w * 32 + 31);
    if (MODE == 2) active = active && (k0 == 0 || k0 + 63 >= q0 + w * 32 - 127);
    if (active) {
      f32x16 s[2];
#pragma unroll
      for (int kt = 0; kt < 2; ++kt) {
#pragma unroll
        for (int i = 0; i < 16; ++i) s[kt][i] = 0.f;
#pragma unroll
        for (int ks = 0; ks < NS; ++ks) {
          bf16x8 kf = *(const bf16x8*)(kb + (kt * 32 + r) * KROW + ks * 32 + h * 16);
          s[kt] = mfma32(kf, qf[ks], s[kt]);
        }
      }
      const bool need_mask = (MODE == 2) || (k0 + 63 > q0 + w * 32);
      float mx = -1e30f;
      if (MODE == 0 || MODE == 2) {
#pragma unroll
        for (int kt = 0; kt < 2; ++kt)
#pragma unroll
          for (int g4 = 0; g4 < 4; ++g4) {
            const int kj0 = k0 + kt * 32 + 8 * g4 + 4 * h;
            f32x4 ck;
            if (MODE == 0) ck = *(const f32x4*)(vb + VSZ + (kt * 32 + 8 * g4 + 4 * h) * 4);
#pragma unroll
            for (int jj = 0; jj < 4; ++jj) {
              if (MODE == 0) s[kt][4 * g4 + jj] -= ck[jj];
              if (MODE == 2) s[kt][4 * g4 + jj] -= slope2 * (float)(qi - kj0 - jj);
            }
          }
      }
      if (__builtin_amdgcn_readfirstlane((int)need_mask)) {
#pragma unroll
        for (int kt = 0; kt < 2; ++kt)
#pragma unroll
          for (int i = 0; i < 16; ++i) {
            const int kj = k0 + kt * 32 + (i & 3) + 8 * (i >> 2) + 4 * h;
            bool ok = kj <= qi;
            if (MODE == 2) ok = ok && (kj < 16 || qi - kj < 128);
            s[kt][i] = ok ? s[kt][i] : -1e30f;
          }
        asm volatile("" ::: "memory");
      }
#pragma unroll
      for (int kt = 0; kt < 2; ++kt)
#pragma unroll
        for (int i = 0; i < 16; ++i) mx = fmaxf(mx, s[kt][i]);
      mx = max32(mx);
      const float m_new = fmaxf(m_run, mx);
      const float alpha = fexp2(m_run - m_new);
      m_run = m_new;
      float psum = 0.f;
#pragma unroll
      for (int kt = 0; kt < 2; ++kt)
#pragma unroll
        for (int i = 0; i < 16; ++i) {
          float pv = fexp2(s[kt][i] - m_new);
          s[kt][i] = pv;
          psum += pv;
        }
      l_run = l_run * alpha + psum;
      if (__builtin_amdgcn_ballot_w64(alpha != 1.f) != 0ull) {
#pragma unroll
        for (int i = 0; i < 16; ++i) { o[0][i] *= alpha; o[1][i] *= alpha; }
      }
#pragma unroll
      for (int kt = 0; kt < 2; ++kt)
#pragma unroll
        for (int st = 0; st < 2; ++st) {
          unsigned pw[4];
#pragma unroll
          for (int u = 0; u < 4; ++u) pw[u] = pk2(s[kt][8 * st + 2 * u], s[kt][8 * st + 2 * u + 1]);
          uint4 pu = make_uint4(pw[0], pw[1], pw[2], pw[3]);
          const bf16x8 pf = __builtin_bit_cast(bf16x8, pu);
#pragma unroll
          for (int dt = 0; dt < 2; ++dt) {
            const char* va = vb + (dt * 32 + r) * 136 + (kt * 32 + 16 * st + 4 * h) * 2;
            const s16x4 lo = *(const s16x4*)va;
            const s16x4 hi = *(const s16x4*)(va + 16);
            const bf16x8 vf = {lo[0], lo[1], lo[2], lo[3], hi[0], hi[1], hi[2], hi[3]};
            o[dt] = mfma32(vf, pf, o[dt]);
          }
        }
    }
    __builtin_amdgcn_sched_barrier(0);
    if (j + 1 < ntiles) sstore((j + 1) & 1);
    __syncthreads();
  }
  float lt = xor32(l_run);
  if (MODE == 2) lt += fexp2(sink2 - m_run);
  const float inv = 1.f / lt;
  if (qi < q_end) {
    bf16_t* orow = Qs + (size_t)qi * DK;
#pragma unroll
    for (int dt = 0; dt < 2; ++dt)
#pragma unroll
      for (int g4 = 0; g4 < 4; ++g4) {
        const int d = dt * 32 + 8 * g4 + 4 * h;
        *(uint2*)(orow + d) = pk4(o[dt][4 * g4] * inv, o[dt][4 * g4 + 1] * inv, o[dt][4 * g4 + 2] * inv, o[dt][4 * g4 + 3] * inv);
      }
  }
}

DI int next_item(unsigned* ctr, int* sidx) {
  if (threadIdx.x == 0) *sidx = (int)atomicAdd(ctr, 1u);
  __syncthreads();
  const int idx = *sidx;
  __syncthreads();
  return idx;
}
DI void phase_attn(const Params& p, int l, char* smem) {
  unsigned char* ws = p.ws;
  unsigned* ctr = (unsigned*)(ws + OFF_CTR) + l * 4;
  int* sidx = (int*)(smem + 147456);
  constexpr int NQT = 17, NIT = 32 * NQT;
#pragma unroll 1
  while (true) {
    const int idx = next_item(ctr, sidx);
    if (idx >= NIT) break;
    const int qt = NQT - 1 - (idx >> 5), bh = idx & 31;
    const int q0 = qt == 0 ? 0 : 16 + 256 * (qt - 1), q_end = qt == 0 ? 16 : q0 + 256;
    attn_item<64, 0>((bf16_t*)(ws + A_QF) + (size_t)bh * LP * 64, (const bf16_t*)(ws + A_KF) + (size_t)bh * LP * 64,
                     (const bf16_t*)(ws + A_VF) + (size_t)bh * 64 * LP, (const float*)(ws + OFF_CDEC) + (size_t)bh * LP, q0, q_end,
                     0.f, 0.f, smem);
  }
#pragma unroll 1
  while (true) {
    const int idx = next_item(ctr + 1, sidx);
    if (idx >= NIT) break;
    const int qt = NQT - 1 - (idx >> 5), bh = idx & 31;
    const int q0 = qt == 0 ? 0 : 16 + 256 * (qt - 1), q_end = qt == 0 ? 16 : q0 + 256;
    attn_item<96, 1>((bf16_t*)(ws + A_QM) + (size_t)bh * LP * 96, (const bf16_t*)(ws + A_KM) + (size_t)bh * LP * 96,
                     (const bf16_t*)(ws + A_VM) + (size_t)bh * 64 * LP, nullptr, q0, q_end, 0.f, 0.f, smem);
  }
#pragma unroll 1
  while (true) {
    const int idx = next_item(ctr + 2, sidx);
    if (idx >= NIT) break;
    const int qt = idx >> 5, bh = idx & 31, b = bh >> 3, hq = bh & 7, hk = hq >> 2;
    const int q0 = qt == 0 ? 0 : 16 + 256 * (qt - 1), q_end = qt == 0 ? 16 : q0 + 256;
    const float slope2 = fexp2(-(float)(hq + 1)) * LOG2E;
    const float sink2 = p.in[15][l * 8 + hq] * LOG2E;
    attn_item<64, 2>((bf16_t*)(ws + A_QS) + (size_t)bh * LP * 64, (const bf16_t*)(ws + A_KS) + (size_t)(b * 2 + hk) * LP * 64,
                     (const bf16_t*)(ws + A_VS) + (size_t)(b * 2 + hk) * 64 * LP, nullptr, q0, q_end, slope2, sink2, smem);
  }
}

DI void phase_merge(const Params& p, int l, char* smem) {
  unsigned char* ws = p.ws;
  const bf16_t* hb = (const bf16_t*)(ws + OFF_HB);
  const bf16_t* Wg = (const bf16_t*)(ws + OFF_WG);
  const bf16_t* Wb = (const bf16_t*)(ws + OFF_WBR);
  const float* ss1 = (const float*)(ws + OFF_SS) + (size_t)(l * 2) * T;
  bf16_t* merged = (bf16_t*)(ws + A_MERGED);
  const int lane = threadIdx.x & 63, wid = __builtin_amdgcn_readfirstlane(threadIdx.x >> 6), r = lane & 31, h = lane >> 5, wm = wid >> 1, wn = wid & 1;
  constexpr int NT = 8, MT = 64;
  TileIter tit(NT * MT);
  for (int t = tit.next(); t >= 0; t = tit.next()) {
    const int nt = t % NT, mt = t / NT;
    const int m0 = mt * 256, n0 = nt * 128;
    float rs[2];
#pragma unroll
    for (int tm = 0; tm < 2; ++tm) rs[tm] = rsqrtf(ss1[min(m0 + wm * 64 + tm * 32 + r, T - 1)] * (1.f / 1024.f) + EPS);
#pragma unroll 1
    for (int n = 0; n < 3; ++n) {
      f32x16 acc[2][2];
      zero_acc(acc);
      gemm_main<4, 2, 2, 2, false>(hb, [&](int row) { return min(m0 + row, T - 1) * D; }, 64, Wg + (size_t)n * 1024 * 1024, D, n0, D / 64,
                            T - m0, acc, smem);
      unsigned gp[2][2][8];
#pragma unroll
      for (int tm = 0; tm < 2; ++tm)
#pragma unroll
      for (int tn = 0; tn < 2; ++tn)
#pragma unroll
        for (int u = 0; u < 8; ++u) {
          float a = __builtin_amdgcn_rcpf(1.f + __expf(-acc[tm][tn][2 * u] * rs[tm]));
          float bq = __builtin_amdgcn_rcpf(1.f + __expf(-acc[tm][tn][2 * u + 1] * rs[tm]));
          gp[tm][tn][u] = pk2(a, bq);
        }
      zero_acc(acc);
      const bf16_t* Ab;
      int rstride, kstride;
      if (n == 0) { Ab = (const bf16_t*)(ws + A_QF); rstride = 64; kstride = LP * 64; }
      else if (n == 1) { Ab = (const bf16_t*)(ws + A_QM); rstride = 96; kstride = LP * 96; }
      else { Ab = (const bf16_t*)(ws + A_QS); rstride = 64; kstride = LP * 64; }
      gemm_main<4, 2, 2, 2, false>(Ab, [&](int row) {
        int mr = min(m0 + row, T - 1);
        int b = mr / L, pos = mr - b * L;
        return (b * 8 * LP + pos) * rstride; }, kstride, Wb + (size_t)n * 1024 * 512, 512, n0, 8, T - m0, acc, smem);
#pragma unroll
      for (int tm = 0; tm < 2; ++tm) {
        const int m = m0 + wm * 64 + tm * 32 + r;
        if (m < T) {
#pragma unroll
          for (int tn = 0; tn < 2; ++tn)
#pragma unroll
            for (int g4 = 0; g4 < 4; ++g4) {
              const int col = n0 + wn * 64 + tn * 32 + 8 * g4 + 4 * h;
              uint2* dst = (uint2*)(merged + (size_t)m * D + col);
              uint2 old = make_uint2(0u, 0u);
              if (n > 0) old = *dst;
              const unsigned g0 = gp[tm][tn][2 * g4], g1 = gp[tm][tn][2 * g4 + 1];
              float f0 = __uint_as_float(g0 << 16) * acc[tm][tn][4 * g4] + __uint_as_float(old.x << 16);
              float f1 = __uint_as_float(g0 & 0xffff0000u) * acc[tm][tn][4 * g4 + 1] + __uint_as_float(old.x & 0xffff0000u);
              float f2 = __uint_as_float(g1 << 16) * acc[tm][tn][4 * g4 + 2] + __uint_as_float(old.y << 16);
              float f3 = __uint_as_float(g1 & 0xffff0000u) * acc[tm][tn][4 * g4 + 3] + __uint_as_float(old.y & 0xffff0000u);
              *dst = pk4(f0, f1, f2, f3);
            }
        }
      }
    }
  }
  {
    const int wm1 = wid >> 2, wn1 = wid & 3;
    for (int nt = blockIdx.x; nt < 8; nt += gridDim.x) {
      const int m0 = 16384, n0 = nt * 128;
      const int m = m0 + wm1 * 32 + r;
      const float rs1 = rsqrtf(ss1[m] * (1.f / 1024.f) + EPS);
#pragma unroll 1
      for (int n = 0; n < 3; ++n) {
        f32x16 acc[1][1];
        zero_acc(acc);
        gemm_rem(hb, [&](int row) { return min(m0 + row, T - 1) * D; }, 64, Wg + (size_t)n * 1024 * 1024, D, n0, D / 64, acc[0][0], smem);
        unsigned gp[8];
#pragma unroll
        for (int u = 0; u < 8; ++u)
          gp[u] = pk2(__builtin_amdgcn_rcpf(1.f + __expf(-acc[0][0][2 * u] * rs1)), __builtin_amdgcn_rcpf(1.f + __expf(-acc[0][0][2 * u + 1] * rs1)));
        zero_acc(acc);
        const bf16_t* Ab;
        int rstride, kstride;
        if (n == 0) { Ab = (const bf16_t*)(ws + A_QF); rstride = 64; kstride = LP * 64; }
        else if (n == 1) { Ab = (const bf16_t*)(ws + A_QM); rstride = 96; kstride = LP * 96; }
        else { Ab = (const bf16_t*)(ws + A_QS); rstride = 64; kstride = LP * 64; }
        gemm_rem(Ab, [&](int row) {
          int mr = min(m0 + row, T - 1);
          int b = mr / L, pos = mr - b * L;
          return (b * 8 * LP + pos) * rstride; }, kstride, Wb + (size_t)n * 1024 * 512, 512, n0, 8, acc[0][0], smem);
#pragma unroll
        for (int g4 = 0; g4 < 4; ++g4) {
          const int col = n0 + wn1 * 32 + 8 * g4 + 4 * h;
          uint2* dst = (uint2*)(merged + (size_t)m * D + col);
          uint2 old = make_uint2(0u, 0u);
          if (n > 0) old = *dst;
          const unsigned g0 = gp[2 * g4], g1 = gp[2 * g4 + 1];
          float f0 = __uint_as_float(g0 << 16) * acc[0][0][4 * g4] + __uint_as_float(old.x << 16);
          float f1 = __uint_as_float(g0 & 0xffff0000u) * acc[0][0][4 * g4 + 1] + __uint_as_float(old.x & 0xffff0000u);
          float f2 = __uint_as_float(g1 << 16) * acc[0][0][4 * g4 + 2] + __uint_as_float(old.y << 16);
          float f3 = __uint_as_float(g1 & 0xffff0000u) * acc[0][0][4 * g4 + 3] + __uint_as_float(old.y & 0xffff0000u);
          *dst = pk4(f0, f1, f2, f3);
        }
      }
    }
  }
}


DI void stage_half(const f32x16 (&acc)[4][2], int hp, int wm, int wn, int r, int h, const float (&rowscale)[4], float* stg) {
  if ((wn >> 1) == hp) {
#pragma unroll
    for (int tm = 0; tm < 4; ++tm) {
      float* srow = stg + (wm * 128 + tm * 32 + r) * 132 + (wn & 1) * 64 + 4 * h;
#pragma unroll
      for (int tn = 0; tn < 2; ++tn)
#pragma unroll
        for (int g4 = 0; g4 < 4; ++g4) {
          f32x4 v = {acc[tm][tn][4 * g4] * rowscale[tm], acc[tm][tn][4 * g4 + 1] * rowscale[tm],
                     acc[tm][tn][4 * g4 + 2] * rowscale[tm], acc[tm][tn][4 * g4 + 3] * rowscale[tm]};
          *(f32x4*)(srow + tn * 32 + 8 * g4) = v;
        }
    }
  }
}

DI void phase_resid(const Params& p, const bf16_t* A, int K, const bf16_t* W, float* ss_next, bool last, char* smem) {
  unsigned char* ws = p.ws;
  bf16_t* hb = (bf16_t*)(ws + OFF_HB);
  const int tid = threadIdx.x, lane = tid & 63, wid = __builtin_amdgcn_readfirstlane(tid >> 6), r = lane & 31, h = lane >> 5, wm = wid >> 2, wn = wid & 3;
  constexpr int NT = 4, MT = 64;
  float* stg = (float*)smem;
  TileIter tit(NT * MT);
  for (int t = tit.next(); t >= 0; t = tit.next()) {
    const int nt = t % NT, mt = t / NT;
    const int m0 = mt * 256, n0 = nt * 256;
    f32x16 acc[4][2];
    zero_acc(acc);
    gemm_main<2, 4, 4, 2>(A, [&](int row) { return min(m0 + row, T - 1) * K; }, 64, W, K, n0, K / 64, T - m0, acc, smem);
    const float ones[4] = {1.f, 1.f, 1.f, 1.f};
#pragma unroll 1
    for (int hp = 0; hp < 2; ++hp) {
      const int chunk = tid & 15;
      const int col = n0 + hp * 128 + chunk * 8;
      f32x4 h0[2], h1[2];
      auto hptr = [&](int it) {
        const int m = m0 + (tid >> 4) + 32 * it;
        const int b = m / L, pos = m - b * L;
        return hrow(p, b, pos) + col;
      };
      auto issue = [&](int bt) {
#pragma unroll
        for (int q = 0; q < 2; ++q) {
          const float* hp_ = hptr(bt * 2 + q);
          h0[q] = *(const f32x4*)hp_;
          h1[q] = *(const f32x4*)(hp_ + 4);
        }
      };
      auto process = [&](int bt) {
#pragma unroll
        for (int q = 0; q < 2; ++q) {
          const int row = (tid >> 4) + 32 * (bt * 2 + q);
          const int m = m0 + row;
          float* hp_ = hptr(bt * 2 + q);
          const f32x4 a0 = *(const f32x4*)(stg + row * 132 + chunk * 8);
          const f32x4 a1 = *(const f32x4*)(stg + row * 132 + chunk * 8 + 4);
          f32x4 v0, v1;
          float ssq = 0.f;
#pragma unroll
          for (int j = 0; j < 4; ++j) {
            v0[j] = a0[j] + h0[q][j];
            v1[j] = a1[j] + h1[q][j];
            ssq += v0[j] * v0[j] + v1[j] * v1[j];
          }
          *(f32x4*)hp_ = v0;
          *(f32x4*)(hp_ + 4) = v1;
          if (!last) {
            *(uint4*)(hb + (size_t)m * D + col) = make_uint4(pk2(v0[0], v0[1]), pk2(v0[2], v0[3]), pk2(v1[0], v1[1]), pk2(v1[2], v1[3]));
            ssq += __shfl_xor(ssq, 8);
            ssq += __shfl_xor(ssq, 4);
            ssq += __shfl_xor(ssq, 2);
            ssq += __shfl_xor(ssq, 1);
            if (chunk == 0) atomicAdd(ss_next + m, ssq);
          }
        }
      };
      issue(0);
      stage_half(acc, hp, wm, wn, r, h, ones, stg);
      __syncthreads();
      process(0);
#pragma unroll
      for (int bt = 1; bt < 4; ++bt) {
        __builtin_amdgcn_sched_barrier(0);
        issue(bt);
        process(bt);
      }
      __syncthreads();
    }
  }
  for (int nt = blockIdx.x; nt < 8; nt += gridDim.x) {
    const int m0 = 16384, n0 = nt * 128;
    f32x16 acc[1][1];
    zero_acc(acc);
    gemm_rem(A, [&](int row) { return min(m0 + row, T - 1) * K; }, 64, W, K, n0, K / 64, acc[0][0], smem);
    const int m = m0 + wm * 32 + r;
    const int b = m / L, pos = m - b * L;
    float* hr = hrow(p, b, pos);
    float ssq = 0.f;
    f32x4 hv[4];
#pragma unroll
    for (int g4 = 0; g4 < 4; ++g4) hv[g4] = *(const f32x4*)(hr + n0 + wn * 32 + 8 * g4 + 4 * h);
#pragma unroll
    for (int g4 = 0; g4 < 4; ++g4) {
      const int col = n0 + wn * 32 + 8 * g4 + 4 * h;
      f32x4 v;
#pragma unroll
      for (int j = 0; j < 4; ++j) { v[j] = hv[g4][j] + acc[0][0][4 * g4 + j]; ssq += v[j] * v[j]; }
      *(f32x4*)(hr + col) = v;
      if (!last) *(uint2*)(hb + (size_t)m * D + col) = pk4(v[0], v[1], v[2], v[3]);
    }
    ssq = xor32(ssq);
    if (!last && h == 0) atomicAdd(ss_next + m, ssq);
  }
}

DI void phase_up(const Params& p, int l, char* smem) {
  unsigned char* ws = p.ws;
  const bf16_t* hb = (const bf16_t*)(ws + OFF_HB);
  const bf16_t* W = (const bf16_t*)(ws + OFF_WUP);
  const float* ss2 = (const float*)(ws + OFF_SS) + (size_t)(l * 2 + 1) * T;
  const float* cw = p.in[20] + (size_t)l * 3 * 5632;
  const float* cb = p.in[21] + (size_t)l * 5632;
  bf16_t* act = (bf16_t*)(ws + A_ACT);
  const int tid = threadIdx.x, lane = tid & 63, wid = __builtin_amdgcn_readfirstlane(tid >> 6), r = lane & 31, h = lane >> 5, wm = wid >> 2, wn = wid & 3;
  constexpr int NT = 5632 / 256, MT = (T + 253) / 254;
  float* stg = (float*)smem;
  TileIter tit(NT * MT);
  for (int t = tit.next(); t >= 0; t = tit.next()) {
    const int nt = t % NT, mt = t / NT;
    const int mbase = mt * 254 - 2, n0 = nt * 256;
    f32x16 acc[4][2];
    zero_acc(acc);
    float rsv[4];
#pragma unroll
    for (int tm = 0; tm < 4; ++tm) rsv[tm] = ss2[min(max(mbase + wm * 128 + tm * 32 + r, 0), T - 1)];
    gemm_main<2, 4, 4, 2>(hb, [&](int row) { return min(max(mbase + row, 0), T - 1) * D; }, 64, W, D, n0, D / 64, T - mbase, acc,
                          smem);
#pragma unroll
    for (int tm = 0; tm < 4; ++tm) rsv[tm] = rsqrtf(rsv[tm] * (1.f / 1024.f) + EPS);
#pragma unroll 1
    for (int hp = 0; hp < 2; ++hp) {
      const int chunk = tid & 15, grp = chunk >> 3, jl0 = (chunk & 7) * 4;
      const int jg0 = (n0 / 64 + hp * 2 + grp) * 32 + jl0;
      f32x4 wg[3], wv[3];
#pragma unroll
      for (int i = 0; i < 3; ++i) {
        wg[i] = *(const f32x4*)(cw + i * 5632 + jg0);
        wv[i] = *(const f32x4*)(cw + i * 5632 + DFF + jg0);
      }
      const f32x4 bg = *(const f32x4*)(cb + jg0), bv = *(const f32x4*)(cb + DFF + jg0);
      stage_half(acc, hp, wm, wn, r, h, rsv, stg);
      __syncthreads();
      {
        const float* sgc = stg + grp * 64 + jl0;
#pragma unroll 2
        for (int it = 0; it < 8; ++it) {
          const int row = 2 + (tid >> 4) + 32 * it;
          const int gm = mbase + row;
          if (row < 256 && gm < T) {
            const int b = gm / L, pos = gm - b * L;
            const float* s0 = sgc + row * 132;
            const f32x4 g0 = *(const f32x4*)(s0), v0 = *(const f32x4*)(s0 + 32);
            const f32x4 g1 = *(const f32x4*)(s0 - 132), v1 = *(const f32x4*)(s0 - 132 + 32);
            const f32x4 g2 = *(const f32x4*)(s0 - 264), v2 = *(const f32x4*)(s0 - 264 + 32);
            float o[4];
#pragma unroll
            for (int j = 0; j < 4; ++j) {
              float a = bg[j] + wg[2][j] * g0[j], c = bv[j] + wv[2][j] * v0[j];
              if (pos >= 1) { a += wg[1][j] * g1[j]; c += wv[1][j] * v1[j]; }
              if (pos >= 2) { a += wg[0][j] * g2[j]; c += wv[0][j] * v2[j]; }
              o[j] = a * __builtin_amdgcn_rcpf(1.f + __expf(-a)) * c;
            }
            *(uint2*)(act + (size_t)gm * DFF + jg0) = pk4(o[0], o[1], o[2], o[3]);
          }
        }
      }
      __syncthreads();
    }
  }
}

#define XB_TMO      128
#define XB_XCNT(j)  (256  + 64 * (j))
#define XB_XSUB(j)  (1280 + 64 * (j))
#define XB_XGEN(j)  (2304 + 64 * (j))
#define XB_TOP      3328
#define XB_TOPGEN   3392
#define XB_SPIN_CAP (1u << 22)
DI unsigned xb_ld(unsigned* p) { return __hip_atomic_load(p, __ATOMIC_RELAXED, __HIP_MEMORY_SCOPE_AGENT); }
DI unsigned xb_add(unsigned* p, unsigned v) { return __hip_atomic_fetch_add(p, v, __ATOMIC_RELAXED, __HIP_MEMORY_SCOPE_AGENT); }
DI unsigned xb_xcc_id() { return (unsigned)__builtin_amdgcn_s_getreg((3 << 11) | 20) & 0xFu; }
#define XB_SPIN(cond, bar) do { unsigned _sp = 0; while (cond) { __builtin_amdgcn_s_sleep(1); \
    if ((++_sp & 255u) == 0u) { if (xb_ld(&(bar)[XB_TMO])) break; if (_sp > XB_SPIN_CAP) { atomicAdd(&(bar)[XB_TMO], 1u); break; } } } } while (0)
DI void xcd_barrier_complete(unsigned* bar, unsigned x, unsigned& nloc, unsigned& nx) {
  const unsigned G = gridDim.x;
  unsigned sum, cnt, mine, sp = 0u;
  for (;;) {
    sum = 0u; cnt = 0u; mine = 0u;
#pragma unroll
    for (unsigned j = 0; j < 16; ++j) { const unsigned c = xb_ld(&bar[XB_XCNT(j)]); sum += c; cnt += (c > 0u) ? 1u : 0u; mine = (j == x) ? c : mine; }
    if (sum == G) break;
    __builtin_amdgcn_s_sleep(1);
    if ((++sp & 255u) == 0u) { if (xb_ld(&bar[XB_TMO])) break; if (sp > XB_SPIN_CAP) { atomicAdd(&bar[XB_TMO], 1u); break; } }
  }
  nloc = mine > 0u ? mine : 1u; nx = cnt > 0u ? cnt : 1u;
}
DI void xcd_barrier(unsigned* bar, unsigned x, volatile unsigned* st) {
  asm volatile("s_waitcnt vmcnt(0)" ::: "memory");
  __syncthreads();
  if (threadIdx.x == 0) {
    __builtin_amdgcn_s_waitcnt(0);
    unsigned nloc = st[0], nx = st[1];
    if (nloc == 0u) { xcd_barrier_complete(bar, x, nloc, nx); st[0] = nloc; st[1] = nx; }
    const unsigned old = xb_add(&bar[XB_XSUB(x)], 1u);
    const unsigned gen = old / nloc;
    if (old + 1u == (gen + 1u) * nloc) {
      __builtin_amdgcn_fence(__ATOMIC_RELEASE, "agent");
      asm volatile("s_waitcnt vmcnt(0)" ::: "memory");
      const unsigned og = xb_add(&bar[XB_TOP], 1u);
      const unsigned tg = og / nx;
      if (og + 1u == (tg + 1u) * nx) xb_add(&bar[XB_TOPGEN], 1u);
      else XB_SPIN(xb_ld(&bar[XB_TOPGEN]) == tg, bar);
      __builtin_amdgcn_fence(__ATOMIC_ACQUIRE, "agent");
      xb_add(&bar[XB_XGEN(x)], 1u);
      asm volatile("s_waitcnt vmcnt(0)" ::: "memory");
    } else {
      XB_SPIN(xb_ld(&bar[XB_XGEN(x)]) == gen, bar);
      __builtin_amdgcn_fence(__ATOMIC_ACQUIRE, "agent");
      asm volatile("s_waitcnt vmcnt(0)" ::: "memory");
    }
  }
  __syncthreads();
}

constexpr int NPHASES = 16;
__global__ void __launch_bounds__(NTHREADS, 2) mega_kernel(Params p) {
  __shared__ __attribute__((aligned(16))) char smem[SMEM_BYTES];
  cg::grid_group grid = cg::this_grid();
  unsigned char* ws = p.ws;
  int ph = 0;
  __shared__ __attribute__((aligned(16))) unsigned xb_st[4];
  unsigned* xbar = (unsigned*)(ws + OFF_XBAR);
  const unsigned xb_x = xb_xcc_id();
  if (threadIdx.x < 4) xb_st[threadIdx.x] = 0u;
#define RUN(body)                                   \
  {                                                 \
    if (ph >= p.ph_lo && ph < p.ph_hi) {            \
      body;                                         \
      if (ph + 1 < p.ph_hi) {                       \
        if (ph == 0) {                              \
          grid.sync();                              \
          if (threadIdx.x == 0) (void)xb_add(&xbar[XB_XCNT(xb_x)], 1u); \
        } else xcd_barrier(xbar, xb_x, xb_st);      \
      }                                             \
    }                                               \
    ++ph;                                           \
  }
  RUN(convert_layer(p, 0, smem); phase_init(p));
#define LAYER(l)                                                                                          \
  RUN(phase_inproj(p, l, smem));                                                                          \
  RUN(phase_mla_up(p, l, smem));                                                                          \
  RUN(phase_attn(p, l, smem));                                                                            \
  RUN(phase_merge(p, l, smem));                                                                           \
  RUN(phase_resid(p, (const bf16_t*)(ws + A_MERGED), 1024, (const bf16_t*)(ws + OFF_WO),                  \
                  (float*)(ws + OFF_SS) + (size_t)(l * 2 + 1) * T, false, smem));                         \
  RUN(phase_up(p, l, smem));                                                                              \
  RUN(phase_resid(p, (const bf16_t*)(ws + A_ACT), DFF, (const bf16_t*)(ws + OFF_WDN),                     \
                  (float*)(ws + OFF_SS) + (size_t)((l + 1) * 2) * T, l == 1, smem));
  LAYER(0)
  RUN(convert_layer(p, 1, smem));
  LAYER(1)
#undef LAYER
#undef RUN
}

extern "C" void kernel_launch(void* const* d_in, const int* in_sizes, int n_in, void* d_out, int out_size, void* d_ws,
                              size_t ws_size, hipStream_t stream) {
  static int grid_blocks = 0;
  if (!grid_blocks) {
    int dev = 0, cus = 0, per_cu = 0;
    hipGetDevice(&dev);
    hipDeviceGetAttribute(&cus, hipDeviceAttributeMultiprocessorCount, dev);
    hipOccupancyMaxActiveBlocksPerMultiprocessor(&per_cu, mega_kernel, NTHREADS, 0);
    if (per_cu < 1) per_cu = 1;
    if (per_cu > 1) per_cu = 1;
    grid_blocks = cus * per_cu;
    if (ws_size < A_END) fprintf(stderr, "workspace too small: %zu < %zu\n", ws_size, (size_t)A_END);
  }
  Params p{};
  for (int i = 0; i < 23; ++i) p.in[i] = (const float*)d_in[i];
  p.out = (float*)d_out;
  p.ws = (unsigned char*)d_ws;
  p.ph_lo = 0;
  p.ph_hi = NPHASES;
  void* args[] = {&p};
  hipError_t e = hipLaunchCooperativeKernel((void*)mega_kernel, dim3(grid_blocks), dim3(NTHREADS), args, 0, stream);
  if (e != hipSuccess) fprintf(stderr, "cooperative launch failed: %s (grid %d)\n", hipGetErrorString(e), grid_blocks);
}
```

```cpp
#include <hip/hip_runtime.h>
#include <hip/hip_cooperative_groups.h>
#include <cstdio>
namespace cg = cooperative_groups;

#define DI __device__ __forceinline__
typedef __attribute__((ext_vector_type(8))) short bf16x8;
typedef __attribute__((ext_vector_type(4))) short s16x4;
typedef __attribute__((ext_vector_type(16))) float f32x16;
typedef __attribute__((ext_vector_type(4))) float f32x4;
typedef __attribute__((ext_vector_type(2))) float f32x2;
typedef __attribute__((ext_vector_type(2))) __bf16 bf16x2_t;
typedef unsigned short bf16_t;

constexpr int D = 1024, NBATCH = 4, SEQ = 4096, L = 4112, T = NBATCH * L  , LP = 4224;
constexpr int DFF = 2816;
constexpr int NIN = 2816;
constexpr float EPS = 1e-6f;
constexpr float LOG2E = 1.4426950408889634f;
constexpr int NTHREADS = 512;
constexpr int SMEM_BYTES = 147456 + 64;

constexpr size_t OFF_WIN = 0;
constexpr size_t OFF_WG = OFF_WIN + (size_t)NIN * 1024 * 2;
constexpr size_t OFF_WQUP = OFF_WG + (size_t)3072 * 1024 * 2;
constexpr size_t OFF_WKVUP = OFF_WQUP + (size_t)768 * 256 * 2;
constexpr size_t OFF_WBR = OFF_WKVUP + (size_t)1024 * 128 * 2;
constexpr size_t OFF_WO = OFF_WBR + (size_t)3 * 1024 * 512 * 2;
constexpr size_t OFF_WUP = OFF_WO + (size_t)1024 * 1024 * 2;
constexpr size_t OFF_WDN = OFF_WUP + (size_t)5632 * 1024 * 2;
constexpr size_t OFF_HB = OFF_WDN + (size_t)1024 * 2816 * 2;
constexpr size_t OFF_SS = OFF_HB + (size_t)T * 1024 * 2;
constexpr size_t OFF_SSKR = OFF_SS + (size_t)8 * T * 4;
constexpr size_t OFF_ROPE = OFF_SSKR + (size_t)T * 4;
constexpr size_t OFF_LF = OFF_ROPE + (size_t)L * 32 * 4;
constexpr size_t OFF_CDEC = OFF_LF + (size_t)T * 8 * 4;
constexpr size_t OFF_HMETA = OFF_CDEC + (size_t)32 * LP * 4;
constexpr size_t OFF_KR = OFF_HMETA + (size_t)64 * 1024 * 4;
constexpr size_t OFF_CTR = OFF_KR + (size_t)T * 32 * 2;
constexpr size_t OFF_XBAR = OFF_CTR + 256;
constexpr size_t OFF_ARENA = OFF_XBAR + 3456 * 4 + 128;
constexpr size_t SZ64 = (size_t)NBATCH * 8 * LP * 64 * 2;
constexpr size_t SZ96 = (size_t)NBATCH * 8 * LP * 96 * 2;
constexpr size_t SZKS = (size_t)NBATCH * 2 * LP * 64 * 2;
constexpr size_t A_QF = OFF_ARENA;
constexpr size_t A_QS = A_QF + SZ64;
constexpr size_t A_QM = A_QS + SZ64;
constexpr size_t A_KF = A_QM + SZ96;
constexpr size_t A_VF = A_KF + SZ64;
constexpr size_t A_KS = A_VF + SZ64;
constexpr size_t A_VS = A_KS + SZKS;
constexpr size_t A_KM = A_VS + SZKS;
constexpr size_t A_VM = A_KM + SZ96;
constexpr size_t A_CQ = A_VM + SZ64;
constexpr size_t A_CKV = A_CQ + (size_t)T * 256 * 2;
constexpr size_t A_END = A_CKV + (size_t)T * 128 * 2;
constexpr size_t A_MERGED = A_KF;
constexpr size_t A_ACT = OFF_ARENA;
static_assert((size_t)T * 1024 * 2 <= 2 * SZ64, "merged alias");
static_assert(A_END <= (size_t)256 * 1024 * 1024, "workspace");
static_assert(A_ACT + (size_t)T * 2816 * 2 <= A_END, "act alias");

struct Params {
  const float* in[23];
  float* out;
  unsigned char* ws;
  int ph_lo, ph_hi;
};

__device__ const double ROPE_FREQ[16] = {1.0, 0.5623413251903491, 0.31622776601683794, 0.1778279410038923, 0.1, 0.05623413251903491,
  0.03162277660168379, 0.01778279410038923, 0.01, 0.005623413251903491, 0.0031622776601683794, 0.0017782794100389228, 0.001,
  0.0005623413251903491, 0.00031622776601683794, 0.00017782794100389227};

DI unsigned pk2(float a, float b) {
  f32x2 v = {a, b};
  bf16x2_t r = __builtin_convertvector(v, bf16x2_t);
  return __builtin_bit_cast(unsigned, r);
}
DI uint2 pk4(float a, float b, float c, float d) { return make_uint2(pk2(a, b), pk2(c, d)); }
DI bf16_t f2bf(float v) { return (bf16_t)(pk2(v, 0.f) & 0xffffu); }
DI float bf2f(bf16_t v) { return __uint_as_float(((unsigned)v) << 16); }
DI float xor32(float v) {
  const auto r = __builtin_amdgcn_permlane32_swap(__float_as_uint(v), __float_as_uint(v), false, false);
  return __uint_as_float(r[0]) + __uint_as_float(r[1]);
}
DI float max32(float v) {
  const auto r = __builtin_amdgcn_permlane32_swap(__float_as_uint(v), __float_as_uint(v), false, false);
  return fmaxf(__uint_as_float(r[0]), __uint_as_float(r[1]));
}
DI float fexp2(float x) { return __builtin_amdgcn_exp2f(x); }
DI f32x16 mfma32(bf16x8 a, bf16x8 b, f32x16 c) { return __builtin_amdgcn_mfma_f32_32x32x16_bf16(a, b, c, 0, 0, 0); }
DI float* hrow(const Params& p, int b, int pos) {
  return pos >= 16 ? p.out + ((size_t)(b * SEQ + pos - 16)) * D : (float*)(p.ws + OFF_HMETA) + (size_t)(b * 16 + pos) * D;
}

template <int WM, int WN, int TM, int TN, bool LOWREG = false, class RowOff>
DI void gemm_main(const bf16_t* __restrict__ A, RowOff rowoff, int a_kstride, const bf16_t* __restrict__ Bt, int ldb, int n0,
                  int nk, int mvalid, f32x16 (&acc)[TM][TN], char* smem) {
  static_assert(WM * WN == 8, "8 waves");
  constexpr int BM = WM * TM * 32, BN = WN * TN * 32;
  constexpr int NA = (BM + 63) / 64, NB = (BN + 63) / 64;
  constexpr int STAGE = (BM + BN) * 144;
  static_assert(2 * STAGE <= 147456, "smem");
  const int tid = threadIdx.x, lane = tid & 63, wid = __builtin_amdgcn_readfirstlane(tid >> 6);
  const int r = lane & 31, h = lane >> 5;
  const int wm = wid / WN, wn = wid % WN;
  const int lrow = tid >> 3, c8 = tid & 7;
  int aoff[NA];
#pragma unroll
  for (int i = 0; i < NA; ++i) aoff[i] = rowoff(min(lrow + 64 * i, BM - 1)) + c8 * 8;
  const bf16_t* bptr = Bt + (size_t)(n0 + lrow) * ldb + c8 * 8;
  bf16x8 ra0[NA], rb0[NB];
  auto gload = [&](int kt, bf16x8 (&ra)[NA], bf16x8 (&rb)[NB]) {
#pragma unroll
    for (int i = 0; i < NA; ++i) ra[i] = *(const bf16x8*)(A + aoff[i] + (size_t)kt * a_kstride);
#pragma unroll
    for (int i = 0; i < NB; ++i)
      if (BN % 64 == 0 || lrow + 64 * i < BN) rb[i] = *(const bf16x8*)(bptr + (size_t)(64 * i) * ldb + kt * 64);
  };
  auto sstore = [&](int s, bf16x8 (&ra)[NA], bf16x8 (&rb)[NB]) {
    char* as = smem + s * STAGE;
    char* bs = as + BM * 144;
#pragma unroll
    for (int i = 0; i < NA; ++i)
      if (BM % 64 == 0 || lrow + 64 * i < BM) *(bf16x8*)(as + (lrow + 64 * i) * 144 + c8 * 16) = ra[i];
#pragma unroll
    for (int i = 0; i < NB; ++i)
      if (BN % 64 == 0 || lrow + 64 * i < BN) *(bf16x8*)(bs + (lrow + 64 * i) * 144 + c8 * 16) = rb[i];
  };
  const int ntm = min(TM, max(0, (mvalid - wm * TM * 32 + 31) >> 5));
  auto half_a = [&](int kt) {
    if (kt + 1 < nk) {
      char* as = smem + ((kt + 1) & 1) * STAGE;
#pragma unroll
      for (int i = 0; i < NA; ++i)
        if (BM % 64 == 0 || lrow + 64 * i < BM) *(bf16x8*)(as + (lrow + 64 * i) * 144 + c8 * 16) = ra0[i];
    }
    if (kt + 2 < nk) {
#pragma unroll
      for (int i = 0; i < NA; ++i) ra0[i] = *(const bf16x8*)(A + aoff[i] + (size_t)(kt + 2) * a_kstride);
    }
  };
  auto half_b = [&](int kt) {
    if (kt + 1 < nk) {
      char* bs = smem + ((kt + 1) & 1) * STAGE + BM * 144;
#pragma unroll
      for (int i = 0; i < NB; ++i)
        if (BN % 64 == 0 || lrow + 64 * i < BN) *(bf16x8*)(bs + (lrow + 64 * i) * 144 + c8 * 16) = rb0[i];
    }
    if (kt + 2 < nk) {
#pragma unroll
      for (int i = 0; i < NB; ++i)
        if (BN % 64 == 0 || lrow + 64 * i < BN) rb0[i] = *(const bf16x8*)(bptr + (size_t)(64 * i) * ldb + (kt + 2) * 64);
    }
  };
  auto mm = [&](const char* as, const char* bs, int ks) {
    bf16x8 af[TM], bf[TN];
#pragma unroll
    for (int tn = 0; tn < TN; ++tn) bf[tn] = *(const bf16x8*)(bs + tn * 32 * 144 + ks * 32);
#pragma unroll
    for (int tm = 0; tm < TM; ++tm) af[tm] = *(const bf16x8*)(as + tm * 32 * 144 + ks * 32);
#pragma unroll
    for (int tm = 0; tm < TM; ++tm)
#pragma unroll
      for (int tn = 0; tn < TN; ++tn) acc[tm][tn] = mfma32(bf[tn], af[tm], acc[tm][tn]);
  };
  gload(0, ra0, rb0);
  sstore(0, ra0, rb0);
  if (nk > 1) gload(1, ra0, rb0);
#pragma unroll 1
  for (int kt = 0; kt < nk; ++kt) {
    __syncthreads();
    const char* as = smem + (kt & 1) * STAGE + (wm * TM * 32 + r) * 144 + h * 16;
    const char* bs = smem + (kt & 1) * STAGE + BM * 144 + (wn * TN * 32 + r) * 144 + h * 16;
    __builtin_amdgcn_s_setprio(1);
    mm(as, bs, 0);
    __builtin_amdgcn_s_setprio(0);
    __builtin_amdgcn_sched_barrier(0);
    half_a(kt);
    __builtin_amdgcn_sched_barrier(0);
    __builtin_amdgcn_s_setprio(1);
    mm(as, bs, 1);
    mm(as, bs, 2);
    __builtin_amdgcn_s_setprio(0);
    __builtin_amdgcn_sched_barrier(0);
    half_b(kt);
    __builtin_amdgcn_sched_barrier(0);
    __builtin_amdgcn_s_setprio(1);
    mm(as, bs, 3);
    __builtin_amdgcn_s_setprio(0);
  }
  __syncthreads();
}


template <class RowOff>
DI void gemm_rem(const bf16_t* __restrict__ A, RowOff rowoff, int a_kstride, const bf16_t* __restrict__ Bt, int ldb, int n0,
                 int nk, f32x16& acc, char* smem) {
  constexpr int PITCH = 272, STAGE = (64 + 128) * PITCH;
  const int nk2 = nk >> 1;
  const int tid = threadIdx.x, lane = tid & 63, wid = __builtin_amdgcn_readfirstlane(tid >> 6);
  const int r = lane & 31, h = lane >> 5;
  const int wm = wid >> 2, wn = wid & 3;
  const int lrow = tid >> 3, c8 = tid & 7;
  const bf16_t* ap = A + rowoff(lrow) + c8 * 8;
  const bf16_t* bp = Bt + (size_t)(n0 + lrow) * ldb + c8 * 8;
  bf16x8 ra[2][2], rb0[2][2], rb1[2][2];
  auto gload = [&](int k2, int s) {
#pragma unroll
    for (int hf = 0; hf < 2; ++hf) {
      const int kt = 2 * k2 + hf;
      ra[s][hf] = *(const bf16x8*)(ap + (size_t)kt * a_kstride);
      rb0[s][hf] = *(const bf16x8*)(bp + kt * 64);
      rb1[s][hf] = *(const bf16x8*)(bp + (size_t)64 * ldb + kt * 64);
    }
  };
  auto sstore = [&](int st, int s) {
    char* as = smem + st * STAGE;
#pragma unroll
    for (int hf = 0; hf < 2; ++hf) {
      *(bf16x8*)(as + lrow * PITCH + hf * 128 + c8 * 16) = ra[s][hf];
      *(bf16x8*)(as + (64 + lrow) * PITCH + hf * 128 + c8 * 16) = rb0[s][hf];
      *(bf16x8*)(as + (128 + lrow) * PITCH + hf * 128 + c8 * 16) = rb1[s][hf];
    }
  };
  auto compute = [&](int k2) {
    const char* as = smem + (k2 & 1) * STAGE + (wm * 32 + r) * PITCH + h * 16;
    const char* bs = smem + (k2 & 1) * STAGE + (64 + wn * 32 + r) * PITCH + h * 16;
#pragma unroll
    for (int ks = 0; ks < 8; ++ks) {
      const bf16x8 bf = *(const bf16x8*)(bs + ks * 32);
      const bf16x8 af = *(const bf16x8*)(as + ks * 32);
      acc = mfma32(bf, af, acc);
    }
  };
  gload(0, 0);
  gload(1, 1);
  sstore(0, 0);
  __syncthreads();
#pragma unroll 1
  for (int k2 = 0; k2 < nk2; k2 += 2) {
    if (k2 + 2 < nk2) gload(k2 + 2, 0);
    __builtin_amdgcn_sched_barrier(0);
    compute(k2);
    __builtin_amdgcn_sched_barrier(0);
    sstore(1, 1);
    __syncthreads();
    if (k2 + 3 < nk2) gload(k2 + 3, 1);
    __builtin_amdgcn_sched_barrier(0);
    compute(k2 + 1);
    __builtin_amdgcn_sched_barrier(0);
    if (k2 + 2 < nk2) sstore(0, 0);
    __syncthreads();
  }
}

template <int TM, int TN>
DI void zero_acc(f32x16 (&acc)[TM][TN]) {
#pragma unroll
  for (int a = 0; a < TM; ++a)
#pragma unroll
    for (int b = 0; b < TN; ++b)
#pragma unroll
      for (int i = 0; i < 16; ++i) acc[a][b][i] = 0.f;
}

DI int inproj_src_col(int n) {
  if (n < 1536) return n;
  if (n < 2048) return 1960 + (n - 1536);
  if (n < 2176) return 2472 + (n - 2048);
  if (n < 2304) return 2600 + (n - 2176);
  if (n < 2560) return 1544 + (n - 2304);
  if (n < 2688) return 1800 + (n - 2560);
  if (n < 2720) return 1928 + (n - 2688);
  if (n < 2728) return 1536 + (n - 2720);
  return -1;
}
DI void conv_mat(const float* __restrict__ src, int ldsrc, int K, int Np, const float* __restrict__ gain, int map,
                 bf16_t* __restrict__ dst, int& base, char* smem) {
  float* tl = (float*)smem;
  const int tk = K / 64, tn = Np / 64, nt = tk * tn;
  const int G = gridDim.x;
  int start = (int)(((long)blockIdx.x - base) % G);
  if (start < 0) start += G;
  const int tid = threadIdx.x;
  const int lk = tid >> 4, n4 = (tid & 15) * 4;
  const int sn = tid >> 3, k8 = (tid & 7) * 8;
  auto issue = [&](int t, f32x4& a, f32x4& b) {
    const int k0 = (t % tk) * 64, n0 = (t / tk) * 64;
    const int nn = n0 + n4;
    int sc;
    if (map == 0) sc = nn;
    else if (map == 1) sc = inproj_src_col(nn);
    else if (map == 2) sc = 2728 + nn;
    else sc = (nn >> 6) * 32 + (nn & 31) + ((nn & 32) ? DFF : 0);
    a = f32x4{0.f, 0.f, 0.f, 0.f};
    b = a;
    if (sc >= 0) {
      a = *(const f32x4*)(src + (size_t)(k0 + lk) * ldsrc + sc);
      b = *(const f32x4*)(src + (size_t)(k0 + lk + 32) * ldsrc + sc);
    }
    if (gain) {
      const float g0 = gain[k0 + lk], g1 = gain[k0 + lk + 32];
#pragma unroll
      for (int j = 0; j < 4; ++j) { a[j] *= g0; b[j] *= g1; }
    }
  };
  f32x4 ca, cb2;
  int t = start;
  if (t < nt) issue(t, ca, cb2);
  while (t < nt) {
#pragma unroll
    for (int j = 0; j < 4; ++j) {
      tl[(n4 + j) * 65 + lk] = ca[j];
      tl[(n4 + j) * 65 + lk + 32] = cb2[j];
    }
    __syncthreads();
    const int tnx = t + G;
    f32x4 na, nb;
    if (tnx < nt) issue(tnx, na, nb);
    {
      const int k0 = (t % tk) * 64, n0 = (t / tk) * 64;
      float v[8];
#pragma unroll
      for (int j = 0; j < 8; ++j) v[j] = tl[sn * 65 + k8 + j];
      *(uint4*)(dst + (size_t)(n0 + sn) * K + k0 + k8) = make_uint4(pk2(v[0], v[1]), pk2(v[2], v[3]), pk2(v[4], v[5]), pk2(v[6], v[7]));
    }
    __syncthreads();
    ca = na; cb2 = nb;
    t = tnx;
  }
  base += nt;
}
DI void convert_layer(const Params& p, int l, char* smem, int parts = 3) {
  unsigned char* ws = p.ws;
  int base = 0;
  if (parts & 1) {
  const float* w_in = p.in[3] + (size_t)l * 1024 * 5800;
  conv_mat(w_in, 5800, 1024, NIN, p.in[2] + l * 1024, 1, (bf16_t*)(ws + OFF_WIN), base, smem);
  conv_mat(w_in, 5800, 1024, 3072, p.in[2] + l * 1024, 2, (bf16_t*)(ws + OFF_WG), base, smem);
  conv_mat(p.in[8] + (size_t)l * 256 * 768, 768, 256, 768, p.in[7] + l * 256, 0, (bf16_t*)(ws + OFF_WQUP), base, smem);
  conv_mat(p.in[10] + (size_t)l * 128 * 1024, 1024, 128, 1024, p.in[9] + l * 128, 0, (bf16_t*)(ws + OFF_WKVUP), base, smem);
  for (int n = 0; n < 3; ++n)
    conv_mat(p.in[16] + ((size_t)l * 3 + n) * 512 * 1024, 1024, 512, 1024, nullptr, 0,
             (bf16_t*)(ws + OFF_WBR) + (size_t)n * 1024 * 512, base, smem);
  conv_mat(p.in[17] + (size_t)l * 1024 * 1024, 1024, 1024, 1024, nullptr, 0, (bf16_t*)(ws + OFF_WO), base, smem);
  conv_mat(p.in[19] + (size_t)l * 1024 * 5632, 5632, 1024, 5632, p.in[18] + l * 1024, 3, (bf16_t*)(ws + OFF_WUP), base, smem);
  }
  if (parts & 2) conv_mat(p.in[22] + (size_t)l * 2816 * 1024, 1024, 2816, 1024, nullptr, 0, (bf16_t*)(ws + OFF_WDN), base, smem);
}

DI void phase_init(const Params& p) {
  unsigned char* ws = p.ws;
  const int tid = threadIdx.x, lane = tid & 63, wid = tid >> 6;
  const int gw = blockIdx.x * 8 + wid, nw = gridDim.x * 8;
  const int gt = blockIdx.x * NTHREADS + tid, ntot = gridDim.x * NTHREADS;
  float* ss = (float*)(ws + OFF_SS);
  bf16_t* hb = (bf16_t*)(ws + OFF_HB);
#pragma unroll 2
  for (int m = gw; m < T; m += nw) {
    int b = m / L, pos = m - b * L;
    const float* src = pos < 16 ? p.in[1] + pos * D : p.in[0] + ((size_t)(b * SEQ + pos - 16)) * D;
    float* dsth = hrow(p, b, pos);
    float s = 0.f;
#pragma unroll
    for (int i = 0; i < 4; ++i) {
      int c = (i * 64 + lane) * 4;
      f32x4 v = *(const f32x4*)(src + c);
      *(f32x4*)(dsth + c) = v;
      *(uint2*)(hb + (size_t)m * D + c) = pk4(v[0], v[1], v[2], v[3]);
      s += v[0] * v[0] + v[1] * v[1] + v[2] * v[2] + v[3] * v[3];
    }
#pragma unroll
    for (int o = 32; o >= 1; o >>= 1) s += __shfl_xor(s, o);
    if (lane == 0) ss[m] = s;
  }
  for (int i = gt; i < 7 * T; i += ntot) ss[T + i] = 0.f;
  if (gt < 64) ((unsigned*)(ws + OFF_CTR))[gt] = 0u;
  for (int i = gt; i < 3456; i += ntot) ((unsigned*)(ws + OFF_XBAR))[i] = 0u;
  float* rc = (float*)(ws + OFF_ROPE);
  float* rsn = rc + L * 16;
  for (int i = gt; i < L * 16; i += ntot) {
    int pos = i >> 4, c = i & 15;
    double ang = (double)pos * ROPE_FREQ[c];
    double k = rint(ang * 0.15915494309189535);
    double x = ang - k * 6.283185307179586476925;
    double x2 = x * x;
    double sn = 0.0, cs = 0.0;
    double ts = x, tc = 1.0;
#pragma unroll 1
    for (int n = 0; n < 15; ++n) {
      sn += ts;
      cs += tc;
      tc = -tc * x2 / (double)((2 * n + 1) * (2 * n + 2));
      ts = -ts * x2 / (double)((2 * n + 2) * (2 * n + 3));
    }
    rc[i] = (float)cs;
    rsn[i] = (float)sn;
  }
}


struct TileIter {
  int xcd, loc, nloc, per, nt, i;
  bool xmode;
  DI TileIter(int ntiles) {
    nt = ntiles;
    xmode = (gridDim.x & 7) == 0;
    if (xmode) { xcd = blockIdx.x & 7; loc = blockIdx.x >> 3; nloc = gridDim.x >> 3; per = (ntiles + 7) >> 3; i = loc; }
    else { xcd = 0; loc = blockIdx.x; nloc = gridDim.x; per = ntiles; i = loc; }
  }
  DI int next() {
    if (i >= per) return -1;
    const int t = xcd * per + i;
    i += nloc;
    return t < nt ? t : -1;
  }
};

DI void phase_inproj(const Params& p, int l, char* smem) {
  unsigned char* ws = p.ws;
  const bf16_t* hb = (const bf16_t*)(ws + OFF_HB);
  const bf16_t* W = (const bf16_t*)(ws + OFF_WIN);
  const float* ss1 = (const float*)(ws + OFF_SS) + (size_t)(l * 2) * T;
  float* ss_cq = (float*)(ws + OFF_SS) + (size_t)(4 + l) * T;
  float* ss_ckv = (float*)(ws + OFF_SS) + (size_t)(6 + l) * T;
  float* ss_kr = (float*)(ws + OFF_SSKR);
  const int lane = threadIdx.x & 63, wid = __builtin_amdgcn_readfirstlane(threadIdx.x >> 6), r = lane & 31, h = lane >> 5, wm = wid >> 2, wn = wid & 3;
  constexpr int NT = NIN / 256, MT = (T + 255) / 256;
  TileIter tit(NT * MT);
  for (int t = tit.next(); t >= 0; t = tit.next()) {
    const int nt = t % NT, mt = t / NT;
    const int m0 = mt * 256, n0 = nt * 256;
    f32x16 acc[4][2];
    zero_acc(acc);
    gemm_main<2, 4, 4, 2>(hb, [&](int row) { return min(m0 + row, T - 1) * D; }, 64, W, D, n0, D / 64, T - m0, acc, smem);
    const int n0w = n0 + wn * 64;
#pragma unroll
    for (int tm = 0; tm < 4; ++tm) {
      const int m = m0 + wm * 128 + tm * 32 + r;
      const bool valid = m < T;
      const int mm = valid ? m : T - 1;
      const int b = mm / L, pos = mm - b * L;
      const float rs = rsqrtf(ss1[mm] * (1.f / 1024.f) + EPS);
#pragma unroll
      for (int tn = 0; tn < 2; ++tn)
#pragma unroll
        for (int i = 0; i < 16; ++i) acc[tm][tn][i] *= rs;
      float ssq = 0.f;
#pragma unroll
      for (int tn = 0; tn < 2; ++tn)
#pragma unroll
        for (int i = 0; i < 16; ++i) ssq += acc[tm][tn][i] * acc[tm][tn][i];
      if (n0w < 2304) {
        int kind, head, nh;
        const float* gain = nullptr;
        float scale = 1.f;
        bf16_t* dst;
        if (n0w < 512) { kind = 0; head = n0w >> 6; nh = 8; gain = p.in[5] + l * 64; scale = 0.125f * LOG2E; dst = (bf16_t*)(ws + A_QF); }
        else if (n0w < 1024) { kind = 0; head = (n0w - 512) >> 6; nh = 8; gain = p.in[6] + l * 64; dst = (bf16_t*)(ws + A_KF); }
        else if (n0w < 1536) { kind = 1; head = (n0w - 1024) >> 6; nh = 8; dst = (bf16_t*)(ws + A_VF); }
        else if (n0w < 2048) { kind = 0; head = (n0w - 1536) >> 6; nh = 8; gain = p.in[13] + l * 64; scale = 0.125f * LOG2E; dst = (bf16_t*)(ws + A_QS); }
        else if (n0w < 2176) { kind = 0; head = (n0w - 2048) >> 6; nh = 2; gain = p.in[14] + l * 64; dst = (bf16_t*)(ws + A_KS); }
        else { kind = 1; head = (n0w - 2176) >> 6; nh = 2; dst = (bf16_t*)(ws + A_VS); }
        if (kind == 0) {
          const float tot = xor32(ssq);
          const float rr = rsqrtf(tot * (1.f / 64.f) + EPS) * scale;
          bf16_t* drow = dst + ((size_t)(b * nh + head) * LP + pos) * 64;
#pragma unroll
          for (int tn = 0; tn < 2; ++tn)
#pragma unroll
            for (int g4 = 0; g4 < 4; ++g4) {
              const int d = tn * 32 + 8 * g4 + 4 * h;
              const f32x4 gv = *(const f32x4*)(gain + d);
              uint2 o = pk4(acc[tm][tn][4 * g4] * rr * gv[0], acc[tm][tn][4 * g4 + 1] * rr * gv[1],
                            acc[tm][tn][4 * g4 + 2] * rr * gv[2], acc[tm][tn][4 * g4 + 3] * rr * gv[3]);
              if (valid) *(uint2*)(drow + d) = o;
            }
        } else {
          bf16_t* dcol = dst + ((size_t)(b * nh + head) * 64) * LP + pos;
          if (valid) {
#pragma unroll
            for (int tn = 0; tn < 2; ++tn)
#pragma unroll
              for (int i = 0; i < 16; ++i) {
                const int d = tn * 32 + (i & 3) + 8 * (i >> 2) + 4 * h;
                dcol[(size_t)d * LP] = f2bf(acc[tm][tn][i]);
              }
          }
        }
      } else if (n0w < 2688) {
        bf16_t* dst;
        float* ssd;
        int ld, c0;
        if (n0w < 2560) { dst = (bf16_t*)(ws + A_CQ); ssd = ss_cq; ld = 256; c0 = n0w - 2304; }
        else { dst = (bf16_t*)(ws + A_CKV); ssd = ss_ckv; ld = 128; c0 = n0w - 2560; }
        const float tot = xor32(ssq);
        if (valid) {
#pragma unroll
          for (int tn = 0; tn < 2; ++tn)
#pragma unroll
            for (int g4 = 0; g4 < 4; ++g4) {
              const int d = c0 + tn * 32 + 8 * g4 + 4 * h;
              *(uint2*)(dst + (size_t)m * ld + d) =
                  pk4(acc[tm][tn][4 * g4], acc[tm][tn][4 * g4 + 1], acc[tm][tn][4 * g4 + 2], acc[tm][tn][4 * g4 + 3]);
            }
          if (h == 0) atomicAdd(ssd + m, tot);
        }
      } else if (n0w == 2688) {
        float s0 = 0.f;
#pragma unroll
        for (int i = 0; i < 16; ++i) s0 += acc[tm][0][i] * acc[tm][0][i];
        s0 = xor32(s0);
        if (valid) {
          bf16_t* kr = (bf16_t*)(ws + OFF_KR) + (size_t)m * 32;
#pragma unroll
          for (int g4 = 0; g4 < 4; ++g4)
            *(uint2*)(kr + 8 * g4 + 4 * h) =
                pk4(acc[tm][0][4 * g4], acc[tm][0][4 * g4 + 1], acc[tm][0][4 * g4 + 2], acc[tm][0][4 * g4 + 3]);
          if (h == 0) ss_kr[m] = s0;
          float* lf = (float*)(ws + OFF_LF) + (size_t)m * 8 + 4 * h;
          f32x4 o;
#pragma unroll
          for (int j = 0; j < 4; ++j) {
            float x = acc[tm][1][j] + p.in[4][l * 8 + 4 * h + j];
            o[j] = fminf(x, 0.f) - log1pf(__expf(-fabsf(x)));
          }
          *(f32x4*)lf = o;
        }
      }
    }
  }
}

DI void phase_mla_up(const Params& p, int l, char* smem) {
  unsigned char* ws = p.ws;
  const int lane = threadIdx.x & 63, wid = __builtin_amdgcn_readfirstlane(threadIdx.x >> 6), r = lane & 31, h = lane >> 5;
  const float* rope_c = (const float*)(ws + OFF_ROPE);
  const float* rope_s = rope_c + L * 16;
  constexpr int MT = 64;
  {
    const bf16_t* A = (const bf16_t*)(ws + A_CQ);
    const bf16_t* W = (const bf16_t*)(ws + OFF_WQUP);
    const float* ssc = (const float*)(ws + OFF_SS) + (size_t)(4 + l) * T;
    const float* g = p.in[11] + l * 96;
    bf16_t* Qm = (bf16_t*)(ws + A_QM);
    const float qscale = 0.10206207261596575f * LOG2E;
    auto epi = [&](f32x16 (&acc)[1][3], int m, int head) {
      const int b = m / L, pos = m - b * L;
      const float rs = rsqrtf(ssc[m] * (1.f / 256.f) + EPS);
      float ssq = 0.f;
#pragma unroll
      for (int tn = 0; tn < 3; ++tn)
#pragma unroll
        for (int i = 0; i < 16; ++i) { acc[0][tn][i] *= rs; ssq += acc[0][tn][i] * acc[0][tn][i]; }
      ssq = xor32(ssq);
      const float rr = rsqrtf(ssq * (1.f / 96.f) + EPS);
      bf16_t* drow = Qm + ((size_t)(b * 8 + head) * LP + pos) * 96;
#pragma unroll
      for (int tn = 0; tn < 2; ++tn)
#pragma unroll
        for (int g4 = 0; g4 < 4; ++g4) {
          const int d = tn * 32 + 8 * g4 + 4 * h;
          const f32x4 gv = *(const f32x4*)(g + d);
          *(uint2*)(drow + d) = pk4(acc[0][tn][4 * g4] * rr * gv[0] * qscale, acc[0][tn][4 * g4 + 1] * rr * gv[1] * qscale,
                                    acc[0][tn][4 * g4 + 2] * rr * gv[2] * qscale, acc[0][tn][4 * g4 + 3] * rr * gv[3] * qscale);
        }
#pragma unroll
      for (int g4 = 0; g4 < 2; ++g4) {
        const int c = 8 * g4 + 4 * h;
        const f32x4 g1 = *(const f32x4*)(g + 64 + c);
        const f32x4 g2 = *(const f32x4*)(g + 80 + c);
        const f32x4 cs = *(const f32x4*)(rope_c + pos * 16 + c);
        const f32x4 sn = *(const f32x4*)(rope_s + pos * 16 + c);
        float o1[4], o2[4];
#pragma unroll
        for (int j = 0; j < 4; ++j) {
          float x1 = acc[0][2][4 * g4 + j] * rr * g1[j];
          float x2 = acc[0][2][4 * g4 + 8 + j] * rr * g2[j];
          o1[j] = (x1 * cs[j] - x2 * sn[j]) * qscale;
          o2[j] = (x2 * cs[j] + x1 * sn[j]) * qscale;
        }
        *(uint2*)(drow + 64 + c) = pk4(o1[0], o1[1], o1[2], o1[3]);
        *(uint2*)(drow + 80 + c) = pk4(o2[0], o2[1], o2[2], o2[3]);
      }
    };
    for (int t = blockIdx.x; t < 8 * MT; t += gridDim.x) {
      const int head = t % 8, mt = t / 8;
      const int m0 = mt * 256;
      f32x16 acc[1][3];
      zero_acc(acc);
      gemm_main<8, 1, 1, 3>(A, [&](int row) { return (m0 + row) * 256; }, 64, W, 256, head * 96, 4, 256, acc, smem);
      epi(acc, m0 + wid * 32 + r, head);
    }
    for (int nt = (int)blockIdx.x - 8; nt >= 0 && nt < 2; nt += gridDim.x) {
      const int wm = wid >> 2, wn = wid & 3;
      f32x16 acc[1][3];
      zero_acc(acc);
      gemm_main<2, 4, 1, 3>(A, [&](int row) { return min(16384 + row, T - 1) * 256; }, 64, W, 256, nt * 384, 4, 64, acc, smem);
      epi(acc, 16384 + wm * 32 + r, nt * 4 + wn);
    }
  }
  {
    const bf16_t* A = (const bf16_t*)(ws + A_CKV);
    const bf16_t* W = (const bf16_t*)(ws + OFF_WKVUP);
    const float* ssc = (const float*)(ws + OFF_SS) + (size_t)(6 + l) * T;
    const float* ss_kr = (const float*)(ws + OFF_SSKR);
    const bf16_t* krp = (const bf16_t*)(ws + OFF_KR);
    const float* g = p.in[12] + l * 96;
    bf16_t* Km = (bf16_t*)(ws + A_KM);
    bf16_t* Vm = (bf16_t*)(ws + A_VM);
    auto epi = [&](f32x16 (&a)[2], int m, int head, int part) {
      const int b = m / L, pos = m - b * L;
      const float rs = rsqrtf(ssc[m] * (1.f / 128.f) + EPS);
      float ssq = 0.f;
#pragma unroll
      for (int tn = 0; tn < 2; ++tn)
#pragma unroll
        for (int i = 0; i < 16; ++i) { a[tn][i] *= rs; ssq += a[tn][i] * a[tn][i]; }
      ssq = xor32(ssq);
      if (part == 0) {
        const float rr = rsqrtf((ssq + ss_kr[m]) * (1.f / 96.f) + EPS);
        bf16_t* drow = Km + ((size_t)(b * 8 + head) * LP + pos) * 96;
#pragma unroll
        for (int tn = 0; tn < 2; ++tn)
#pragma unroll
          for (int g4 = 0; g4 < 4; ++g4) {
            const int d = tn * 32 + 8 * g4 + 4 * h;
            const f32x4 gv = *(const f32x4*)(g + d);
            *(uint2*)(drow + d) = pk4(a[tn][4 * g4] * rr * gv[0], a[tn][4 * g4 + 1] * rr * gv[1], a[tn][4 * g4 + 2] * rr * gv[2],
                                      a[tn][4 * g4 + 3] * rr * gv[3]);
          }
        const int c0 = 8 * h;
        const bf16x8 k1 = *(const bf16x8*)(krp + (size_t)m * 32 + c0);
        const bf16x8 k2 = *(const bf16x8*)(krp + (size_t)m * 32 + 16 + c0);
        float o1[8], o2[8];
#pragma unroll
        for (int j = 0; j < 8; ++j) {
          float x1 = bf2f((bf16_t)k1[j]) * rr * g[64 + c0 + j];
          float x2 = bf2f((bf16_t)k2[j]) * rr * g[80 + c0 + j];
          float cs = rope_c[pos * 16 + c0 + j], sn = rope_s[pos * 16 + c0 + j];
          o1[j] = x1 * cs - x2 * sn;
          o2[j] = x2 * cs + x1 * sn;
        }
        *(uint4*)(drow + 64 + c0) = make_uint4(pk2(o1[0], o1[1]), pk2(o1[2], o1[3]), pk2(o1[4], o1[5]), pk2(o1[6], o1[7]));
        *(uint4*)(drow + 80 + c0) = make_uint4(pk2(o2[0], o2[1]), pk2(o2[2], o2[3]), pk2(o2[4], o2[5]), pk2(o2[6], o2[7]));
      } else {
        bf16_t* dcol = Vm + ((size_t)(b * 8 + head) * 64) * LP + pos;
#pragma unroll
        for (int tn = 0; tn < 2; ++tn)
#pragma unroll
          for (int i = 0; i < 16; ++i) {
            const int d = tn * 32 + (i & 3) + 8 * (i >> 2) + 4 * h;
            dcol[(size_t)d * LP] = f2bf(a[tn][i]);
          }
      }
    };
    {
      const int wm = wid >> 1, wn = wid & 1;
      for (int t = blockIdx.x; t < 8 * MT; t += gridDim.x) {
        const int head = t % 8, mt = t / 8;
        const int m0 = mt * 256;
        f32x16 acc[2][2];
        zero_acc(acc);
        gemm_main<4, 2, 2, 2>(A, [&](int row) { return (m0 + row) * 128; }, 64, W, 128, head * 128, 2, 256, acc, smem);
#pragma unroll
        for (int tm = 0; tm < 2; ++tm) epi(acc[tm], m0 + wm * 64 + tm * 32 + r, head, wn);
      }
    }
    for (int nt = (int)blockIdx.x - 16; nt >= 0 && nt < 4; nt += gridDim.x) {
      const int wm = wid >> 2, wn = wid & 3;
      f32x16 acc[1][2];
      zero_acc(acc);
      gemm_main<2, 4, 1, 2>(A, [&](int row) { return min(16384 + row, T - 1) * 128; }, 64, W, 128, nt * 256, 2, 64, acc, smem);
      epi(acc[0], 16384 + wm * 32 + r, nt * 2 + (wn >> 1), wn & 1);
    }
  }
  {
    const float* lf = (const float*)(ws + OFF_LF);
    float* cd = (float*)(ws + OFF_CDEC);
    float* wtot = (float*)smem;
    const int tid = threadIdx.x;
    for (int s = (int)blockIdx.x - 32; s >= 0 && s < 32; s += gridDim.x) {
      const int b = s >> 3, hd = s & 7;
      float v[9];
#pragma unroll
      for (int c = 0; c < 9; ++c) {
        const int pos = tid * 9 + c;
        v[c] = pos < L ? lf[((size_t)(b * L + pos)) * 8 + hd] : 0.f;
      }
#pragma unroll
      for (int c = 1; c < 9; ++c) v[c] += v[c - 1];
      float tot = v[8];
#pragma unroll
      for (int o = 1; o < 64; o <<= 1) {
        float u = __shfl_up(tot, o);
        if (lane >= o) tot += u;
      }
      __syncthreads();
      if (lane == 63) wtot[wid] = tot;
      __syncthreads();
      float base = tot - v[8];
      for (int w = 0; w < wid; ++w) base += wtot[w];
#pragma unroll
      for (int c = 0; c < 9; ++c) {
        const int pos = tid * 9 + c;
        if (pos < L) cd[(size_t)s * LP + pos] = v[c] + base;
      }
    }
  }
}

template <int DK, int MODE>
DI void attn_item(bf16_t* Qs, const bf16_t* __restrict__ Ks, const bf16_t* __restrict__ Vt, const float* __restrict__ cdec,
                  int q0, int q_end, float slope2, float sink2, char* smem) {
  constexpr int KROW = (DK + 8) * 2;
  constexpr int KSZ = 64 * KROW;
  constexpr int VSZ = 64 * 136;
  constexpr int STAGE = KSZ + VSZ + 256;
  constexpr int NKC = DK / 8;
  constexpr int NKT = 64 * NKC;
  constexpr int NKL = (NKT + 511) / 512;
  constexpr int NS = DK / 16;
  const int tid = threadIdx.x, lane = tid & 63, w = __builtin_amdgcn_readfirstlane(tid >> 6), r = lane & 31, h = lane >> 5;
  const int qi = q0 + w * 32 + r;
  const bool wave_on = q0 + w * 32 < q_end;
  bf16x8 qf[NS];
#pragma unroll
  for (int s = 0; s < NS; ++s) qf[s] = *(const bf16x8*)(Qs + (size_t)qi * DK + s * 16 + 8 * h);
  const int kt_hi = (q_end - 1) >> 6;
  int t_lo = 0, ntiles;
  if (MODE == 2) { t_lo = max(1, (q0 - 127) >> 6); ntiles = 1 + max(0, kt_hi - t_lo + 1); }
  else ntiles = kt_hi + 1;
  auto tile_of = [&](int j) { return MODE == 2 ? (j == 0 ? 0 : t_lo + j - 1) : j; };

  bf16x8 rk[NKL], rv;
  float rc = 0.f;
  auto gload = [&](int tile) {
    const int k0 = tile * 64;
#pragma unroll
    for (int i = 0; i < NKL; ++i) {
      const int c = tid + i * 512, row = c / NKC, cc = c % NKC;
      if (NKT % 512 == 0 || c < NKT) rk[i] = *(const bf16x8*)(Ks + (size_t)(k0 + row) * DK + cc * 8);
    }
    {
      const int row = tid >> 3, cc = tid & 7;
      rv = *(const bf16x8*)(Vt + (size_t)row * LP + k0 + cc * 8);
    }
    if (MODE == 0 && tid < 64) rc = cdec[k0 + tid] * LOG2E;
  };
  auto sstore = [&](int s) {
    char* kb = smem + s * STAGE;
    char* vb = kb + KSZ;
#pragma unroll
    for (int i = 0; i < NKL; ++i) {
      const int c = tid + i * 512, row = c / NKC, cc = c % NKC;
      if (NKT % 512 == 0 || c < NKT) *(bf16x8*)(kb + row * KROW + cc * 16) = rk[i];
    }
    {
      const int row = tid >> 3, cc = tid & 7;
      s16x4 lo = {rv[0], rv[1], rv[2], rv[3]}, hi = {rv[4], rv[5], rv[6], rv[7]};
      *(s16x4*)(vb + row * 136 + cc * 16) = lo;
      *(s16x4*)(vb + row * 136 + cc * 16 + 8) = hi;
    }
    if (MODE == 0 && tid < 64) *(float*)(vb + VSZ + tid * 4) = rc;
  };

  f32x16 o[2];
#pragma unroll
  for (int i = 0; i < 16; ++i) { o[0][i] = 0.f; o[1][i] = 0.f; }
  float m_run = -1e30f, l_run = 0.f;

  gload(tile_of(0));
  sstore(0);
#pragma unroll
  for (int s = 0; s < NS; ++s) asm volatile("" ::"v"(qf[s]));
  __syncthreads();
  for (int j = 0; j < ntiles; ++j) {
    if (j + 1 < ntiles) gload(tile_of(j + 1));
    __builtin_amdgcn_sched_barrier(0);
    const int k0 = tile_of(j) * 64;
    const char* kb = smem + (j & 1) * STAGE;
    const char* vb = kb + KSZ;
    bool active = wave_on && (k0 <= q0 + w * 32 + 31);
    if (MODE == 2) active = active && (k0 == 0 || k0 + 63 >= q0 + w * 32 - 127);
    if (active) {
      f32x16 s[2];
#pragma unroll
      for (int kt = 0; kt < 2; ++kt) {
#pragma unroll
        for (int i = 0; i < 16; ++i) s[kt][i] = 0.f;
#pragma unroll
        for (int ks = 0; ks < NS; ++ks) {
          bf16x8 kf = *(const bf16x8*)(kb + (kt * 32 + r) * KROW + ks * 32 + h * 16);
          s[kt] = mfma32(kf, qf[ks], s[kt]);
        }
      }
      const bool need_mask = (MODE == 2) || (k0 + 63 > q0 + w * 32);
      float mx = -1e30f;
      if (MODE == 0 || MODE == 2) {
#pragma unroll
        for (int kt = 0; kt < 2; ++kt)
#pragma unroll
          for (int g4 = 0; g4 < 4; ++g4) {
            const int kj0 = k0 + kt * 32 + 8 * g4 + 4 * h;
            f32x4 ck;
            if (MODE == 0) ck = *(const f32x4*)(vb + VSZ + (kt * 32 + 8 * g4 + 4 * h) * 4);
#pragma unroll
            for (int jj = 0; jj < 4; ++jj) {
              if (MODE == 0) s[kt][4 * g4 + jj] -= ck[jj];
              if (MODE == 2) s[kt][4 * g4 + jj] -= slope2 * (float)(qi - kj0 - jj);
            }
          }
      }
      if (__builtin_amdgcn_readfirstlane((int)need_mask)) {
#pragma unroll
        for (int kt = 0; kt < 2; ++kt)
#pragma unroll
          for (int i = 0; i < 16; ++i) {
            const int kj = k0 + kt * 32 + (i & 3) + 8 * (i >> 2) + 4 * h;
            bool ok = kj <= qi;
            if (MODE == 2) ok = ok && (kj < 16 || qi - kj < 128);
            s[kt][i] = ok ? s[kt][i] : -1e30f;
          }
        asm volatile("" ::: "memory");
      }
#pragma unroll
      for (int kt = 0; kt < 2; ++kt)
#pragma unroll
        for (int i = 0; i < 16; ++i) mx = fmaxf(mx, s[kt][i]);
      mx = max32(mx);
      const float m_new = fmaxf(m_run, mx);
      const float alpha = fexp2(m_run - m_new);
      m_run = m_new;
      float psum = 0.f;
#pragma unroll
      for (int kt = 0; kt < 2; ++kt)
#pragma unroll
        for (int i = 0; i < 16; ++i) {
          float pv = fexp2(s[kt][i] - m_new);
          s[kt][i] = pv;
          psum += pv;
        }
      l_run = l_run * alpha + psum;
      if (__builtin_amdgcn_ballot_w64(alpha != 1.f) != 0ull) {
#pragma unroll
        for (int i = 0; i < 16; ++i) { o[0][i] *= alpha; o[1][i] *= alpha; }
      }
#pragma unroll
      for (int kt = 0; kt < 2; ++kt)
#pragma unroll
        for (int st = 0; st < 2; ++st) {
          unsigned pw[4];
#pragma unroll
          for (int u = 0; u < 4; ++u) pw[u] = pk2(s[kt][8 * st + 2 * u], s[kt][8 * st + 2 * u + 1]);
          uint4 pu = make_uint4(pw[0], pw[1], pw[2], pw[3]);
          const bf16x8 pf = __builtin_bit_cast(bf16x8, pu);
#pragma unroll
          for (int dt = 0; dt < 2; ++dt) {
            const char* va = vb + (dt * 32 + r) * 136 + (kt * 32 + 16 * st + 4 * h) * 2;
            const s16x4 lo = *(const s16x4*)va;
            const s16x4 hi = *(const s16x4*)(va + 16);
            const bf16x8 vf = {lo[0], lo[1], lo[2], lo[3], hi[0], hi[1], hi[2], hi[3]};
            o[dt] = mfma32(vf, pf, o[dt]);
          }
        }
    }
    __builtin_amdgcn_sched_barrier(0);
    if (j + 1 < ntiles) sstore((j + 1) & 1);
    __syncthreads();
  }
  float lt = xor32(l_run);
  if (MODE == 2) lt += fexp2(sink2 - m_run);
  const float inv = 1.f / lt;
  if (qi < q_end) {
    bf16_t* orow = Qs + (size_t)qi * DK;
#pragma unroll
    for (int dt = 0; dt < 2; ++dt)
#pragma unroll
      for (int g4 = 0; g4 < 4; ++g4) {
        const int d = dt * 32 + 8 * g4 + 4 * h;
        *(uint2*)(orow + d) = pk4(o[dt][4 * g4] * inv, o[dt][4 * g4 + 1] * inv, o[dt][4 * g4 + 2] * inv, o[dt][4 * g4 + 3] * inv);
      }
  }
}

DI int next_item(unsigned* ctr, int* sidx) {
  if (threadIdx.x == 0) *sidx = (int)atomicAdd(ctr, 1u);
  __syncthreads();
  const int idx = *sidx;
  __syncthreads();
  return idx;
}
DI void phase_attn(const Params& p, int l, char* smem) {
  unsigned char* ws = p.ws;
  unsigned* ctr = (unsigned*)(ws + OFF_CTR) + l * 4;
  int* sidx = (int*)(smem + 147456);
  constexpr int NQT = 17, NIT = 32 * NQT;
#pragma unroll 1
  while (true) {
    const int idx = next_item(ctr, sidx);
    if (idx >= NIT) break;
    const int qt = NQT - 1 - (idx >> 5), bh = idx & 31;
    const int q0 = qt == 0 ? 0 : 16 + 256 * (qt - 1), q_end = qt == 0 ? 16 : q0 + 256;
    attn_item<64, 0>((bf16_t*)(ws + A_QF) + (size_t)bh * LP * 64, (const bf16_t*)(ws + A_KF) + (size_t)bh * LP * 64,
                     (const bf16_t*)(ws + A_VF) + (size_t)bh * 64 * LP, (const float*)(ws + OFF_CDEC) + (size_t)bh * LP, q0, q_end,
                     0.f, 0.f, smem);
  }
#pragma unroll 1
  while (true) {
    const int idx = next_item(ctr + 1, sidx);
    if (idx >= NIT) break;
    const int qt = NQT - 1 - (idx >> 5), bh = idx & 31;
    const int q0 = qt == 0 ? 0 : 16 + 256 * (qt - 1), q_end = qt == 0 ? 16 : q0 + 256;
    attn_item<96, 1>((bf16_t*)(ws + A_QM) + (size_t)bh * LP * 96, (const bf16_t*)(ws + A_KM) + (size_t)bh * LP * 96,
                     (const bf16_t*)(ws + A_VM) + (size_t)bh * 64 * LP, nullptr, q0, q_end, 0.f, 0.f, smem);
  }
#pragma unroll 1
  while (true) {
    const int idx = next_item(ctr + 2, sidx);
    if (idx >= NIT) break;
    const int qt = idx >> 5, bh = idx & 31, b = bh >> 3, hq = bh & 7, hk = hq >> 2;
    const int q0 = qt == 0 ? 0 : 16 + 256 * (qt - 1), q_end = qt == 0 ? 16 : q0 + 256;
    const float slope2 = fexp2(-(float)(hq + 1)) * LOG2E;
    const float sink2 = p.in[15][l * 8 + hq] * LOG2E;
    attn_item<64, 2>((bf16_t*)(ws + A_QS) + (size_t)bh * LP * 64, (const bf16_t*)(ws + A_KS) + (size_t)(b * 2 + hk) * LP * 64,
                     (const bf16_t*)(ws + A_VS) + (size_t)(b * 2 + hk) * 64 * LP, nullptr, q0, q_end, slope2, sink2, smem);
  }
}

DI void phase_merge(const Params& p, int l, char* smem) {
  unsigned char* ws = p.ws;
  const bf16_t* hb = (const bf16_t*)(ws + OFF_HB);
  const bf16_t* Wg = (const bf16_t*)(ws + OFF_WG);
  const bf16_t* Wb = (const bf16_t*)(ws + OFF_WBR);
  const float* ss1 = (const float*)(ws + OFF_SS) + (size_t)(l * 2) * T;
  bf16_t* merged = (bf16_t*)(ws + A_MERGED);
  const int lane = threadIdx.x & 63, wid = __builtin_amdgcn_readfirstlane(threadIdx.x >> 6), r = lane & 31, h = lane >> 5, wm = wid >> 1, wn = wid & 1;
  constexpr int NT = 8, MT = 64;
  TileIter tit(NT * MT);
  for (int t = tit.next(); t >= 0; t = tit.next()) {
    const int nt = t % NT, mt = t / NT;
    const int m0 = mt * 256, n0 = nt * 128;
    float rs[2];
#pragma unroll
    for (int tm = 0; tm < 2; ++tm) rs[tm] = rsqrtf(ss1[min(m0 + wm * 64 + tm * 32 + r, T - 1)] * (1.f / 1024.f) + EPS);
#pragma unroll 1
    for (int n = 0; n < 3; ++n) {
      f32x16 acc[2][2];
      zero_acc(acc);
      gemm_main<4, 2, 2, 2, false>(hb, [&](int row) { return min(m0 + row, T - 1) * D; }, 64, Wg + (size_t)n * 1024 * 1024, D, n0, D / 64,
                            T - m0, acc, smem);
      unsigned gp[2][2][8];
#pragma unroll
      for (int tm = 0; tm < 2; ++tm)
#pragma unroll
      for (int tn = 0; tn < 2; ++tn)
#pragma unroll
        for (int u = 0; u < 8; ++u) {
          float a = __builtin_amdgcn_rcpf(1.f + __expf(-acc[tm][tn][2 * u] * rs[tm]));
          float bq = __builtin_amdgcn_rcpf(1.f + __expf(-acc[tm][tn][2 * u + 1] * rs[tm]));
          gp[tm][tn][u] = pk2(a, bq);
        }
      zero_acc(acc);
      const bf16_t* Ab;
      int rstride, kstride;
      if (n == 0) { Ab = (const bf16_t*)(ws + A_QF); rstride = 64; kstride = LP * 64; }
      else if (n == 1) { Ab = (const bf16_t*)(ws + A_QM); rstride = 96; kstride = LP * 96; }
      else { Ab = (const bf16_t*)(ws + A_QS); rstride = 64; kstride = LP * 64; }
      gemm_main<4, 2, 2, 2, false>(Ab, [&](int row) {
        int mr = min(m0 + row, T - 1);
        int b = mr / L, pos = mr - b * L;
        return (b * 8 * LP + pos) * rstride; }, kstride, Wb + (size_t)n * 1024 * 512, 512, n0, 8, T - m0, acc, smem);
#pragma unroll
      for (int tm = 0; tm < 2; ++tm) {
        const int m = m0 + wm * 64 + tm * 32 + r;
        if (m < T) {
#pragma unroll
          for (int tn = 0; tn < 2; ++tn)
#pragma unroll
            for (int g4 = 0; g4 < 4; ++g4) {
              const int col = n0 + wn * 64 + tn * 32 + 8 * g4 + 4 * h;
              uint2* dst = (uint2*)(merged + (size_t)m * D + col);
              uint2 old = make_uint2(0u, 0u);
              if (n > 0) old = *dst;
              const unsigned g0 = gp[tm][tn][2 * g4], g1 = gp[tm][tn][2 * g4 + 1];
              float f0 = __uint_as_float(g0 << 16) * acc[tm][tn][4 * g4] + __uint_as_float(old.x << 16);
              float f1 = __uint_as_float(g0 & 0xffff0000u) * acc[tm][tn][4 * g4 + 1] + __uint_as_float(old.x & 0xffff0000u);
              float f2 = __uint_as_float(g1 << 16) * acc[tm][tn][4 * g4 + 2] + __uint_as_float(old.y << 16);
              float f3 = __uint_as_float(g1 & 0xffff0000u) * acc[tm][tn][4 * g4 + 3] + __uint_as_float(old.y & 0xffff0000u);
              *dst = pk4(f0, f1, f2, f3);
            }
        }
      }
    }
  }
  {
    const int wm1 = wid >> 2, wn1 = wid & 3;
    for (int nt = blockIdx.x; nt < 8; nt += gridDim.x) {
      const int m0 = 16384, n0 = nt * 128;
      const int m = m0 + wm1 * 32 + r;
      const float rs1 = rsqrtf(ss1[m] * (1.f / 1024.f) + EPS);
#pragma unroll 1
      for (int n = 0; n < 3; ++n) {
        f32x16 acc[1][1];
        zero_acc(acc);
        gemm_rem(hb, [&](int row) { return min(m0 + row, T - 1) * D; }, 64, Wg + (size_t)n * 1024 * 1024, D, n0, D / 64, acc[0][0], smem);
        unsigned gp[8];
#pragma unroll
        for (int u = 0; u < 8; ++u)
          gp[u] = pk2(__builtin_amdgcn_rcpf(1.f + __expf(-acc[0][0][2 * u] * rs1)), __builtin_amdgcn_rcpf(1.f + __expf(-acc[0][0][2 * u + 1] * rs1)));
        zero_acc(acc);
        const bf16_t* Ab;
        int rstride, kstride;
        if (n == 0) { Ab = (const bf16_t*)(ws + A_QF); rstride = 64; kstride = LP * 64; }
        else if (n == 1) { Ab = (const bf16_t*)(ws + A_QM); rstride = 96; kstride = LP * 96; }
        else { Ab = (const bf16_t*)(ws + A_QS); rstride = 64; kstride = LP * 64; }
        gemm_rem(Ab, [&](int row) {
          int mr = min(m0 + row, T - 1);
          int b = mr / L, pos = mr - b * L;
          return (b * 8 * LP + pos) * rstride; }, kstride, Wb + (size_t)n * 1024 * 512, 512, n0, 8, acc[0][0], smem);
#pragma unroll
        for (int g4 = 0; g4 < 4; ++g4) {
          const int col = n0 + wn1 * 32 + 8 * g4 + 4 * h;
          uint2* dst = (uint2*)(merged + (size_t)m * D + col);
          uint2 old = make_uint2(0u, 0u);
          if (n > 0) old = *dst;
          const unsigned g0 = gp[2 * g4], g1 = gp[2 * g4 + 1];
          float f0 = __uint_as_float(g0 << 16) * acc[0][0][4 * g4] + __uint_as_float(old.x << 16);
          float f1 = __uint_as_float(g0 & 0xffff0000u) * acc[0][0][4 * g4 + 1] + __uint_as_float(old.x & 0xffff0000u);
          float f2 = __uint_as_float(g1 << 16) * acc[0][0][4 * g4 + 2] + __uint_as_float(old.y << 16);
          float f3 = __uint_as_float(g1 & 0xffff0000u) * acc[0][0][4 * g4 + 3] + __uint_as_float(old.y & 0xffff0000u);
          *dst = pk4(f0, f1, f2, f3);
        }
      }
    }
  }
}


DI void stage_half(const f32x16 (&acc)[4][2], int hp, int wm, int wn, int r, int h, const float (&rowscale)[4], float* stg) {
  if ((wn >> 1) == hp) {
#pragma unroll
    for (int tm = 0; tm < 4; ++tm) {
      float* srow = stg + (wm * 128 + tm * 32 + r) * 132 + (wn & 1) * 64 + 4 * h;
#pragma unroll
      for (int tn = 0; tn < 2; ++tn)
#pragma unroll
        for (int g4 = 0; g4 < 4; ++g4) {
          f32x4 v = {acc[tm][tn][4 * g4] * rowscale[tm], acc[tm][tn][4 * g4 + 1] * rowscale[tm],
                     acc[tm][tn][4 * g4 + 2] * rowscale[tm], acc[tm][tn][4 * g4 + 3] * rowscale[tm]};
          *(f32x4*)(srow + tn * 32 + 8 * g4) = v;
        }
    }
  }
}

DI void phase_resid(const Params& p, const bf16_t* A, int K, const bf16_t* W, float* ss_next, bool last, char* smem) {
  unsigned char* ws = p.ws;
  bf16_t* hb = (bf16_t*)(ws + OFF_HB);
  const int tid = threadIdx.x, lane = tid & 63, wid = __builtin_amdgcn_readfirstlane(tid >> 6), r = lane & 31, h = lane >> 5, wm = wid >> 2, wn = wid & 3;
  constexpr int NT = 4, MT = 64;
  float* stg = (float*)smem;
  TileIter tit(NT * MT);
  for (int t = tit.next(); t >= 0; t = tit.next()) {
    const int nt = t % NT, mt = t / NT;
    const int m0 = mt * 256, n0 = nt * 256;
    f32x16 acc[4][2];
    zero_acc(acc);
    gemm_main<2, 4, 4, 2>(A, [&](int row) { return min(m0 + row, T - 1) * K; }, 64, W, K, n0, K / 64, T - m0, acc, smem);
    const float ones[4] = {1.f, 1.f, 1.f, 1.f};
#pragma unroll 1
    for (int hp = 0; hp < 2; ++hp) {
      const int chunk = tid & 15;
      const int col = n0 + hp * 128 + chunk * 8;
      f32x4 h0[2], h1[2];
      auto hptr = [&](int it) {
        const int m = m0 + (tid >> 4) + 32 * it;
        const int b = m / L, pos = m - b * L;
        return hrow(p, b, pos) + col;
      };
      auto issue = [&](int bt) {
#pragma unroll
        for (int q = 0; q < 2; ++q) {
          const float* hp_ = hptr(bt * 2 + q);
          h0[q] = *(const f32x4*)hp_;
          h1[q] = *(const f32x4*)(hp_ + 4);
        }
      };
      auto process = [&](int bt) {
#pragma unroll
        for (int q = 0; q < 2; ++q) {
          const int row = (tid >> 4) + 32 * (bt * 2 + q);
          const int m = m0 + row;
          float* hp_ = hptr(bt * 2 + q);
          const f32x4 a0 = *(const f32x4*)(stg + row * 132 + chunk * 8);
          const f32x4 a1 = *(const f32x4*)(stg + row * 132 + chunk * 8 + 4);
          f32x4 v0, v1;
          float ssq = 0.f;
#pragma unroll
          for (int j = 0; j < 4; ++j) {
            v0[j] = a0[j] + h0[q][j];
            v1[j] = a1[j] + h1[q][j];
            ssq += v0[j] * v0[j] + v1[j] * v1[j];
          }
          *(f32x4*)hp_ = v0;
          *(f32x4*)(hp_ + 4) = v1;
          if (!last) {
            *(uint4*)(hb + (size_t)m * D + col) = make_uint4(pk2(v0[0], v0[1]), pk2(v0[2], v0[3]), pk2(v1[0], v1[1]), pk2(v1[2], v1[3]));
            ssq += __shfl_xor(ssq, 8);
            ssq += __shfl_xor(ssq, 4);
            ssq += __shfl_xor(ssq, 2);
            ssq += __shfl_xor(ssq, 1);
            if (chunk == 0) atomicAdd(ss_next + m, ssq);
          }
        }
      };
      issue(0);
      stage_half(acc, hp, wm, wn, r, h, ones, stg);
      __syncthreads();
      process(0);
#pragma unroll
      for (int bt = 1; bt < 4; ++bt) {
        __builtin_amdgcn_sched_barrier(0);
        issue(bt);
        process(bt);
      }
      __syncthreads();
    }
  }
  for (int nt = blockIdx.x; nt < 8; nt += gridDim.x) {
    const int m0 = 16384, n0 = nt * 128;
    f32x16 acc[1][1];
    zero_acc(acc);
    gemm_rem(A, [&](int row) { return min(m0 + row, T - 1) * K; }, 64, W, K, n0, K / 64, acc[0][0], smem);
    const int m = m0 + wm * 32 + r;
    const int b = m / L, pos = m - b * L;
    float* hr = hrow(p, b, pos);
    float ssq = 0.f;
    f32x4 hv[4];
#pragma unroll
    for (int g4 = 0; g4 < 4; ++g4) hv[g4] = *(const f32x4*)(hr + n0 + wn * 32 + 8 * g4 + 4 * h);
#pragma unroll
    for (int g4 = 0; g4 < 4; ++g4) {
      const int col = n0 + wn * 32 + 8 * g4 + 4 * h;
      f32x4 v;
#pragma unroll
      for (int j = 0; j < 4; ++j) { v[j] = hv[g4][j] + acc[0][0][4 * g4 + j]; ssq += v[j] * v[j]; }
      *(f32x4*)(hr + col) = v;
      if (!last) *(uint2*)(hb + (size_t)m * D + col) = pk4(v[0], v[1], v[2], v[3]);
    }
    ssq = xor32(ssq);
    if (!last && h == 0) atomicAdd(ss_next + m, ssq);
  }
}

DI void phase_up(const Params& p, int l, char* smem) {
  unsigned char* ws = p.ws;
  const bf16_t* hb = (const bf16_t*)(ws + OFF_HB);
  const bf16_t* W = (const bf16_t*)(ws + OFF_WUP);
  const float* ss2 = (const float*)(ws + OFF_SS) + (size_t)(l * 2 + 1) * T;
  const float* cw = p.in[20] + (size_t)l * 3 * 5632;
  const float* cb = p.in[21] + (size_t)l * 5632;
  bf16_t* act = (bf16_t*)(ws + A_ACT);
  const int tid = threadIdx.x, lane = tid & 63, wid = __builtin_amdgcn_readfirstlane(tid >> 6), r = lane & 31, h = lane >> 5, wm = wid >> 2, wn = wid & 3;
  constexpr int NT = 5632 / 256, MT = (T + 253) / 254;
  float* stg = (float*)smem;
  TileIter tit(NT * MT);
  for (int t = tit.next(); t >= 0; t = tit.next()) {
    const int nt = t % NT, mt = t / NT;
    const int mbase = mt * 254 - 2, n0 = nt * 256;
    f32x16 acc[4][2];
    zero_acc(acc);
    float rsv[4];
#pragma unroll
    for (int tm = 0; tm < 4; ++tm) rsv[tm] = ss2[min(max(mbase + wm * 128 + tm * 32 + r, 0), T - 1)];
    gemm_main<2, 4, 4, 2>(hb, [&](int row) { return min(max(mbase + row, 0), T - 1) * D; }, 64, W, D, n0, D / 64, T - mbase, acc,
                          smem);
#pragma unroll
    for (int tm = 0; tm < 4; ++tm) rsv[tm] = rsqrtf(rsv[tm] * (1.f / 1024.f) + EPS);
#pragma unroll 1
    for (int hp = 0; hp < 2; ++hp) {
      const int chunk = tid & 15, grp = chunk >> 3, jl0 = (chunk & 7) * 4;
      const int jg0 = (n0 / 64 + hp * 2 + grp) * 32 + jl0;
      f32x4 wg[3], wv[3];
#pragma unroll
      for (int i = 0; i < 3; ++i) {
        wg[i] = *(const f32x4*)(cw + i * 5632 + jg0);
        wv[i] = *(const f32x4*)(cw + i * 5632 + DFF + jg0);
      }
      const f32x4 bg = *(const f32x4*)(cb + jg0), bv = *(const f32x4*)(cb + DFF + jg0);
      stage_half(acc, hp, wm, wn, r, h, rsv, stg);
      __syncthreads();
      {
        const float* sgc = stg + grp * 64 + jl0;
#pragma unroll 2
        for (int it = 0; it < 8; ++it) {
          const int row = 2 + (tid >> 4) + 32 * it;
          const int gm = mbase + row;
          if (row < 256 && gm < T) {
            const int b = gm / L, pos = gm - b * L;
            const float* s0 = sgc + row * 132;
            const f32x4 g0 = *(const f32x4*)(s0), v0 = *(const f32x4*)(s0 + 32);
            const f32x4 g1 = *(const f32x4*)(s0 - 132), v1 = *(const f32x4*)(s0 - 132 + 32);
            const f32x4 g2 = *(const f32x4*)(s0 - 264), v2 = *(const f32x4*)(s0 - 264 + 32);
            float o[4];
#pragma unroll
            for (int j = 0; j < 4; ++j) {
              float a = bg[j] + wg[2][j] * g0[j], c = bv[j] + wv[2][j] * v0[j];
              if (pos >= 1) { a += wg[1][j] * g1[j]; c += wv[1][j] * v1[j]; }
              if (pos >= 2) { a += wg[0][j] * g2[j]; c += wv[0][j] * v2[j]; }
              o[j] = a * __builtin_amdgcn_rcpf(1.f + __expf(-a)) * c;
            }
            *(uint2*)(act + (size_t)gm * DFF + jg0) = pk4(o[0], o[1], o[2], o[3]);
          }
        }
      }
      __syncthreads();
    }
  }
}

#define XB_TMO      128
#define XB_XCNT(j)  (256  + 64 * (j))
#define XB_XSUB(j)  (1280 + 64 * (j))
#define XB_XGEN(j)  (2304 + 64 * (j))
#define XB_TOP      3328
#define XB_TOPGEN   3392
#define XB_SPIN_CAP (1u << 22)
DI unsigned xb_ld(unsigned* p) { return __hip_atomic_load(p, __ATOMIC_RELAXED, __HIP_MEMORY_SCOPE_AGENT); }
DI unsigned xb_add(unsigned* p, unsigned v) { return __hip_atomic_fetch_add(p, v, __ATOMIC_RELAXED, __HIP_MEMORY_SCOPE_AGENT); }
DI unsigned xb_xcc_id() { return (unsigned)__builtin_amdgcn_s_getreg((3 << 11) | 20) & 0xFu; }
#define XB_SPIN(cond, bar) do { unsigned _sp = 0; while (cond) { __builtin_amdgcn_s_sleep(1); \
    if ((++_sp & 255u) == 0u) { if (xb_ld(&(bar)[XB_TMO])) break; if (_sp > XB_SPIN_CAP) { atomicAdd(&(bar)[XB_TMO], 1u); break; } } } } while (0)
DI void xcd_barrier_complete(unsigned* bar, unsigned x, unsigned& nloc, unsigned& nx) {
  const unsigned G = gridDim.x;
  unsigned sum, cnt, mine, sp = 0u;
  for (;;) {
    sum = 0u; cnt = 0u; mine = 0u;
#pragma unroll
    for (unsigned j = 0; j < 16; ++j) { const unsigned c = xb_ld(&bar[XB_XCNT(j)]); sum += c; cnt += (c > 0u) ? 1u : 0u; mine = (j == x) ? c : mine; }
    if (sum == G) break;
    __builtin_amdgcn_s_sleep(1);
    if ((++sp & 255u) == 0u) { if (xb_ld(&bar[XB_TMO])) break; if (sp > XB_SPIN_CAP) { atomicAdd(&bar[XB_TMO], 1u); break; } }
  }
  nloc = mine > 0u ? mine : 1u; nx = cnt > 0u ? cnt : 1u;
}
DI void xcd_barrier(unsigned* bar, unsigned x, volatile unsigned* st) {
  asm volatile("s_waitcnt vmcnt(0)" ::: "memory");
  __syncthreads();
  if (threadIdx.x == 0) {
    __builtin_amdgcn_s_waitcnt(0);
    unsigned nloc = st[0], nx = st[1];
    if (nloc == 0u) { xcd_barrier_complete(bar, x, nloc, nx); st[0] = nloc; st[1] = nx; }
    const unsigned old = xb_add(&bar[XB_XSUB(x)], 1u);
    const unsigned gen = old / nloc;
    if (old + 1u == (gen + 1u) * nloc) {
      __builtin_amdgcn_fence(__ATOMIC_RELEASE, "agent");
      asm volatile("s_waitcnt vmcnt(0)" ::: "memory");
      const unsigned og = xb_add(&bar[XB_TOP], 1u);
      const unsigned tg = og / nx;
      if (og + 1u == (tg + 1u) * nx) xb_add(&bar[XB_TOPGEN], 1u);
      else XB_SPIN(xb_ld(&bar[XB_TOPGEN]) == tg, bar);
      __builtin_amdgcn_fence(__ATOMIC_ACQUIRE, "agent");
      xb_add(&bar[XB_XGEN(x)], 1u);
      asm volatile("s_waitcnt vmcnt(0)" ::: "memory");
    } else {
      XB_SPIN(xb_ld(&bar[XB_XGEN(x)]) == gen, bar);
      __builtin_amdgcn_fence(__ATOMIC_ACQUIRE, "agent");
      asm volatile("s_waitcnt vmcnt(0)" ::: "memory");
    }
  }
  __syncthreads();
}

constexpr int NPHASES = 15;
__global__ void __launch_bounds__(NTHREADS, 2) mega_kernel(Params p) {
  __shared__ __attribute__((aligned(16))) char smem[SMEM_BYTES];
  cg::grid_group grid = cg::this_grid();
  unsigned char* ws = p.ws;
  int ph = 0;
  __shared__ __attribute__((aligned(16))) unsigned xb_st[4];
  unsigned* xbar = (unsigned*)(ws + OFF_XBAR);
  const unsigned xb_x = xb_xcc_id();
  if (threadIdx.x < 4) xb_st[threadIdx.x] = 0u;
#define RUN(body)                                   \
  {                                                 \
    if (ph >= p.ph_lo && ph < p.ph_hi) {            \
      body;                                         \
      if (ph + 1 < p.ph_hi) {                       \
        if (ph == 0) {                              \
          grid.sync();                              \
          if (threadIdx.x == 0) (void)xb_add(&xbar[XB_XCNT(xb_x)], 1u); \
        } else xcd_barrier(xbar, xb_x, xb_st);      \
      }                                             \
    }                                               \
    ++ph;                                           \
  }
  RUN(convert_layer(p, 0, smem); phase_init(p));
#define LAYER(l)                                                                                          \
  RUN(if (l == 1) convert_layer(p, 1, smem, 2); phase_inproj(p, l, smem));                                                                          \
  RUN(phase_mla_up(p, l, smem));                                                                          \
  RUN(phase_attn(p, l, smem));                                                                            \
  RUN(phase_merge(p, l, smem));                                                                           \
  RUN(phase_resid(p, (const bf16_t*)(ws + A_MERGED), 1024, (const bf16_t*)(ws + OFF_WO),                  \
                  (float*)(ws + OFF_SS) + (size_t)(l * 2 + 1) * T, false, smem));                         \
  RUN(phase_up(p, l, smem));                                                                              \
  RUN(phase_resid(p, (const bf16_t*)(ws + A_ACT), DFF, (const bf16_t*)(ws + OFF_WDN),                     \
                  (float*)(ws + OFF_SS) + (size_t)((l + 1) * 2) * T, l == 1, smem); if (l == 0) convert_layer(p, 1, smem, 1));
  LAYER(0)
  LAYER(1)
#undef LAYER
#undef RUN
}

extern "C" void kernel_launch(void* const* d_in, const int* in_sizes, int n_in, void* d_out, int out_size, void* d_ws,
                              size_t ws_size, hipStream_t stream) {
  static int grid_blocks = 0;
  if (!grid_blocks) {
    int dev = 0, cus = 0, per_cu = 0;
    hipGetDevice(&dev);
    hipDeviceGetAttribute(&cus, hipDeviceAttributeMultiprocessorCount, dev);
    hipOccupancyMaxActiveBlocksPerMultiprocessor(&per_cu, mega_kernel, NTHREADS, 0);
    if (per_cu < 1) per_cu = 1;
    if (per_cu > 1) per_cu = 1;
    grid_blocks = cus * per_cu;
    if (ws_size < A_END) fprintf(stderr, "workspace too small: %zu < %zu\n", ws_size, (size_t)A_END);
  }
  Params p{};
  for (int i = 0; i < 23; ++i) p.in[i] = (const float*)d_in[i];
  p.out = (float*)d_out;
  p.ws = (unsigned char*)d_ws;
  p.ph_lo = 0;
  p.ph_hi = NPHASES;
  void* args[] = {&p};
  hipError_t e = hipLaunchCooperativeKernel((void*)mega_kernel, dim3(grid_blocks), dim3(NTHREADS), args, 0, stream);
  if (e != hipSuccess) fprintf(stderr, "cooperative launch failed: %s (grid %d)\n", hipGetErrorString(e), grid_blocks);
}
```

```cpp
#include <hip/hip_runtime.h>
#include <hip/hip_cooperative_groups.h>
#include <cstdio>
namespace cg = cooperative_groups;

#define DI __device__ __forceinline__
typedef __attribute__((ext_vector_type(8))) short bf16x8;
typedef __attribute__((ext_vector_type(4))) short s16x4;
typedef __attribute__((ext_vector_type(16))) float f32x16;
typedef __attribute__((ext_vector_type(4))) float f32x4;
typedef __attribute__((ext_vector_type(2))) float f32x2;
typedef __attribute__((ext_vector_type(2))) __bf16 bf16x2_t;
typedef unsigned short bf16_t;

constexpr int D = 1024, NBATCH = 4, SEQ = 4096, L = 4112, T = NBATCH * L  , LP = 4224;
constexpr int DFF = 2816;
constexpr int NIN = 2816;
constexpr float EPS = 1e-6f;
constexpr float LOG2E = 1.4426950408889634f;
constexpr int NTHREADS = 512;
constexpr int SMEM_BYTES = 147456 + 64;

constexpr size_t OFF_WIN = 0;
constexpr size_t OFF_WG = OFF_WIN + (size_t)NIN * 1024 * 2;
constexpr size_t OFF_WQUP = OFF_WG + (size_t)3072 * 1024 * 2;
constexpr size_t OFF_WKVUP = OFF_WQUP + (size_t)768 * 256 * 2;
constexpr size_t OFF_WBR = OFF_WKVUP + (size_t)1024 * 128 * 2;
constexpr size_t OFF_WO = OFF_WBR + (size_t)3 * 1024 * 512 * 2;
constexpr size_t OFF_WUP = OFF_WO + (size_t)1024 * 1024 * 2;
constexpr size_t OFF_WDN = OFF_WUP + (size_t)5632 * 1024 * 2;
constexpr size_t OFF_HB = OFF_WDN + (size_t)1024 * 2816 * 2;
constexpr size_t OFF_SS = OFF_HB + (size_t)T * 1024 * 2;
constexpr size_t OFF_SSKR = OFF_SS + (size_t)8 * T * 4;
constexpr size_t OFF_ROPE = OFF_SSKR + (size_t)T * 4;
constexpr size_t OFF_LF = OFF_ROPE + (size_t)L * 32 * 4;
constexpr size_t OFF_CDEC = OFF_LF + (size_t)T * 8 * 4;
constexpr size_t OFF_HMETA = OFF_CDEC + (size_t)32 * LP * 4;
constexpr size_t OFF_KR = OFF_HMETA + (size_t)64 * 1024 * 4;
constexpr size_t OFF_CTR = OFF_KR + (size_t)T * 32 * 2;
constexpr size_t OFF_XBAR = OFF_CTR + 256;
constexpr size_t OFF_ARENA = OFF_XBAR + 3456 * 4 + 128;
constexpr size_t SZ64 = (size_t)NBATCH * 8 * LP * 64 * 2;
constexpr size_t SZ96 = (size_t)NBATCH * 8 * LP * 96 * 2;
constexpr size_t SZKS = (size_t)NBATCH * 2 * LP * 64 * 2;
constexpr size_t A_QF = OFF_ARENA;
constexpr size_t A_QS = A_QF + SZ64;
constexpr size_t A_QM = A_QS + SZ64;
constexpr size_t A_KF = A_QM + SZ96;
constexpr size_t A_VF = A_KF + SZ64;
constexpr size_t A_KS = A_VF + SZ64;
constexpr size_t A_VS = A_KS + SZKS;
constexpr size_t A_KM = A_VS + SZKS;
constexpr size_t A_VM = A_KM + SZ96;
constexpr size_t A_CQ = A_VM + SZ64;
constexpr size_t A_CKV = A_CQ + (size_t)T * 256 * 2;
constexpr size_t A_END = A_CKV + (size_t)T * 128 * 2;
constexpr size_t A_MERGED = A_KF;
constexpr size_t A_ACT = OFF_ARENA;
static_assert((size_t)T * 1024 * 2 <= 2 * SZ64, "merged alias");
static_assert(A_END <= (size_t)256 * 1024 * 1024, "workspace");
static_assert(A_ACT + (size_t)T * 2816 * 2 <= A_END, "act alias");

struct Params {
  const float* in[23];
  float* out;
  unsigned char* ws;
  int ph_lo, ph_hi;
};

__device__ const double ROPE_FREQ[16] = {1.0, 0.5623413251903491, 0.31622776601683794, 0.1778279410038923, 0.1, 0.05623413251903491,
  0.03162277660168379, 0.01778279410038923, 0.01, 0.005623413251903491, 0.0031622776601683794, 0.0017782794100389228, 0.001,
  0.0005623413251903491, 0.00031622776601683794, 0.00017782794100389227};

DI unsigned pk2(float a, float b) {
  f32x2 v = {a, b};
  bf16x2_t r = __builtin_convertvector(v, bf16x2_t);
  return __builtin_bit_cast(unsigned, r);
}
DI uint2 pk4(float a, float b, float c, float d) { return make_uint2(pk2(a, b), pk2(c, d)); }
DI bf16_t f2bf(float v) { return (bf16_t)(pk2(v, 0.f) & 0xffffu); }
DI float bf2f(bf16_t v) { return __uint_as_float(((unsigned)v) << 16); }
DI float xor32(float v) {
  const auto r = __builtin_amdgcn_permlane32_swap(__float_as_uint(v), __float_as_uint(v), false, false);
  return __uint_as_float(r[0]) + __uint_as_float(r[1]);
}
DI float max32(float v) {
  const auto r = __builtin_amdgcn_permlane32_swap(__float_as_uint(v), __float_as_uint(v), false, false);
  return fmaxf(__uint_as_float(r[0]), __uint_as_float(r[1]));
}
DI float fexp2(float x) { return __builtin_amdgcn_exp2f(x); }
DI f32x16 mfma32(bf16x8 a, bf16x8 b, f32x16 c) { return __builtin_amdgcn_mfma_f32_32x32x16_bf16(a, b, c, 0, 0, 0); }
DI float* hrow(const Params& p, int b, int pos) {
  return pos >= 16 ? p.out + ((size_t)(b * SEQ + pos - 16)) * D : (float*)(p.ws + OFF_HMETA) + (size_t)(b * 16 + pos) * D;
}

template <int WM, int WN, int TM, int TN, bool LOWREG = false, class RowOff>
DI void gemm_main(const bf16_t* __restrict__ A, RowOff rowoff, int a_kstride, const bf16_t* __restrict__ Bt, int ldb, int n0,
                  int nk, int mvalid, f32x16 (&acc)[TM][TN], char* smem) {
  static_assert(WM * WN == 8, "8 waves");
  constexpr int BM = WM * TM * 32, BN = WN * TN * 32;
  constexpr int NA = (BM + 63) / 64, NB = (BN + 63) / 64;
  constexpr int STAGE = (BM + BN) * 144;
  static_assert(2 * STAGE <= 147456, "smem");
  const int tid = threadIdx.x, lane = tid & 63, wid = __builtin_amdgcn_readfirstlane(tid >> 6);
  const int r = lane & 31, h = lane >> 5;
  const int wm = wid / WN, wn = wid % WN;
  const int lrow = tid >> 3, c8 = tid & 7;
  int aoff[NA];
#pragma unroll
  for (int i = 0; i < NA; ++i) aoff[i] = rowoff(min(lrow + 64 * i, BM - 1)) + c8 * 8;
  const bf16_t* bptr = Bt + (size_t)(n0 + lrow) * ldb + c8 * 8;
  bf16x8 ra0[NA], rb0[NB];
  auto gload = [&](int kt, bf16x8 (&ra)[NA], bf16x8 (&rb)[NB]) {
#pragma unroll
    for (int i = 0; i < NA; ++i) ra[i] = *(const bf16x8*)(A + aoff[i] + (size_t)kt * a_kstride);
#pragma unroll
    for (int i = 0; i < NB; ++i)
      if (BN % 64 == 0 || lrow + 64 * i < BN) rb[i] = *(const bf16x8*)(bptr + (size_t)(64 * i) * ldb + kt * 64);
  };
  auto sstore = [&](int s, bf16x8 (&ra)[NA], bf16x8 (&rb)[NB]) {
    char* as = smem + s * STAGE;
    char* bs = as + BM * 144;
#pragma unroll
    for (int i = 0; i < NA; ++i)
      if (BM % 64 == 0 || lrow + 64 * i < BM) *(bf16x8*)(as + (lrow + 64 * i) * 144 + c8 * 16) = ra[i];
#pragma unroll
    for (int i = 0; i < NB; ++i)
      if (BN % 64 == 0 || lrow + 64 * i < BN) *(bf16x8*)(bs + (lrow + 64 * i) * 144 + c8 * 16) = rb[i];
  };
  const int ntm = min(TM, max(0, (mvalid - wm * TM * 32 + 31) >> 5));
  auto half_a = [&](int kt) {
    if (kt + 1 < nk) {
      char* as = smem + ((kt + 1) & 1) * STAGE;
#pragma unroll
      for (int i = 0; i < NA; ++i)
        if (BM % 64 == 0 || lrow + 64 * i < BM) *(bf16x8*)(as + (lrow + 64 * i) * 144 + c8 * 16) = ra0[i];
    }
    if (kt + 2 < nk) {
#pragma unroll
      for (int i = 0; i < NA; ++i) ra0[i] = *(const bf16x8*)(A + aoff[i] + (size_t)(kt + 2) * a_kstride);
    }
  };
  auto half_b = [&](int kt) {
    if (kt + 1 < nk) {
      char* bs = smem + ((kt + 1) & 1) * STAGE + BM * 144;
#pragma unroll
      for (int i = 0; i < NB; ++i)
        if (BN % 64 == 0 || lrow + 64 * i < BN) *(bf16x8*)(bs + (lrow + 64 * i) * 144 + c8 * 16) = rb0[i];
    }
    if (kt + 2 < nk) {
#pragma unroll
      for (int i = 0; i < NB; ++i)
        if (BN % 64 == 0 || lrow + 64 * i < BN) rb0[i] = *(const bf16x8*)(bptr + (size_t)(64 * i) * ldb + (kt + 2) * 64);
    }
  };
  auto mm = [&](const char* as, const char* bs, int ks) {
    bf16x8 af[TM], bf[TN];
#pragma unroll
    for (int tn = 0; tn < TN; ++tn) bf[tn] = *(const bf16x8*)(bs + tn * 32 * 144 + ks * 32);
#pragma unroll
    for (int tm = 0; tm < TM; ++tm) af[tm] = *(const bf16x8*)(as + tm * 32 * 144 + ks * 32);
#pragma unroll
    for (int tm = 0; tm < TM; ++tm)
#pragma unroll
      for (int tn = 0; tn < TN; ++tn) acc[tm][tn] = mfma32(bf[tn], af[tm], acc[tm][tn]);
  };
  gload(0, ra0, rb0);
  sstore(0, ra0, rb0);
  if (nk > 1) gload(1, ra0, rb0);
#pragma unroll 1
  for (int kt = 0; kt < nk; ++kt) {
    __syncthreads();
    const char* as = smem + (kt & 1) * STAGE + (wm * TM * 32 + r) * 144 + h * 16;
    const char* bs = smem + (kt & 1) * STAGE + BM * 144 + (wn * TN * 32 + r) * 144 + h * 16;
    __builtin_amdgcn_s_setprio(1);
    mm(as, bs, 0);
    __builtin_amdgcn_s_setprio(0);
    __builtin_amdgcn_sched_barrier(0);
    half_a(kt);
    __builtin_amdgcn_sched_barrier(0);
    __builtin_amdgcn_s_setprio(1);
    mm(as, bs, 1);
    mm(as, bs, 2);
    __builtin_amdgcn_s_setprio(0);
    __builtin_amdgcn_sched_barrier(0);
    half_b(kt);
    __builtin_amdgcn_sched_barrier(0);
    __builtin_amdgcn_s_setprio(1);
    mm(as, bs, 3);
    __builtin_amdgcn_s_setprio(0);
  }
  __syncthreads();
}


template <class RowOff>
DI void gemm_rem(const bf16_t* __restrict__ A, RowOff rowoff, int a_kstride, const bf16_t* __restrict__ Bt, int ldb, int n0,
                 int nk, f32x16& acc, char* smem) {
  constexpr int PITCH = 272, STAGE = (64 + 128) * PITCH;
  const int nk2 = nk >> 1;
  const int tid = threadIdx.x, lane = tid & 63, wid = __builtin_amdgcn_readfirstlane(tid >> 6);
  const int r = lane & 31, h = lane >> 5;
  const int wm = wid >> 2, wn = wid & 3;
  const int lrow = tid >> 3, c8 = tid & 7;
  const bf16_t* ap = A + rowoff(lrow) + c8 * 8;
  const bf16_t* bp = Bt + (size_t)(n0 + lrow) * ldb + c8 * 8;
  bf16x8 ra[2][2], rb0[2][2], rb1[2][2];
  auto gload = [&](int k2, int s) {
#pragma unroll
    for (int hf = 0; hf < 2; ++hf) {
      const int kt = 2 * k2 + hf;
      ra[s][hf] = *(const bf16x8*)(ap + (size_t)kt * a_kstride);
      rb0[s][hf] = *(const bf16x8*)(bp + kt * 64);
      rb1[s][hf] = *(const bf16x8*)(bp + (size_t)64 * ldb + kt * 64);
    }
  };
  auto sstore = [&](int st, int s) {
    char* as = smem + st * STAGE;
#pragma unroll
    for (int hf = 0; hf < 2; ++hf) {
      *(bf16x8*)(as + lrow * PITCH + hf * 128 + c8 * 16) = ra[s][hf];
      *(bf16x8*)(as + (64 + lrow) * PITCH + hf * 128 + c8 * 16) = rb0[s][hf];
      *(bf16x8*)(as + (128 + lrow) * PITCH + hf * 128 + c8 * 16) = rb1[s][hf];
    }
  };
  auto compute = [&](int k2) {
    const char* as = smem + (k2 & 1) * STAGE + (wm * 32 + r) * PITCH + h * 16;
    const char* bs = smem + (k2 & 1) * STAGE + (64 + wn * 32 + r) * PITCH + h * 16;
#pragma unroll
    for (int ks = 0; ks < 8; ++ks) {
      const bf16x8 bf = *(const bf16x8*)(bs + ks * 32);
      const bf16x8 af = *(const bf16x8*)(as + ks * 32);
      acc = mfma32(bf, af, acc);
    }
  };
  gload(0, 0);
  gload(1, 1);
  sstore(0, 0);
  __syncthreads();
#pragma unroll 1
  for (int k2 = 0; k2 < nk2; k2 += 2) {
    if (k2 + 2 < nk2) gload(k2 + 2, 0);
    __builtin_amdgcn_sched_barrier(0);
    compute(k2);
    __builtin_amdgcn_sched_barrier(0);
    sstore(1, 1);
    __syncthreads();
    if (k2 + 3 < nk2) gload(k2 + 3, 1);
    __builtin_amdgcn_sched_barrier(0);
    compute(k2 + 1);
    __builtin_amdgcn_sched_barrier(0);
    if (k2 + 2 < nk2) sstore(0, 0);
    __syncthreads();
  }
}

template <int TM, int TN>
DI void zero_acc(f32x16 (&acc)[TM][TN]) {
#pragma unroll
  for (int a = 0; a < TM; ++a)
#pragma unroll
    for (int b = 0; b < TN; ++b)
#pragma unroll
      for (int i = 0; i < 16; ++i) acc[a][b][i] = 0.f;
}

DI int inproj_src_col(int n) {
  if (n < 1536) return n;
  if (n < 2048) return 1960 + (n - 1536);
  if (n < 2176) return 2472 + (n - 2048);
  if (n < 2304) return 2600 + (n - 2176);
  if (n < 2560) return 1544 + (n - 2304);
  if (n < 2688) return 1800 + (n - 2560);
  if (n < 2720) return 1928 + (n - 2688);
  if (n < 2728) return 1536 + (n - 2720);
  return -1;
}
DI void conv_mat(const float* __restrict__ src, int ldsrc, int K, int Np, const float* __restrict__ gain, int map,
                 bf16_t* __restrict__ dst, int& base, char* smem, int skip = 0) {
  float* tl = (float*)smem;
  const int tk = K / 64, tn = Np / 64, nt = tk * tn;
  const int G = (int)gridDim.x - skip;
  if ((int)blockIdx.x < skip) { base += nt; return; }
  int start = (int)(((long)blockIdx.x - skip - base) % G);
  if (start < 0) start += G;
  const int tid = threadIdx.x;
  const int lk = tid >> 4, n4 = (tid & 15) * 4;
  const int sn = tid >> 3, k8 = (tid & 7) * 8;
  auto issue = [&](int t, f32x4& a, f32x4& b) {
    const int k0 = (t % tk) * 64, n0 = (t / tk) * 64;
    const int nn = n0 + n4;
    int sc;
    if (map == 0) sc = nn;
    else if (map == 1) sc = inproj_src_col(nn);
    else if (map == 2) sc = 2728 + nn;
    else sc = (nn >> 6) * 32 + (nn & 31) + ((nn & 32) ? DFF : 0);
    a = f32x4{0.f, 0.f, 0.f, 0.f};
    b = a;
    if (sc >= 0) {
      a = *(const f32x4*)(src + (size_t)(k0 + lk) * ldsrc + sc);
      b = *(const f32x4*)(src + (size_t)(k0 + lk + 32) * ldsrc + sc);
    }
    if (gain) {
      const float g0 = gain[k0 + lk], g1 = gain[k0 + lk + 32];
#pragma unroll
      for (int j = 0; j < 4; ++j) { a[j] *= g0; b[j] *= g1; }
    }
  };
  f32x4 ca, cb2;
  int t = start;
  if (t < nt) issue(t, ca, cb2);
  while (t < nt) {
#pragma unroll
    for (int j = 0; j < 4; ++j) {
      tl[(n4 + j) * 65 + lk] = ca[j];
      tl[(n4 + j) * 65 + lk + 32] = cb2[j];
    }
    __syncthreads();
    const int tnx = t + G;
    f32x4 na, nb;
    if (tnx < nt) issue(tnx, na, nb);
    {
      const int k0 = (t % tk) * 64, n0 = (t / tk) * 64;
      float v[8];
#pragma unroll
      for (int j = 0; j < 8; ++j) v[j] = tl[sn * 65 + k8 + j];
      *(uint4*)(dst + (size_t)(n0 + sn) * K + k0 + k8) = make_uint4(pk2(v[0], v[1]), pk2(v[2], v[3]), pk2(v[4], v[5]), pk2(v[6], v[7]));
    }
    __syncthreads();
    ca = na; cb2 = nb;
    t = tnx;
  }
  base += nt;
}
DI void convert_layer(const Params& p, int l, char* smem, int parts = 3, int skip = 0) {
  unsigned char* ws = p.ws;
  int base = 0;
  if (parts & 1) {
  const float* w_in = p.in[3] + (size_t)l * 1024 * 5800;
  conv_mat(w_in, 5800, 1024, NIN, p.in[2] + l * 1024, 1, (bf16_t*)(ws + OFF_WIN), base, smem, skip);
  conv_mat(w_in, 5800, 1024, 3072, p.in[2] + l * 1024, 2, (bf16_t*)(ws + OFF_WG), base, smem, skip);
  conv_mat(p.in[8] + (size_t)l * 256 * 768, 768, 256, 768, p.in[7] + l * 256, 0, (bf16_t*)(ws + OFF_WQUP), base, smem, skip);
  conv_mat(p.in[10] + (size_t)l * 128 * 1024, 1024, 128, 1024, p.in[9] + l * 128, 0, (bf16_t*)(ws + OFF_WKVUP), base, smem, skip);
  for (int n = 0; n < 3; ++n)
    conv_mat(p.in[16] + ((size_t)l * 3 + n) * 512 * 1024, 1024, 512, 1024, nullptr, 0,
             (bf16_t*)(ws + OFF_WBR) + (size_t)n * 1024 * 512, base, smem, skip);
  conv_mat(p.in[17] + (size_t)l * 1024 * 1024, 1024, 1024, 1024, nullptr, 0, (bf16_t*)(ws + OFF_WO), base, smem, skip);
  conv_mat(p.in[19] + (size_t)l * 1024 * 5632, 5632, 1024, 5632, p.in[18] + l * 1024, 3, (bf16_t*)(ws + OFF_WUP), base, smem, skip);
  }
  if (parts & 2) conv_mat(p.in[22] + (size_t)l * 2816 * 1024, 1024, 2816, 1024, nullptr, 0, (bf16_t*)(ws + OFF_WDN), base, smem, skip);
}

DI void phase_init(const Params& p) {
  unsigned char* ws = p.ws;
  const int tid = threadIdx.x, lane = tid & 63, wid = tid >> 6;
  const int gw = blockIdx.x * 8 + wid, nw = gridDim.x * 8;
  const int gt = blockIdx.x * NTHREADS + tid, ntot = gridDim.x * NTHREADS;
  float* ss = (float*)(ws + OFF_SS);
  bf16_t* hb = (bf16_t*)(ws + OFF_HB);
#pragma unroll 2
  for (int m = gw; m < T; m += nw) {
    int b = m / L, pos = m - b * L;
    const float* src = pos < 16 ? p.in[1] + pos * D : p.in[0] + ((size_t)(b * SEQ + pos - 16)) * D;
    float* dsth = hrow(p, b, pos);
    float s = 0.f;
#pragma unroll
    for (int i = 0; i < 4; ++i) {
      int c = (i * 64 + lane) * 4;
      f32x4 v = *(const f32x4*)(src + c);
      *(f32x4*)(dsth + c) = v;
      *(uint2*)(hb + (size_t)m * D + c) = pk4(v[0], v[1], v[2], v[3]);
      s += v[0] * v[0] + v[1] * v[1] + v[2] * v[2] + v[3] * v[3];
    }
#pragma unroll
    for (int o = 32; o >= 1; o >>= 1) s += __shfl_xor(s, o);
    if (lane == 0) ss[m] = s;
  }
  for (int i = gt; i < 7 * T; i += ntot) ss[T + i] = 0.f;
  if (gt < 64) ((unsigned*)(ws + OFF_CTR))[gt] = 0u;
  for (int i = gt; i < 3456; i += ntot) ((unsigned*)(ws + OFF_XBAR))[i] = 0u;
  float* rc = (float*)(ws + OFF_ROPE);
  float* rsn = rc + L * 16;
  for (int i = gt; i < L * 16; i += ntot) {
    int pos = i >> 4, c = i & 15;
    double ang = (double)pos * ROPE_FREQ[c];
    double k = rint(ang * 0.15915494309189535);
    double x = ang - k * 6.283185307179586476925;
    double x2 = x * x;
    double sn = 0.0, cs = 0.0;
    double ts = x, tc = 1.0;
#pragma unroll 1
    for (int n = 0; n < 15; ++n) {
      sn += ts;
      cs += tc;
      tc = -tc * x2 / (double)((2 * n + 1) * (2 * n + 2));
      ts = -ts * x2 / (double)((2 * n + 2) * (2 * n + 3));
    }
    rc[i] = (float)cs;
    rsn[i] = (float)sn;
  }
}


struct TileIter {
  int xcd, loc, nloc, per, nt, i;
  bool xmode;
  DI TileIter(int ntiles) {
    nt = ntiles;
    xmode = (gridDim.x & 7) == 0;
    if (xmode) { xcd = blockIdx.x & 7; loc = blockIdx.x >> 3; nloc = gridDim.x >> 3; per = (ntiles + 7) >> 3; i = loc; }
    else { xcd = 0; loc = blockIdx.x; nloc = gridDim.x; per = ntiles; i = loc; }
  }
  DI int next() {
    if (i >= per) return -1;
    const int t = xcd * per + i;
    i += nloc;
    return t < nt ? t : -1;
  }
};

DI void phase_inproj(const Params& p, int l, char* smem) {
  unsigned char* ws = p.ws;
  const bf16_t* hb = (const bf16_t*)(ws + OFF_HB);
  const bf16_t* W = (const bf16_t*)(ws + OFF_WIN);
  const float* ss1 = (const float*)(ws + OFF_SS) + (size_t)(l * 2) * T;
  float* ss_cq = (float*)(ws + OFF_SS) + (size_t)(4 + l) * T;
  float* ss_ckv = (float*)(ws + OFF_SS) + (size_t)(6 + l) * T;
  float* ss_kr = (float*)(ws + OFF_SSKR);
  const int lane = threadIdx.x & 63, wid = __builtin_amdgcn_readfirstlane(threadIdx.x >> 6), r = lane & 31, h = lane >> 5, wm = wid >> 2, wn = wid & 3;
  constexpr int NT = NIN / 256, MT = (T + 255) / 256;
  TileIter tit(NT * MT);
  for (int t = tit.next(); t >= 0; t = tit.next()) {
    const int nt = t % NT, mt = t / NT;
    const int m0 = mt * 256, n0 = nt * 256;
    f32x16 acc[4][2];
    zero_acc(acc);
    gemm_main<2, 4, 4, 2>(hb, [&](int row) { return min(m0 + row, T - 1) * D; }, 64, W, D, n0, D / 64, T - m0, acc, smem);
    const int n0w = n0 + wn * 64;
#pragma unroll
    for (int tm = 0; tm < 4; ++tm) {
      const int m = m0 + wm * 128 + tm * 32 + r;
      const bool valid = m < T;
      const int mm = valid ? m : T - 1;
      const int b = mm / L, pos = mm - b * L;
      const float rs = rsqrtf(ss1[mm] * (1.f / 1024.f) + EPS);
#pragma unroll
      for (int tn = 0; tn < 2; ++tn)
#pragma unroll
        for (int i = 0; i < 16; ++i) acc[tm][tn][i] *= rs;
      float ssq = 0.f;
#pragma unroll
      for (int tn = 0; tn < 2; ++tn)
#pragma unroll
        for (int i = 0; i < 16; ++i) ssq += acc[tm][tn][i] * acc[tm][tn][i];
      if (n0w < 2304) {
        int kind, head, nh;
        const float* gain = nullptr;
        float scale = 1.f;
        bf16_t* dst;
        if (n0w < 512) { kind = 0; head = n0w >> 6; nh = 8; gain = p.in[5] + l * 64; scale = 0.125f * LOG2E; dst = (bf16_t*)(ws + A_QF); }
        else if (n0w < 1024) { kind = 0; head = (n0w - 512) >> 6; nh = 8; gain = p.in[6] + l * 64; dst = (bf16_t*)(ws + A_KF); }
        else if (n0w < 1536) { kind = 1; head = (n0w - 1024) >> 6; nh = 8; dst = (bf16_t*)(ws + A_VF); }
        else if (n0w < 2048) { kind = 0; head = (n0w - 1536) >> 6; nh = 8; gain = p.in[13] + l * 64; scale = 0.125f * LOG2E; dst = (bf16_t*)(ws + A_QS); }
        else if (n0w < 2176) { kind = 0; head = (n0w - 2048) >> 6; nh = 2; gain = p.in[14] + l * 64; dst = (bf16_t*)(ws + A_KS); }
        else { kind = 1; head = (n0w - 2176) >> 6; nh = 2; dst = (bf16_t*)(ws + A_VS); }
        if (kind == 0) {
          const float tot = xor32(ssq);
          const float rr = rsqrtf(tot * (1.f / 64.f) + EPS) * scale;
          bf16_t* drow = dst + ((size_t)(b * nh + head) * LP + pos) * 64;
#pragma unroll
          for (int tn = 0; tn < 2; ++tn)
#pragma unroll
            for (int g4 = 0; g4 < 4; ++g4) {
              const int d = tn * 32 + 8 * g4 + 4 * h;
              const f32x4 gv = *(const f32x4*)(gain + d);
              uint2 o = pk4(acc[tm][tn][4 * g4] * rr * gv[0], acc[tm][tn][4 * g4 + 1] * rr * gv[1],
                            acc[tm][tn][4 * g4 + 2] * rr * gv[2], acc[tm][tn][4 * g4 + 3] * rr * gv[3]);
              if (valid) *(uint2*)(drow + d) = o;
            }
        } else {
          bf16_t* dcol = dst + ((size_t)(b * nh + head) * 64) * LP + pos;
          if (valid) {
#pragma unroll
            for (int tn = 0; tn < 2; ++tn)
#pragma unroll
              for (int i = 0; i < 16; ++i) {
                const int d = tn * 32 + (i & 3) + 8 * (i >> 2) + 4 * h;
                dcol[(size_t)d * LP] = f2bf(acc[tm][tn][i]);
              }
          }
        }
      } else if (n0w < 2688) {
        bf16_t* dst;
        float* ssd;
        int ld, c0;
        if (n0w < 2560) { dst = (bf16_t*)(ws + A_CQ); ssd = ss_cq; ld = 256; c0 = n0w - 2304; }
        else { dst = (bf16_t*)(ws + A_CKV); ssd = ss_ckv; ld = 128; c0 = n0w - 2560; }
        const float tot = xor32(ssq);
        if (valid) {
#pragma unroll
          for (int tn = 0; tn < 2; ++tn)
#pragma unroll
            for (int g4 = 0; g4 < 4; ++g4) {
              const int d = c0 + tn * 32 + 8 * g4 + 4 * h;
              *(uint2*)(dst + (size_t)m * ld + d) =
                  pk4(acc[tm][tn][4 * g4], acc[tm][tn][4 * g4 + 1], acc[tm][tn][4 * g4 + 2], acc[tm][tn][4 * g4 + 3]);
            }
          if (h == 0) atomicAdd(ssd + m, tot);
        }
      } else if (n0w == 2688) {
        float s0 = 0.f;
#pragma unroll
        for (int i = 0; i < 16; ++i) s0 += acc[tm][0][i] * acc[tm][0][i];
        s0 = xor32(s0);
        if (valid) {
          bf16_t* kr = (bf16_t*)(ws + OFF_KR) + (size_t)m * 32;
#pragma unroll
          for (int g4 = 0; g4 < 4; ++g4)
            *(uint2*)(kr + 8 * g4 + 4 * h) =
                pk4(acc[tm][0][4 * g4], acc[tm][0][4 * g4 + 1], acc[tm][0][4 * g4 + 2], acc[tm][0][4 * g4 + 3]);
          if (h == 0) ss_kr[m] = s0;
          float* lf = (float*)(ws + OFF_LF) + (size_t)m * 8 + 4 * h;
          f32x4 o;
#pragma unroll
          for (int j = 0; j < 4; ++j) {
            float x = acc[tm][1][j] + p.in[4][l * 8 + 4 * h + j];
            o[j] = fminf(x, 0.f) - log1pf(__expf(-fabsf(x)));
          }
          *(f32x4*)lf = o;
        }
      }
    }
  }
}

DI void phase_mla_up(const Params& p, int l, char* smem) {
  unsigned char* ws = p.ws;
  const int lane = threadIdx.x & 63, wid = __builtin_amdgcn_readfirstlane(threadIdx.x >> 6), r = lane & 31, h = lane >> 5;
  const float* rope_c = (const float*)(ws + OFF_ROPE);
  const float* rope_s = rope_c + L * 16;
  constexpr int MT = 64;
  {
    const bf16_t* A = (const bf16_t*)(ws + A_CQ);
    const bf16_t* W = (const bf16_t*)(ws + OFF_WQUP);
    const float* ssc = (const float*)(ws + OFF_SS) + (size_t)(4 + l) * T;
    const float* g = p.in[11] + l * 96;
    bf16_t* Qm = (bf16_t*)(ws + A_QM);
    const float qscale = 0.10206207261596575f * LOG2E;
    auto epi = [&](f32x16 (&acc)[1][3], int m, int head) {
      const int b = m / L, pos = m - b * L;
      const float rs = rsqrtf(ssc[m] * (1.f / 256.f) + EPS);
      float ssq = 0.f;
#pragma unroll
      for (int tn = 0; tn < 3; ++tn)
#pragma unroll
        for (int i = 0; i < 16; ++i) { acc[0][tn][i] *= rs; ssq += acc[0][tn][i] * acc[0][tn][i]; }
      ssq = xor32(ssq);
      const float rr = rsqrtf(ssq * (1.f / 96.f) + EPS);
      bf16_t* drow = Qm + ((size_t)(b * 8 + head) * LP + pos) * 96;
#pragma unroll
      for (int tn = 0; tn < 2; ++tn)
#pragma unroll
        for (int g4 = 0; g4 < 4; ++g4) {
          const int d = tn * 32 + 8 * g4 + 4 * h;
          const f32x4 gv = *(const f32x4*)(g + d);
          *(uint2*)(drow + d) = pk4(acc[0][tn][4 * g4] * rr * gv[0] * qscale, acc[0][tn][4 * g4 + 1] * rr * gv[1] * qscale,
                                    acc[0][tn][4 * g4 + 2] * rr * gv[2] * qscale, acc[0][tn][4 * g4 + 3] * rr * gv[3] * qscale);
        }
#pragma unroll
      for (int g4 = 0; g4 < 2; ++g4) {
        const int c = 8 * g4 + 4 * h;
        const f32x4 g1 = *(const f32x4*)(g + 64 + c);
        const f32x4 g2 = *(const f32x4*)(g + 80 + c);
        const f32x4 cs = *(const f32x4*)(rope_c + pos * 16 + c);
        const f32x4 sn = *(const f32x4*)(rope_s + pos * 16 + c);
        float o1[4], o2[4];
#pragma unroll
        for (int j = 0; j < 4; ++j) {
          float x1 = acc[0][2][4 * g4 + j] * rr * g1[j];
          float x2 = acc[0][2][4 * g4 + 8 + j] * rr * g2[j];
          o1[j] = (x1 * cs[j] - x2 * sn[j]) * qscale;
          o2[j] = (x2 * cs[j] + x1 * sn[j]) * qscale;
        }
        *(uint2*)(drow + 64 + c) = pk4(o1[0], o1[1], o1[2], o1[3]);
        *(uint2*)(drow + 80 + c) = pk4(o2[0], o2[1], o2[2], o2[3]);
      }
    };
    for (int t = blockIdx.x; t < 8 * MT; t += gridDim.x) {
      const int head = t % 8, mt = t / 8;
      const int m0 = mt * 256;
      f32x16 acc[1][3];
      zero_acc(acc);
      gemm_main<8, 1, 1, 3>(A, [&](int row) { return (m0 + row) * 256; }, 64, W, 256, head * 96, 4, 256, acc, smem);
      epi(acc, m0 + wid * 32 + r, head);
    }
    for (int nt = (int)blockIdx.x - 8; nt >= 0 && nt < 2; nt += gridDim.x) {
      const int wm = wid >> 2, wn = wid & 3;
      f32x16 acc[1][3];
      zero_acc(acc);
      gemm_main<2, 4, 1, 3>(A, [&](int row) { return min(16384 + row, T - 1) * 256; }, 64, W, 256, nt * 384, 4, 64, acc, smem);
      epi(acc, 16384 + wm * 32 + r, nt * 4 + wn);
    }
  }
  {
    const bf16_t* A = (const bf16_t*)(ws + A_CKV);
    const bf16_t* W = (const bf16_t*)(ws + OFF_WKVUP);
    const float* ssc = (const float*)(ws + OFF_SS) + (size_t)(6 + l) * T;
    const float* ss_kr = (const float*)(ws + OFF_SSKR);
    const bf16_t* krp = (const bf16_t*)(ws + OFF_KR);
    const float* g = p.in[12] + l * 96;
    bf16_t* Km = (bf16_t*)(ws + A_KM);
    bf16_t* Vm = (bf16_t*)(ws + A_VM);
    auto epi = [&](f32x16 (&a)[2], int m, int head, int part) {
      const int b = m / L, pos = m - b * L;
      const float rs = rsqrtf(ssc[m] * (1.f / 128.f) + EPS);
      float ssq = 0.f;
#pragma unroll
      for (int tn = 0; tn < 2; ++tn)
#pragma unroll
        for (int i = 0; i < 16; ++i) { a[tn][i] *= rs; ssq += a[tn][i] * a[tn][i]; }
      ssq = xor32(ssq);
      if (part == 0) {
        const float rr = rsqrtf((ssq + ss_kr[m]) * (1.f / 96.f) + EPS);
        bf16_t* drow = Km + ((size_t)(b * 8 + head) * LP + pos) * 96;
#pragma unroll
        for (int tn = 0; tn < 2; ++tn)
#pragma unroll
          for (int g4 = 0; g4 < 4; ++g4) {
            const int d = tn * 32 + 8 * g4 + 4 * h;
            const f32x4 gv = *(const f32x4*)(g + d);
            *(uint2*)(drow + d) = pk4(a[tn][4 * g4] * rr * gv[0], a[tn][4 * g4 + 1] * rr * gv[1], a[tn][4 * g4 + 2] * rr * gv[2],
                                      a[tn][4 * g4 + 3] * rr * gv[3]);
          }
        const int c0 = 8 * h;
        const bf16x8 k1 = *(const bf16x8*)(krp + (size_t)m * 32 + c0);
        const bf16x8 k2 = *(const bf16x8*)(krp + (size_t)m * 32 + 16 + c0);
        float o1[8], o2[8];
#pragma unroll
        for (int j = 0; j < 8; ++j) {
          float x1 = bf2f((bf16_t)k1[j]) * rr * g[64 + c0 + j];
          float x2 = bf2f((bf16_t)k2[j]) * rr * g[80 + c0 + j];
          float cs = rope_c[pos * 16 + c0 + j], sn = rope_s[pos * 16 + c0 + j];
          o1[j] = x1 * cs - x2 * sn;
          o2[j] = x2 * cs + x1 * sn;
        }
        *(uint4*)(drow + 64 + c0) = make_uint4(pk2(o1[0], o1[1]), pk2(o1[2], o1[3]), pk2(o1[4], o1[5]), pk2(o1[6], o1[7]));
        *(uint4*)(drow + 80 + c0) = make_uint4(pk2(o2[0], o2[1]), pk2(o2[2], o2[3]), pk2(o2[4], o2[5]), pk2(o2[6], o2[7]));
      } else {
        bf16_t* dcol = Vm + ((size_t)(b * 8 + head) * 64) * LP + pos;
#pragma unroll
        for (int tn = 0; tn < 2; ++tn)
#pragma unroll
          for (int i = 0; i < 16; ++i) {
            const int d = tn * 32 + (i & 3) + 8 * (i >> 2) + 4 * h;
            dcol[(size_t)d * LP] = f2bf(a[tn][i]);
          }
      }
    };
    {
      const int wm = wid >> 1, wn = wid & 1;
      for (int t = blockIdx.x; t < 8 * MT; t += gridDim.x) {
        const int head = t % 8, mt = t / 8;
        const int m0 = mt * 256;
        f32x16 acc[2][2];
        zero_acc(acc);
        gemm_main<4, 2, 2, 2>(A, [&](int row) { return (m0 + row) * 128; }, 64, W, 128, head * 128, 2, 256, acc, smem);
#pragma unroll
        for (int tm = 0; tm < 2; ++tm) epi(acc[tm], m0 + wm * 64 + tm * 32 + r, head, wn);
      }
    }
    for (int nt = (int)blockIdx.x - 16; nt >= 0 && nt < 4; nt += gridDim.x) {
      const int wm = wid >> 2, wn = wid & 3;
      f32x16 acc[1][2];
      zero_acc(acc);
      gemm_main<2, 4, 1, 2>(A, [&](int row) { return min(16384 + row, T - 1) * 128; }, 64, W, 128, nt * 256, 2, 64, acc, smem);
      epi(acc[0], 16384 + wm * 32 + r, nt * 2 + (wn >> 1), wn & 1);
    }
  }
  {
    const float* lf = (const float*)(ws + OFF_LF);
    float* cd = (float*)(ws + OFF_CDEC);
    float* wtot = (float*)smem;
    const int tid = threadIdx.x;
    for (int s = (int)blockIdx.x - 32; s >= 0 && s < 32; s += gridDim.x) {
      const int b = s >> 3, hd = s & 7;
      float v[9];
#pragma unroll
      for (int c = 0; c < 9; ++c) {
        const int pos = tid * 9 + c;
        v[c] = pos < L ? lf[((size_t)(b * L + pos)) * 8 + hd] : 0.f;
      }
#pragma unroll
      for (int c = 1; c < 9; ++c) v[c] += v[c - 1];
      float tot = v[8];
#pragma unroll
      for (int o = 1; o < 64; o <<= 1) {
        float u = __shfl_up(tot, o);
        if (lane >= o) tot += u;
      }
      __syncthreads();
      if (lane == 63) wtot[wid] = tot;
      __syncthreads();
      float base = tot - v[8];
      for (int w = 0; w < wid; ++w) base += wtot[w];
#pragma unroll
      for (int c = 0; c < 9; ++c) {
        const int pos = tid * 9 + c;
        if (pos < L) cd[(size_t)s * LP + pos] = v[c] + base;
      }
    }
  }
}

template <int DK, int MODE>
DI void attn_item(bf16_t* Qs, const bf16_t* __restrict__ Ks, const bf16_t* __restrict__ Vt, const float* __restrict__ cdec,
                  int q0, int q_end, float slope2, float sink2, char* smem) {
  constexpr int KROW = (DK + 8) * 2;
  constexpr int KSZ = 64 * KROW;
  constexpr int VSZ = 64 * 136;
  constexpr int STAGE = KSZ + VSZ + 256;
  constexpr int NKC = DK / 8;
  constexpr int NKT = 64 * NKC;
  constexpr int NKL = (NKT + 511) / 512;
  constexpr int NS = DK / 16;
  const int tid = threadIdx.x, lane = tid & 63, w = __builtin_amdgcn_readfirstlane(tid >> 6), r = lane & 31, h = lane >> 5;
  const int qi = q0 + w * 32 + r;
  const bool wave_on = q0 + w * 32 < q_end;
  bf16x8 qf[NS];
#pragma unroll
  for (int s = 0; s < NS; ++s) qf[s] = *(const bf16x8*)(Qs + (size_t)qi * DK + s * 16 + 8 * h);
  const int kt_hi = (q_end - 1) >> 6;
  int t_lo = 0, ntiles;
  if (MODE == 2) { t_lo = max(1, (q0 - 127) >> 6); ntiles = 1 + max(0, kt_hi - t_lo + 1); }
  else ntiles = kt_hi + 1;
  auto tile_of = [&](int j) { return MODE == 2 ? (j == 0 ? 0 : t_lo + j - 1) : j; };

  bf16x8 rk[NKL], rv;
  float rc = 0.f;
  auto gload = [&](int tile) {
    const int k0 = tile * 64;
#pragma unroll
    for (int i = 0; i < NKL; ++i) {
      const int c = tid + i * 512, row = c / NKC, cc = c % NKC;
      if (NKT % 512 == 0 || c < NKT) rk[i] = *(const bf16x8*)(Ks + (size_t)(k0 + row) * DK + cc * 8);
    }
    {
      const int row = tid >> 3, cc = tid & 7;
      rv = *(const bf16x8*)(Vt + (size_t)row * LP + k0 + cc * 8);
    }
    if (MODE == 0 && tid < 64) rc = cdec[k0 + tid] * LOG2E;
  };
  auto sstore = [&](int s) {
    char* kb = smem + s * STAGE;
    char* vb = kb + KSZ;
#pragma unroll
    for (int i = 0; i < NKL; ++i) {
      const int c = tid + i * 512, row = c / NKC, cc = c % NKC;
      if (NKT % 512 == 0 || c < NKT) *(bf16x8*)(kb + row * KROW + cc * 16) = rk[i];
    }
    {
      const int row = tid >> 3, cc = tid & 7;
      s16x4 lo = {rv[0], rv[1], rv[2], rv[3]}, hi = {rv[4], rv[5], rv[6], rv[7]};
      *(s16x4*)(vb + row * 136 + cc * 16) = lo;
      *(s16x4*)(vb + row * 136 + cc * 16 + 8) = hi;
    }
    if (MODE == 0 && tid < 64) *(float*)(vb + VSZ + tid * 4) = rc;
  };

  f32x16 o[2];
#pragma unroll
  for (int i = 0; i < 16; ++i) { o[0][i] = 0.f; o[1][i] = 0.f; }
  float m_run = -1e30f, l_run = 0.f;

  gload(tile_of(0));
  sstore(0);
#pragma unroll
  for (int s = 0; s < NS; ++s) asm volatile("" ::"v"(qf[s]));
  __syncthreads();
  for (int j = 0; j < ntiles; ++j) {
    if (j + 1 < ntiles) gload(tile_of(j + 1));
    __builtin_amdgcn_sched_barrier(0);
    const int k0 = tile_of(j) * 64;
    const char* kb = smem + (j & 1) * STAGE;
    const char* vb = kb + KSZ;
    bool active = wave_on && (k0 <= q0 + w * 32 + 31);
    if (MODE == 2) active = active && (k0 == 0 || k0 + 63 >= q0 + w * 32 - 127);
    if (active) {
      f32x16 s[2];
#pragma unroll
      for (int kt = 0; kt < 2; ++kt) {
#pragma unroll
        for (int i = 0; i < 16; ++i) s[kt][i] = 0.f;
#pragma unroll
        for (int ks = 0; ks < NS; ++ks) {
          bf16x8 kf = *(const bf16x8*)(kb + (kt * 32 + r) * KROW + ks * 32 + h * 16);
          s[kt] = mfma32(kf, qf[ks], s[kt]);
        }
      }
      const bool need_mask = (MODE == 2) || (k0 + 63 > q0 + w * 32);
      float mx = -1e30f;
      if (MODE == 0 || MODE == 2) {
#pragma unroll
        for (int kt = 0; kt < 2; ++kt)
#pragma unroll
          for (int g4 = 0; g4 < 4; ++g4) {
            const int kj0 = k0 + kt * 32 + 8 * g4 + 4 * h;
            f32x4 ck;
            if (MODE == 0) ck = *(const f32x4*)(vb + VSZ + (kt * 32 + 8 * g4 + 4 * h) * 4);
#pragma unroll
            for (int jj = 0; jj < 4; ++jj) {
              if (MODE == 0) s[kt][4 * g4 + jj] -= ck[jj];
              if (MODE == 2) s[kt][4 * g4 + jj] -= slope2 * (float)(qi - kj0 - jj);
            }
          }
      }
      if (__builtin_amdgcn_readfirstlane((int)need_mask)) {
#pragma unroll
        for (int kt = 0; kt < 2; ++kt)
#pragma unroll
          for (int i = 0; i < 16; ++i) {
            const int kj = k0 + kt * 32 + (i & 3) + 8 * (i >> 2) + 4 * h;
            bool ok = kj <= qi;
            if (MODE == 2) ok = ok && (kj < 16 || qi - kj < 128);
            s[kt][i] = ok ? s[kt][i] : -1e30f;
          }
        asm volatile("" ::: "memory");
      }
#pragma unroll
      for (int kt = 0; kt < 2; ++kt)
#pragma unroll
        for (int i = 0; i < 16; ++i) mx = fmaxf(mx, s[kt][i]);
      mx = max32(mx);
      const float m_new = fmaxf(m_run, mx);
      const float alpha = fexp2(m_run - m_new);
      m_run = m_new;
      float psum = 0.f;
#pragma unroll
      for (int kt = 0; kt < 2; ++kt)
#pragma unroll
        for (int i = 0; i < 16; ++i) {
          float pv = fexp2(s[kt][i] - m_new);
          s[kt][i] = pv;
          psum += pv;
        }
      l_run = l_run * alpha + psum;
      if (__builtin_amdgcn_ballot_w64(alpha != 1.f) != 0ull) {
#pragma unroll
        for (int i = 0; i < 16; ++i) { o[0][i] *= alpha; o[1][i] *= alpha; }
      }
#pragma unroll
      for (int kt = 0; kt < 2; ++kt)
#pragma unroll
        for (int st = 0; st < 2; ++st) {
          unsigned pw[4];
#pragma unroll
          for (int u = 0; u < 4; ++u) pw[u] = pk2(s[kt][8 * st + 2 * u], s[kt][8 * st + 2 * u + 1]);
          uint4 pu = make_uint4(pw[0], pw[1], pw[2], pw[3]);
          const bf16x8 pf = __builtin_bit_cast(bf16x8, pu);
#pragma unroll
          for (int dt = 0; dt < 2; ++dt) {
            const char* va = vb + (dt * 32 + r) * 136 + (kt * 32 + 16 * st + 4 * h) * 2;
            const s16x4 lo = *(const s16x4*)va;
            const s16x4 hi = *(const s16x4*)(va + 16);
            const bf16x8 vf = {lo[0], lo[1], lo[2], lo[3], hi[0], hi[1], hi[2], hi[3]};
            o[dt] = mfma32(vf, pf, o[dt]);
          }
        }
    }
    __builtin_amdgcn_sched_barrier(0);
    if (j + 1 < ntiles) sstore((j + 1) & 1);
    __syncthreads();
  }
  float lt = xor32(l_run);
  if (MODE == 2) lt += fexp2(sink2 - m_run);
  const float inv = 1.f / lt;
  if (qi < q_end) {
    bf16_t* orow = Qs + (size_t)qi * DK;
#pragma unroll
    for (int dt = 0; dt < 2; ++dt)
#pragma unroll
      for (int g4 = 0; g4 < 4; ++g4) {
        const int d = dt * 32 + 8 * g4 + 4 * h;
        *(uint2*)(orow + d) = pk4(o[dt][4 * g4] * inv, o[dt][4 * g4 + 1] * inv, o[dt][4 * g4 + 2] * inv, o[dt][4 * g4 + 3] * inv);
      }
  }
}

DI int next_item(unsigned* ctr, int* sidx) {
  if (threadIdx.x == 0) *sidx = (int)atomicAdd(ctr, 1u);
  __syncthreads();
  const int idx = *sidx;
  __syncthreads();
  return idx;
}
DI void phase_attn(const Params& p, int l, char* smem) {
  unsigned char* ws = p.ws;
  unsigned* ctr = (unsigned*)(ws + OFF_CTR) + l * 4;
  int* sidx = (int*)(smem + 147456);
  constexpr int NQT = 17, NIT = 32 * NQT;
#pragma unroll 1
  while (true) {
    const int idx = next_item(ctr, sidx);
    if (idx >= NIT) break;
    const int qt = NQT - 1 - (idx >> 5), bh = idx & 31;
    const int q0 = qt == 0 ? 0 : 16 + 256 * (qt - 1), q_end = qt == 0 ? 16 : q0 + 256;
    attn_item<64, 0>((bf16_t*)(ws + A_QF) + (size_t)bh * LP * 64, (const bf16_t*)(ws + A_KF) + (size_t)bh * LP * 64,
                     (const bf16_t*)(ws + A_VF) + (size_t)bh * 64 * LP, (const float*)(ws + OFF_CDEC) + (size_t)bh * LP, q0, q_end,
                     0.f, 0.f, smem);
  }
#pragma unroll 1
  while (true) {
    const int idx = next_item(ctr + 1, sidx);
    if (idx >= NIT) break;
    const int qt = NQT - 1 - (idx >> 5), bh = idx & 31;
    const int q0 = qt == 0 ? 0 : 16 + 256 * (qt - 1), q_end = qt == 0 ? 16 : q0 + 256;
    attn_item<96, 1>((bf16_t*)(ws + A_QM) + (size_t)bh * LP * 96, (const bf16_t*)(ws + A_KM) + (size_t)bh * LP * 96,
                     (const bf16_t*)(ws + A_VM) + (size_t)bh * 64 * LP, nullptr, q0, q_end, 0.f, 0.f, smem);
  }
#pragma unroll 1
  while (true) {
    const int idx = next_item(ctr + 2, sidx);
    if (idx >= NIT) break;
    const int qt = idx >> 5, bh = idx & 31, b = bh >> 3, hq = bh & 7, hk = hq >> 2;
    const int q0 = qt == 0 ? 0 : 16 + 256 * (qt - 1), q_end = qt == 0 ? 16 : q0 + 256;
    const float slope2 = fexp2(-(float)(hq + 1)) * LOG2E;
    const float sink2 = p.in[15][l * 8 + hq] * LOG2E;
    attn_item<64, 2>((bf16_t*)(ws + A_QS) + (size_t)bh * LP * 64, (const bf16_t*)(ws + A_KS) + (size_t)(b * 2 + hk) * LP * 64,
                     (const bf16_t*)(ws + A_VS) + (size_t)(b * 2 + hk) * 64 * LP, nullptr, q0, q_end, slope2, sink2, smem);
  }
}

DI void phase_merge(const Params& p, int l, char* smem) {
  unsigned char* ws = p.ws;
  const bf16_t* hb = (const bf16_t*)(ws + OFF_HB);
  const bf16_t* Wg = (const bf16_t*)(ws + OFF_WG);
  const bf16_t* Wb = (const bf16_t*)(ws + OFF_WBR);
  const float* ss1 = (const float*)(ws + OFF_SS) + (size_t)(l * 2) * T;
  bf16_t* merged = (bf16_t*)(ws + A_MERGED);
  const int lane = threadIdx.x & 63, wid = __builtin_amdgcn_readfirstlane(threadIdx.x >> 6), r = lane & 31, h = lane >> 5, wm = wid >> 1, wn = wid & 1;
  constexpr int NT = 8, MT = 64;
  TileIter tit(NT * MT);
  for (int t = tit.next(); t >= 0; t = tit.next()) {
    const int nt = t % NT, mt = t / NT;
    const int m0 = mt * 256, n0 = nt * 128;
    float rs[2];
#pragma unroll
    for (int tm = 0; tm < 2; ++tm) rs[tm] = rsqrtf(ss1[min(m0 + wm * 64 + tm * 32 + r, T - 1)] * (1.f / 1024.f) + EPS);
#pragma unroll 1
    for (int n = 0; n < 3; ++n) {
      f32x16 acc[2][2];
      zero_acc(acc);
      gemm_main<4, 2, 2, 2, false>(hb, [&](int row) { return min(m0 + row, T - 1) * D; }, 64, Wg + (size_t)n * 1024 * 1024, D, n0, D / 64,
                            T - m0, acc, smem);
      unsigned gp[2][2][8];
#pragma unroll
      for (int tm = 0; tm < 2; ++tm)
#pragma unroll
      for (int tn = 0; tn < 2; ++tn)
#pragma unroll
        for (int u = 0; u < 8; ++u) {
          float a = __builtin_amdgcn_rcpf(1.f + __expf(-acc[tm][tn][2 * u] * rs[tm]));
          float bq = __builtin_amdgcn_rcpf(1.f + __expf(-acc[tm][tn][2 * u + 1] * rs[tm]));
          gp[tm][tn][u] = pk2(a, bq);
        }
      zero_acc(acc);
      const bf16_t* Ab;
      int rstride, kstride;
      if (n == 0) { Ab = (const bf16_t*)(ws + A_QF); rstride = 64; kstride = LP * 64; }
      else if (n == 1) { Ab = (const bf16_t*)(ws + A_QM); rstride = 96; kstride = LP * 96; }
      else { Ab = (const bf16_t*)(ws + A_QS); rstride = 64; kstride = LP * 64; }
      gemm_main<4, 2, 2, 2, false>(Ab, [&](int row) {
        int mr = min(m0 + row, T - 1);
        int b = mr / L, pos = mr - b * L;
        return (b * 8 * LP + pos) * rstride; }, kstride, Wb + (size_t)n * 1024 * 512, 512, n0, 8, T - m0, acc, smem);
#pragma unroll
      for (int tm = 0; tm < 2; ++tm) {
        const int m = m0 + wm * 64 + tm * 32 + r;
        if (m < T) {
#pragma unroll
          for (int tn = 0; tn < 2; ++tn)
#pragma unroll
            for (int g4 = 0; g4 < 4; ++g4) {
              const int col = n0 + wn * 64 + tn * 32 + 8 * g4 + 4 * h;
              uint2* dst = (uint2*)(merged + (size_t)m * D + col);
              uint2 old = make_uint2(0u, 0u);
              if (n > 0) old = *dst;
              const unsigned g0 = gp[tm][tn][2 * g4], g1 = gp[tm][tn][2 * g4 + 1];
              float f0 = __uint_as_float(g0 << 16) * acc[tm][tn][4 * g4] + __uint_as_float(old.x << 16);
              float f1 = __uint_as_float(g0 & 0xffff0000u) * acc[tm][tn][4 * g4 + 1] + __uint_as_float(old.x & 0xffff0000u);
              float f2 = __uint_as_float(g1 << 16) * acc[tm][tn][4 * g4 + 2] + __uint_as_float(old.y << 16);
              float f3 = __uint_as_float(g1 & 0xffff0000u) * acc[tm][tn][4 * g4 + 3] + __uint_as_float(old.y & 0xffff0000u);
              *dst = pk4(f0, f1, f2, f3);
            }
        }
      }
    }
  }
  {
    const int wm1 = wid >> 2, wn1 = wid & 3;
    for (int nt = blockIdx.x; nt < 8; nt += gridDim.x) {
      const int m0 = 16384, n0 = nt * 128;
      const int m = m0 + wm1 * 32 + r;
      const float rs1 = rsqrtf(ss1[m] * (1.f / 1024.f) + EPS);
#pragma unroll 1
      for (int n = 0; n < 3; ++n) {
        f32x16 acc[1][1];
        zero_acc(acc);
        gemm_rem(hb, [&](int row) { return min(m0 + row, T - 1) * D; }, 64, Wg + (size_t)n * 1024 * 1024, D, n0, D / 64, acc[0][0], smem);
        unsigned gp[8];
#pragma unroll
        for (int u = 0; u < 8; ++u)
          gp[u] = pk2(__builtin_amdgcn_rcpf(1.f + __expf(-acc[0][0][2 * u] * rs1)), __builtin_amdgcn_rcpf(1.f + __expf(-acc[0][0][2 * u + 1] * rs1)));
        zero_acc(acc);
        const bf16_t* Ab;
        int rstride, kstride;
        if (n == 0) { Ab = (const bf16_t*)(ws + A_QF); rstride = 64; kstride = LP * 64; }
        else if (n == 1) { Ab = (const bf16_t*)(ws + A_QM); rstride = 96; kstride = LP * 96; }
        else { Ab = (const bf16_t*)(ws + A_QS); rstride = 64; kstride = LP * 64; }
        gemm_rem(Ab, [&](int row) {
          int mr = min(m0 + row, T - 1);
          int b = mr / L, pos = mr - b * L;
          return (b * 8 * LP + pos) * rstride; }, kstride, Wb + (size_t)n * 1024 * 512, 512, n0, 8, acc[0][0], smem);
#pragma unroll
        for (int g4 = 0; g4 < 4; ++g4) {
          const int col = n0 + wn1 * 32 + 8 * g4 + 4 * h;
          uint2* dst = (uint2*)(merged + (size_t)m * D + col);
          uint2 old = make_uint2(0u, 0u);
          if (n > 0) old = *dst;
          const unsigned g0 = gp[2 * g4], g1 = gp[2 * g4 + 1];
          float f0 = __uint_as_float(g0 << 16) * acc[0][0][4 * g4] + __uint_as_float(old.x << 16);
          float f1 = __uint_as_float(g0 & 0xffff0000u) * acc[0][0][4 * g4 + 1] + __uint_as_float(old.x & 0xffff0000u);
          float f2 = __uint_as_float(g1 << 16) * acc[0][0][4 * g4 + 2] + __uint_as_float(old.y << 16);
          float f3 = __uint_as_float(g1 & 0xffff0000u) * acc[0][0][4 * g4 + 3] + __uint_as_float(old.y & 0xffff0000u);
          *dst = pk4(f0, f1, f2, f3);
        }
      }
    }
  }
}


DI void stage_half(const f32x16 (&acc)[4][2], int hp, int wm, int wn, int r, int h, const float (&rowscale)[4], float* stg) {
  if ((wn >> 1) == hp) {
#pragma unroll
    for (int tm = 0; tm < 4; ++tm) {
      float* srow = stg + (wm * 128 + tm * 32 + r) * 132 + (wn & 1) * 64 + 4 * h;
#pragma unroll
      for (int tn = 0; tn < 2; ++tn)
#pragma unroll
        for (int g4 = 0; g4 < 4; ++g4) {
          f32x4 v = {acc[tm][tn][4 * g4] * rowscale[tm], acc[tm][tn][4 * g4 + 1] * rowscale[tm],
                     acc[tm][tn][4 * g4 + 2] * rowscale[tm], acc[tm][tn][4 * g4 + 3] * rowscale[tm]};
          *(f32x4*)(srow + tn * 32 + 8 * g4) = v;
        }
    }
  }
}

DI void phase_resid(const Params& p, const bf16_t* A, int K, const bf16_t* W, float* ss_next, bool last, char* smem) {
  unsigned char* ws = p.ws;
  bf16_t* hb = (bf16_t*)(ws + OFF_HB);
  const int tid = threadIdx.x, lane = tid & 63, wid = __builtin_amdgcn_readfirstlane(tid >> 6), r = lane & 31, h = lane >> 5, wm = wid >> 2, wn = wid & 3;
  constexpr int NT = 4, MT = 64;
  float* stg = (float*)smem;
  TileIter tit(NT * MT);
  for (int t = tit.next(); t >= 0; t = tit.next()) {
    const int nt = t % NT, mt = t / NT;
    const int m0 = mt * 256, n0 = nt * 256;
    f32x16 acc[4][2];
    zero_acc(acc);
    gemm_main<2, 4, 4, 2>(A, [&](int row) { return min(m0 + row, T - 1) * K; }, 64, W, K, n0, K / 64, T - m0, acc, smem);
    const float ones[4] = {1.f, 1.f, 1.f, 1.f};
#pragma unroll 1
    for (int hp = 0; hp < 2; ++hp) {
      const int chunk = tid & 15;
      const int col = n0 + hp * 128 + chunk * 8;
      f32x4 h0[2], h1[2];
      auto hptr = [&](int it) {
        const int m = m0 + (tid >> 4) + 32 * it;
        const int b = m / L, pos = m - b * L;
        return hrow(p, b, pos) + col;
      };
      auto issue = [&](int bt) {
#pragma unroll
        for (int q = 0; q < 2; ++q) {
          const float* hp_ = hptr(bt * 2 + q);
          h0[q] = *(const f32x4*)hp_;
          h1[q] = *(const f32x4*)(hp_ + 4);
        }
      };
      auto process = [&](int bt) {
#pragma unroll
        for (int q = 0; q < 2; ++q) {
          const int row = (tid >> 4) + 32 * (bt * 2 + q);
          const int m = m0 + row;
          float* hp_ = hptr(bt * 2 + q);
          const f32x4 a0 = *(const f32x4*)(stg + row * 132 + chunk * 8);
          const f32x4 a1 = *(const f32x4*)(stg + row * 132 + chunk * 8 + 4);
          f32x4 v0, v1;
          float ssq = 0.f;
#pragma unroll
          for (int j = 0; j < 4; ++j) {
            v0[j] = a0[j] + h0[q][j];
            v1[j] = a1[j] + h1[q][j];
            ssq += v0[j] * v0[j] + v1[j] * v1[j];
          }
          *(f32x4*)hp_ = v0;
          *(f32x4*)(hp_ + 4) = v1;
          if (!last) {
            *(uint4*)(hb + (size_t)m * D + col) = make_uint4(pk2(v0[0], v0[1]), pk2(v0[2], v0[3]), pk2(v1[0], v1[1]), pk2(v1[2], v1[3]));
            ssq += __shfl_xor(ssq, 8);
            ssq += __shfl_xor(ssq, 4);
            ssq += __shfl_xor(ssq, 2);
            ssq += __shfl_xor(ssq, 1);
            if (chunk == 0) atomicAdd(ss_next + m, ssq);
          }
        }
      };
      issue(0);
      stage_half(acc, hp, wm, wn, r, h, ones, stg);
      __syncthreads();
      process(0);
#pragma unroll
      for (int bt = 1; bt < 4; ++bt) {
        __builtin_amdgcn_sched_barrier(0);
        issue(bt);
        process(bt);
      }
      __syncthreads();
    }
  }
  for (int nt = blockIdx.x; nt < 8; nt += gridDim.x) {
    const int m0 = 16384, n0 = nt * 128;
    f32x16 acc[1][1];
    zero_acc(acc);
    gemm_rem(A, [&](int row) { return min(m0 + row, T - 1) * K; }, 64, W, K, n0, K / 64, acc[0][0], smem);
    const int m = m0 + wm * 32 + r;
    const int b = m / L, pos = m - b * L;
    float* hr = hrow(p, b, pos);
    float ssq = 0.f;
    f32x4 hv[4];
#pragma unroll
    for (int g4 = 0; g4 < 4; ++g4) hv[g4] = *(const f32x4*)(hr + n0 + wn * 32 + 8 * g4 + 4 * h);
#pragma unroll
    for (int g4 = 0; g4 < 4; ++g4) {
      const int col = n0 + wn * 32 + 8 * g4 + 4 * h;
      f32x4 v;
#pragma unroll
      for (int j = 0; j < 4; ++j) { v[j] = hv[g4][j] + acc[0][0][4 * g4 + j]; ssq += v[j] * v[j]; }
      *(f32x4*)(hr + col) = v;
      if (!last) *(uint2*)(hb + (size_t)m * D + col) = pk4(v[0], v[1], v[2], v[3]);
    }
    ssq = xor32(ssq);
    if (!last && h == 0) atomicAdd(ss_next + m, ssq);
  }
}

DI void phase_up(const Params& p, int l, char* smem) {
  unsigned char* ws = p.ws;
  const bf16_t* hb = (const bf16_t*)(ws + OFF_HB);
  const bf16_t* W = (const bf16_t*)(ws + OFF_WUP);
  const float* ss2 = (const float*)(ws + OFF_SS) + (size_t)(l * 2 + 1) * T;
  const float* cw = p.in[20] + (size_t)l * 3 * 5632;
  const float* cb = p.in[21] + (size_t)l * 5632;
  bf16_t* act = (bf16_t*)(ws + A_ACT);
  const int tid = threadIdx.x, lane = tid & 63, wid = __builtin_amdgcn_readfirstlane(tid >> 6), r = lane & 31, h = lane >> 5, wm = wid >> 2, wn = wid & 3;
  constexpr int NT = 5632 / 256, MT = (T + 253) / 254;
  float* stg = (float*)smem;
  TileIter tit(NT * MT);
  for (int t = tit.next(); t >= 0; t = tit.next()) {
    const int nt = t % NT, mt = t / NT;
    const int mbase = mt * 254 - 2, n0 = nt * 256;
    f32x16 acc[4][2];
    zero_acc(acc);
    float rsv[4];
#pragma unroll
    for (int tm = 0; tm < 4; ++tm) rsv[tm] = ss2[min(max(mbase + wm * 128 + tm * 32 + r, 0), T - 1)];
    gemm_main<2, 4, 4, 2>(hb, [&](int row) { return min(max(mbase + row, 0), T - 1) * D; }, 64, W, D, n0, D / 64, T - mbase, acc,
                          smem);
#pragma unroll
    for (int tm = 0; tm < 4; ++tm) rsv[tm] = rsqrtf(rsv[tm] * (1.f / 1024.f) + EPS);
#pragma unroll 1
    for (int hp = 0; hp < 2; ++hp) {
      const int chunk = tid & 15, grp = chunk >> 3, jl0 = (chunk & 7) * 4;
      const int jg0 = (n0 / 64 + hp * 2 + grp) * 32 + jl0;
      f32x4 wg[3], wv[3];
#pragma unroll
      for (int i = 0; i < 3; ++i) {
        wg[i] = *(const f32x4*)(cw + i * 5632 + jg0);
        wv[i] = *(const f32x4*)(cw + i * 5632 + DFF + jg0);
      }
      const f32x4 bg = *(const f32x4*)(cb + jg0), bv = *(const f32x4*)(cb + DFF + jg0);
      stage_half(acc, hp, wm, wn, r, h, rsv, stg);
      __syncthreads();
      {
        const float* sgc = stg + grp * 64 + jl0;
#pragma unroll 2
        for (int it = 0; it < 8; ++it) {
          const int row = 2 + (tid >> 4) + 32 * it;
          const int gm = mbase + row;
          if (row < 256 && gm < T) {
            const int b = gm / L, pos = gm - b * L;
            const float* s0 = sgc + row * 132;
            const f32x4 g0 = *(const f32x4*)(s0), v0 = *(const f32x4*)(s0 + 32);
            const f32x4 g1 = *(const f32x4*)(s0 - 132), v1 = *(const f32x4*)(s0 - 132 + 32);
            const f32x4 g2 = *(const f32x4*)(s0 - 264), v2 = *(const f32x4*)(s0 - 264 + 32);
            float o[4];
#pragma unroll
            for (int j = 0; j < 4; ++j) {
              float a = bg[j] + wg[2][j] * g0[j], c = bv[j] + wv[2][j] * v0[j];
              if (pos >= 1) { a += wg[1][j] * g1[j]; c += wv[1][j] * v1[j]; }
              if (pos >= 2) { a += wg[0][j] * g2[j]; c += wv[0][j] * v2[j]; }
              o[j] = a * __builtin_amdgcn_rcpf(1.f + __expf(-a)) * c;
            }
            *(uint2*)(act + (size_t)gm * DFF + jg0) = pk4(o[0], o[1], o[2], o[3]);
          }
        }
      }
      __syncthreads();
    }
  }
}

#define XB_TMO      128
#define XB_XCNT(j)  (256  + 64 * (j))
#define XB_XSUB(j)  (1280 + 64 * (j))
#define XB_XGEN(j)  (2304 + 64 * (j))
#define XB_TOP      3328
#define XB_TOPGEN   3392
#define XB_SPIN_CAP (1u << 22)
DI unsigned xb_ld(unsigned* p) { return __hip_atomic_load(p, __ATOMIC_RELAXED, __HIP_MEMORY_SCOPE_AGENT); }
DI unsigned xb_add(unsigned* p, unsigned v) { return __hip_atomic_fetch_add(p, v, __ATOMIC_RELAXED, __HIP_MEMORY_SCOPE_AGENT); }
DI unsigned xb_xcc_id() { return (unsigned)__builtin_amdgcn_s_getreg((3 << 11) | 20) & 0xFu; }
#define XB_SPIN(cond, bar) do { unsigned _sp = 0; while (cond) { __builtin_amdgcn_s_sleep(1); \
    if ((++_sp & 255u) == 0u) { if (xb_ld(&(bar)[XB_TMO])) break; if (_sp > XB_SPIN_CAP) { atomicAdd(&(bar)[XB_TMO], 1u); break; } } } } while (0)
DI void xcd_barrier_complete(unsigned* bar, unsigned x, unsigned& nloc, unsigned& nx) {
  const unsigned G = gridDim.x;
  unsigned sum, cnt, mine, sp = 0u;
  for (;;) {
    sum = 0u; cnt = 0u; mine = 0u;
#pragma unroll
    for (unsigned j = 0; j < 16; ++j) { const unsigned c = xb_ld(&bar[XB_XCNT(j)]); sum += c; cnt += (c > 0u) ? 1u : 0u; mine = (j == x) ? c : mine; }
    if (sum == G) break;
    __builtin_amdgcn_s_sleep(1);
    if ((++sp & 255u) == 0u) { if (xb_ld(&bar[XB_TMO])) break; if (sp > XB_SPIN_CAP) { atomicAdd(&bar[XB_TMO], 1u); break; } }
  }
  nloc = mine > 0u ? mine : 1u; nx = cnt > 0u ? cnt : 1u;
}
DI void xcd_barrier(unsigned* bar, unsigned x, volatile unsigned* st) {
  asm volatile("s_waitcnt vmcnt(0)" ::: "memory");
  __syncthreads();
  if (threadIdx.x == 0) {
    __builtin_amdgcn_s_waitcnt(0);
    unsigned nloc = st[0], nx = st[1];
    if (nloc == 0u) { xcd_barrier_complete(bar, x, nloc, nx); st[0] = nloc; st[1] = nx; }
    const unsigned old = xb_add(&bar[XB_XSUB(x)], 1u);
    const unsigned gen = old / nloc;
    if (old + 1u == (gen + 1u) * nloc) {
      __builtin_amdgcn_fence(__ATOMIC_RELEASE, "agent");
      asm volatile("s_waitcnt vmcnt(0)" ::: "memory");
      const unsigned og = xb_add(&bar[XB_TOP], 1u);
      const unsigned tg = og / nx;
      if (og + 1u == (tg + 1u) * nx) xb_add(&bar[XB_TOPGEN], 1u);
      else XB_SPIN(xb_ld(&bar[XB_TOPGEN]) == tg, bar);
      __builtin_amdgcn_fence(__ATOMIC_ACQUIRE, "agent");
      xb_add(&bar[XB_XGEN(x)], 1u);
      asm volatile("s_waitcnt vmcnt(0)" ::: "memory");
    } else {
      XB_SPIN(xb_ld(&bar[XB_XGEN(x)]) == gen, bar);
      __builtin_amdgcn_fence(__ATOMIC_ACQUIRE, "agent");
      asm volatile("s_waitcnt vmcnt(0)" ::: "memory");
    }
  }
  __syncthreads();
}

constexpr int NPHASES = 15;
__global__ void __launch_bounds__(NTHREADS, 2) mega_kernel(Params p) {
  __shared__ __attribute__((aligned(16))) char smem[SMEM_BYTES];
  cg::grid_group grid = cg::this_grid();
  unsigned char* ws = p.ws;
  int ph = 0;
  __shared__ __attribute__((aligned(16))) unsigned xb_st[4];
  unsigned* xbar = (unsigned*)(ws + OFF_XBAR);
  const unsigned xb_x = xb_xcc_id();
  if (threadIdx.x < 4) xb_st[threadIdx.x] = 0u;
#define RUN(body)                                   \
  {                                                 \
    if (ph >= p.ph_lo && ph < p.ph_hi) {            \
      body;                                         \
      if (ph + 1 < p.ph_hi) {                       \
        if (ph == 0) {                              \
          grid.sync();                              \
          if (threadIdx.x == 0) (void)xb_add(&xbar[XB_XCNT(xb_x)], 1u); \
        } else xcd_barrier(xbar, xb_x, xb_st);      \
      }                                             \
    }                                               \
    ++ph;                                           \
  }
  RUN(convert_layer(p, 0, smem); phase_init(p));
#define LAYER(l)                                                                                          \
  RUN(if (l == 1) convert_layer(p, 1, smem, 2); phase_inproj(p, l, smem));                                                                          \
  RUN(phase_mla_up(p, l, smem));                                                                          \
  RUN(phase_attn(p, l, smem));                                                                            \
  RUN(phase_merge(p, l, smem));                                                                           \
  RUN(phase_resid(p, (const bf16_t*)(ws + A_MERGED), 1024, (const bf16_t*)(ws + OFF_WO),                  \
                  (float*)(ws + OFF_SS) + (size_t)(l * 2 + 1) * T, false, smem));                         \
  RUN(phase_up(p, l, smem));                                                                              \
  RUN(phase_resid(p, (const bf16_t*)(ws + A_ACT), DFF, (const bf16_t*)(ws + OFF_WDN),                     \
                  (float*)(ws + OFF_SS) + (size_t)((l + 1) * 2) * T, l == 1, smem); if (l == 0) convert_layer(p, 1, smem, 1, 8));
  LAYER(0)
  LAYER(1)
#undef LAYER
#undef RUN
}

extern "C" void kernel_launch(void* const* d_in, const int* in_sizes, int n_in, void* d_out, int out_size, void* d_ws,
                              size_t ws_size, hipStream_t stream) {
  static int grid_blocks = 0;
  if (!grid_blocks) {
    int dev = 0, cus = 0, per_cu = 0;
    hipGetDevice(&dev);
    hipDeviceGetAttribute(&cus, hipDeviceAttributeMultiprocessorCount, dev);
    hipOccupancyMaxActiveBlocksPerMultiprocessor(&per_cu, mega_kernel, NTHREADS, 0);
    if (per_cu < 1) per_cu = 1;
    if (per_cu > 1) per_cu = 1;
    grid_blocks = cus * per_cu;
    if (ws_size < A_END) fprintf(stderr, "workspace too small: %zu < %zu\n", ws_size, (size_t)A_END);
  }
  Params p{};
  for (int i = 0; i < 23; ++i) p.in[i] = (const float*)d_in[i];
  p.out = (float*)d_out;
  p.ws = (unsigned char*)d_ws;
  p.ph_lo = 0;
  p.ph_hi = NPHASES;
  void* args[] = {&p};
  hipError_t e = hipLaunchCooperativeKernel((void*)mega_kernel, dim3(grid_blocks), dim3(NTHREADS), args, 0, stream);
  if (e != hipSuccess) fprintf(stderr, "cooperative launch failed: %s (grid %d)\n", hipGetErrorString(e), grid_blocks);
}
```

```cpp
#include <hip/hip_runtime.h>
#include <hip/hip_cooperative_groups.h>
#include <cstdio>
namespace cg = cooperative_groups;

#define DI __device__ __forceinline__
typedef __attribute__((ext_vector_type(8))) short bf16x8;
typedef __attribute__((ext_vector_type(4))) short s16x4;
typedef __attribute__((ext_vector_type(16))) float f32x16;
typedef __attribute__((ext_vector_type(4))) float f32x4;
typedef __attribute__((ext_vector_type(2))) float f32x2;
typedef __attribute__((ext_vector_type(2))) __bf16 bf16x2_t;
typedef unsigned short bf16_t;

constexpr int D = 1024, NBATCH = 4, SEQ = 4096, L = 4112, T = NBATCH * L  , LP = 4224;
constexpr int DFF = 2816;
constexpr int NIN = 2816;
constexpr float EPS = 1e-6f;
constexpr float LOG2E = 1.4426950408889634f;
constexpr int NTHREADS = 512;
constexpr int SMEM_BYTES = 147456 + 64;

constexpr size_t OFF_WIN = 0;
constexpr size_t OFF_WG = OFF_WIN + (size_t)NIN * 1024 * 2;
constexpr size_t OFF_WQUP = OFF_WG + (size_t)3072 * 1024 * 2;
constexpr size_t OFF_WKVUP = OFF_WQUP + (size_t)768 * 256 * 2;
constexpr size_t OFF_WBR = OFF_WKVUP + (size_t)1024 * 128 * 2;
constexpr size_t OFF_WO = OFF_WBR + (size_t)3 * 1024 * 512 * 2;
constexpr size_t OFF_WUP = OFF_WO + (size_t)1024 * 1024 * 2;
constexpr size_t OFF_WDN = OFF_WUP + (size_t)5632 * 1024 * 2;
constexpr size_t OFF_HB = OFF_WDN + (size_t)1024 * 2816 * 2;
constexpr size_t OFF_SS = OFF_HB + (size_t)T * 1024 * 2;
constexpr size_t OFF_SSKR = OFF_SS + (size_t)8 * T * 4;
constexpr size_t OFF_ROPE = OFF_SSKR + (size_t)T * 4;
constexpr size_t OFF_LF = OFF_ROPE + (size_t)L * 32 * 4;
constexpr size_t OFF_CDEC = OFF_LF + (size_t)T * 8 * 4;
constexpr size_t OFF_HMETA = OFF_CDEC + (size_t)32 * LP * 4;
constexpr size_t OFF_KR = OFF_HMETA + (size_t)64 * 1024 * 4;
constexpr size_t OFF_CTR = OFF_KR + (size_t)T * 32 * 2;
constexpr size_t OFF_XBAR = OFF_CTR + 256;
constexpr size_t OFF_ARENA = OFF_XBAR + 3456 * 4 + 128;
constexpr size_t SZ64 = (size_t)NBATCH * 8 * LP * 64 * 2;
constexpr size_t SZ96 = (size_t)NBATCH * 8 * LP * 96 * 2;
constexpr size_t SZKS = (size_t)NBATCH * 2 * LP * 64 * 2;
constexpr size_t A_QF = OFF_ARENA;
constexpr size_t A_QS = A_QF + SZ64;
constexpr size_t A_QM = A_QS + SZ64;
constexpr size_t A_KF = A_QM + SZ96;
constexpr size_t A_VF = A_KF + SZ64;
constexpr size_t A_KS = A_VF + SZ64;
constexpr size_t A_VS = A_KS + SZKS;
constexpr size_t A_KM = A_VS + SZKS;
constexpr size_t A_VM = A_KM + SZ96;
constexpr size_t A_CQ = A_VM + SZ64;
constexpr size_t A_CKV = A_CQ + (size_t)T * 256 * 2;
constexpr size_t A_END = A_CKV + (size_t)T * 128 * 2;
constexpr size_t OFF_MREM = A_END;
static_assert(OFF_MREM + (size_t)3 * 64 * 1024 * 4 <= (size_t)256 * 1024 * 1024, "mrem");
constexpr size_t A_MERGED = A_KF;
constexpr size_t A_ACT = OFF_ARENA;
static_assert((size_t)T * 1024 * 2 <= 2 * SZ64, "merged alias");
static_assert(A_END <= (size_t)256 * 1024 * 1024, "workspace");
static_assert(A_ACT + (size_t)T * 2816 * 2 <= A_END, "act alias");

struct Params {
  const float* in[23];
  float* out;
  unsigned char* ws;
  int ph_lo, ph_hi;
};

__device__ const double ROPE_FREQ[16] = {1.0, 0.5623413251903491, 0.31622776601683794, 0.1778279410038923, 0.1, 0.05623413251903491,
  0.03162277660168379, 0.01778279410038923, 0.01, 0.005623413251903491, 0.0031622776601683794, 0.0017782794100389228, 0.001,
  0.0005623413251903491, 0.00031622776601683794, 0.00017782794100389227};

DI unsigned pk2(float a, float b) {
  f32x2 v = {a, b};
  bf16x2_t r = __builtin_convertvector(v, bf16x2_t);
  return __builtin_bit_cast(unsigned, r);
}
DI uint2 pk4(float a, float b, float c, float d) { return make_uint2(pk2(a, b), pk2(c, d)); }
DI bf16_t f2bf(float v) { return (bf16_t)(pk2(v, 0.f) & 0xffffu); }
DI float bf2f(bf16_t v) { return __uint_as_float(((unsigned)v) << 16); }
DI float xor32(float v) {
  const auto r = __builtin_amdgcn_permlane32_swap(__float_as_uint(v), __float_as_uint(v), false, false);
  return __uint_as_float(r[0]) + __uint_as_float(r[1]);
}
DI float max32(float v) {
  const auto r = __builtin_amdgcn_permlane32_swap(__float_as_uint(v), __float_as_uint(v), false, false);
  return fmaxf(__uint_as_float(r[0]), __uint_as_float(r[1]));
}
DI float fexp2(float x) { return __builtin_amdgcn_exp2f(x); }
DI f32x16 mfma32(bf16x8 a, bf16x8 b, f32x16 c) { return __builtin_amdgcn_mfma_f32_32x32x16_bf16(a, b, c, 0, 0, 0); }
DI float* hrow(const Params& p, int b, int pos) {
  return pos >= 16 ? p.out + ((size_t)(b * SEQ + pos - 16)) * D : (float*)(p.ws + OFF_HMETA) + (size_t)(b * 16 + pos) * D;
}

template <int WM, int WN, int TM, int TN, bool LOWREG = false, class RowOff>
DI void gemm_main(const bf16_t* __restrict__ A, RowOff rowoff, int a_kstride, const bf16_t* __restrict__ Bt, int ldb, int n0,
                  int nk, int mvalid, f32x16 (&acc)[TM][TN], char* smem) {
  static_assert(WM * WN == 8, "8 waves");
  constexpr int BM = WM * TM * 32, BN = WN * TN * 32;
  constexpr int NA = (BM + 63) / 64, NB = (BN + 63) / 64;
  constexpr int STAGE = (BM + BN) * 144;
  static_assert(2 * STAGE <= 147456, "smem");
  const int tid = threadIdx.x, lane = tid & 63, wid = __builtin_amdgcn_readfirstlane(tid >> 6);
  const int r = lane & 31, h = lane >> 5;
  const int wm = wid / WN, wn = wid % WN;
  const int lrow = tid >> 3, c8 = tid & 7;
  int aoff[NA];
#pragma unroll
  for (int i = 0; i < NA; ++i) aoff[i] = rowoff(min(lrow + 64 * i, BM - 1)) + c8 * 8;
  const bf16_t* bptr = Bt + (size_t)(n0 + lrow) * ldb + c8 * 8;
  bf16x8 ra0[NA], rb0[NB];
  auto gload = [&](int kt, bf16x8 (&ra)[NA], bf16x8 (&rb)[NB]) {
#pragma unroll
    for (int i = 0; i < NA; ++i) ra[i] = *(const bf16x8*)(A + aoff[i] + (size_t)kt * a_kstride);
#pragma unroll
    for (int i = 0; i < NB; ++i)
      if (BN % 64 == 0 || lrow + 64 * i < BN) rb[i] = *(const bf16x8*)(bptr + (size_t)(64 * i) * ldb + kt * 64);
  };
  auto sstore = [&](int s, bf16x8 (&ra)[NA], bf16x8 (&rb)[NB]) {
    char* as = smem + s * STAGE;
    char* bs = as + BM * 144;
#pragma unroll
    for (int i = 0; i < NA; ++i)
      if (BM % 64 == 0 || lrow + 64 * i < BM) *(bf16x8*)(as + (lrow + 64 * i) * 144 + c8 * 16) = ra[i];
#pragma unroll
    for (int i = 0; i < NB; ++i)
      if (BN % 64 == 0 || lrow + 64 * i < BN) *(bf16x8*)(bs + (lrow + 64 * i) * 144 + c8 * 16) = rb[i];
  };
  const int ntm = min(TM, max(0, (mvalid - wm * TM * 32 + 31) >> 5));
  auto half_a = [&](int kt) {
    if (kt + 1 < nk) {
      char* as = smem + ((kt + 1) & 1) * STAGE;
#pragma unroll
      for (int i = 0; i < NA; ++i)
        if (BM % 64 == 0 || lrow + 64 * i < BM) *(bf16x8*)(as + (lrow + 64 * i) * 144 + c8 * 16) = ra0[i];
    }
    if (kt + 2 < nk) {
#pragma unroll
      for (int i = 0; i < NA; ++i) ra0[i] = *(const bf16x8*)(A + aoff[i] + (size_t)(kt + 2) * a_kstride);
    }
  };
  auto half_b = [&](int kt) {
    if (kt + 1 < nk) {
      char* bs = smem + ((kt + 1) & 1) * STAGE + BM * 144;
#pragma unroll
      for (int i = 0; i < NB; ++i)
        if (BN % 64 == 0 || lrow + 64 * i < BN) *(bf16x8*)(bs + (lrow + 64 * i) * 144 + c8 * 16) = rb0[i];
    }
    if (kt + 2 < nk) {
#pragma unroll
      for (int i = 0; i < NB; ++i)
        if (BN % 64 == 0 || lrow + 64 * i < BN) rb0[i] = *(const bf16x8*)(bptr + (size_t)(64 * i) * ldb + (kt + 2) * 64);
    }
  };
  auto mm = [&](const char* as, const char* bs, int ks) {
    bf16x8 af[TM], bf[TN];
#pragma unroll
    for (int tn = 0; tn < TN; ++tn) bf[tn] = *(const bf16x8*)(bs + tn * 32 * 144 + ks * 32);
#pragma unroll
    for (int tm = 0; tm < TM; ++tm) af[tm] = *(const bf16x8*)(as + tm * 32 * 144 + ks * 32);
#pragma unroll
    for (int tm = 0; tm < TM; ++tm)
#pragma unroll
      for (int tn = 0; tn < TN; ++tn) acc[tm][tn] = mfma32(bf[tn], af[tm], acc[tm][tn]);
  };
  gload(0, ra0, rb0);
  sstore(0, ra0, rb0);
  if (nk > 1) gload(1, ra0, rb0);
#pragma unroll 1
  for (int kt = 0; kt < nk; ++kt) {
    __syncthreads();
    const char* as = smem + (kt & 1) * STAGE + (wm * TM * 32 + r) * 144 + h * 16;
    const char* bs = smem + (kt & 1) * STAGE + BM * 144 + (wn * TN * 32 + r) * 144 + h * 16;
    __builtin_amdgcn_s_setprio(1);
    mm(as, bs, 0);
    __builtin_amdgcn_s_setprio(0);
    __builtin_amdgcn_sched_barrier(0);
    half_a(kt);
    __builtin_amdgcn_sched_barrier(0);
    __builtin_amdgcn_s_setprio(1);
    mm(as, bs, 1);
    mm(as, bs, 2);
    __builtin_amdgcn_s_setprio(0);
    __builtin_amdgcn_sched_barrier(0);
    half_b(kt);
    __builtin_amdgcn_sched_barrier(0);
    __builtin_amdgcn_s_setprio(1);
    mm(as, bs, 3);
    __builtin_amdgcn_s_setprio(0);
  }
  __syncthreads();
}


template <class RowOff>
DI void gemm_rem(const bf16_t* __restrict__ A, RowOff rowoff, int a_kstride, const bf16_t* __restrict__ Bt, int ldb, int n0,
                 int nk, f32x16& acc, char* smem) {
  constexpr int PITCH = 272, STAGE = (64 + 128) * PITCH;
  const int nk2 = nk >> 1;
  const int tid = threadIdx.x, lane = tid & 63, wid = __builtin_amdgcn_readfirstlane(tid >> 6);
  const int r = lane & 31, h = lane >> 5;
  const int wm = wid >> 2, wn = wid & 3;
  const int lrow = tid >> 3, c8 = tid & 7;
  const bf16_t* ap = A + rowoff(lrow) + c8 * 8;
  const bf16_t* bp = Bt + (size_t)(n0 + lrow) * ldb + c8 * 8;
  bf16x8 ra[2][2], rb0[2][2], rb1[2][2];
  auto gload = [&](int k2, int s) {
#pragma unroll
    for (int hf = 0; hf < 2; ++hf) {
      const int kt = 2 * k2 + hf;
      ra[s][hf] = *(const bf16x8*)(ap + (size_t)kt * a_kstride);
      rb0[s][hf] = *(const bf16x8*)(bp + kt * 64);
      rb1[s][hf] = *(const bf16x8*)(bp + (size_t)64 * ldb + kt * 64);
    }
  };
  auto sstore = [&](int st, int s) {
    char* as = smem + st * STAGE;
#pragma unroll
    for (int hf = 0; hf < 2; ++hf) {
      *(bf16x8*)(as + lrow * PITCH + hf * 128 + c8 * 16) = ra[s][hf];
      *(bf16x8*)(as + (64 + lrow) * PITCH + hf * 128 + c8 * 16) = rb0[s][hf];
      *(bf16x8*)(as + (128 + lrow) * PITCH + hf * 128 + c8 * 16) = rb1[s][hf];
    }
  };
  auto compute = [&](int k2) {
    const char* as = smem + (k2 & 1) * STAGE + (wm * 32 + r) * PITCH + h * 16;
    const char* bs = smem + (k2 & 1) * STAGE + (64 + wn * 32 + r) * PITCH + h * 16;
#pragma unroll
    for (int ks = 0; ks < 8; ++ks) {
      const bf16x8 bf = *(const bf16x8*)(bs + ks * 32);
      const bf16x8 af = *(const bf16x8*)(as + ks * 32);
      acc = mfma32(bf, af, acc);
    }
  };
  gload(0, 0);
  gload(1, 1);
  sstore(0, 0);
  __syncthreads();
#pragma unroll 1
  for (int k2 = 0; k2 < nk2; k2 += 2) {
    if (k2 + 2 < nk2) gload(k2 + 2, 0);
    __builtin_amdgcn_sched_barrier(0);
    compute(k2);
    __builtin_amdgcn_sched_barrier(0);
    sstore(1, 1);
    __syncthreads();
    if (k2 + 3 < nk2) gload(k2 + 3, 1);
    __builtin_amdgcn_sched_barrier(0);
    compute(k2 + 1);
    __builtin_amdgcn_sched_barrier(0);
    if (k2 + 2 < nk2) sstore(0, 0);
    __syncthreads();
  }
}

template <int TM, int TN>
DI void zero_acc(f32x16 (&acc)[TM][TN]) {
#pragma unroll
  for (int a = 0; a < TM; ++a)
#pragma unroll
    for (int b = 0; b < TN; ++b)
#pragma unroll
      for (int i = 0; i < 16; ++i) acc[a][b][i] = 0.f;
}

DI int inproj_src_col(int n) {
  if (n < 1536) return n;
  if (n < 2048) return 1960 + (n - 1536);
  if (n < 2176) return 2472 + (n - 2048);
  if (n < 2304) return 2600 + (n - 2176);
  if (n < 2560) return 1544 + (n - 2304);
  if (n < 2688) return 1800 + (n - 2560);
  if (n < 2720) return 1928 + (n - 2688);
  if (n < 2728) return 1536 + (n - 2720);
  return -1;
}
DI void conv_mat(const float* __restrict__ src, int ldsrc, int K, int Np, const float* __restrict__ gain, int map,
                 bf16_t* __restrict__ dst, int& base, char* smem, int skip = 0) {
  float* tl = (float*)smem;
  const int tk = K / 64, tn = Np / 64, nt = tk * tn;
  const int G = (int)gridDim.x - skip;
  if ((int)blockIdx.x < skip) { base += nt; return; }
  int start = (int)(((long)blockIdx.x - skip - base) % G);
  if (start < 0) start += G;
  const int tid = threadIdx.x;
  const int lk = tid >> 4, n4 = (tid & 15) * 4;
  const int sn = tid >> 3, k8 = (tid & 7) * 8;
  auto issue = [&](int t, f32x4& a, f32x4& b) {
    const int k0 = (t % tk) * 64, n0 = (t / tk) * 64;
    const int nn = n0 + n4;
    int sc;
    if (map == 0) sc = nn;
    else if (map == 1) sc = inproj_src_col(nn);
    else if (map == 2) sc = 2728 + nn;
    else sc = (nn >> 6) * 32 + (nn & 31) + ((nn & 32) ? DFF : 0);
    a = f32x4{0.f, 0.f, 0.f, 0.f};
    b = a;
    if (sc >= 0) {
      a = *(const f32x4*)(src + (size_t)(k0 + lk) * ldsrc + sc);
      b = *(const f32x4*)(src + (size_t)(k0 + lk + 32) * ldsrc + sc);
    }
    if (gain) {
      const float g0 = gain[k0 + lk], g1 = gain[k0 + lk + 32];
#pragma unroll
      for (int j = 0; j < 4; ++j) { a[j] *= g0; b[j] *= g1; }
    }
  };
  f32x4 ca, cb2;
  int t = start;
  if (t < nt) issue(t, ca, cb2);
  while (t < nt) {
#pragma unroll
    for (int j = 0; j < 4; ++j) {
      tl[(n4 + j) * 65 + lk] = ca[j];
      tl[(n4 + j) * 65 + lk + 32] = cb2[j];
    }
    __syncthreads();
    const int tnx = t + G;
    f32x4 na, nb;
    if (tnx < nt) issue(tnx, na, nb);
    {
      const int k0 = (t % tk) * 64, n0 = (t / tk) * 64;
      float v[8];
#pragma unroll
      for (int j = 0; j < 8; ++j) v[j] = tl[sn * 65 + k8 + j];
      *(uint4*)(dst + (size_t)(n0 + sn) * K + k0 + k8) = make_uint4(pk2(v[0], v[1]), pk2(v[2], v[3]), pk2(v[4], v[5]), pk2(v[6], v[7]));
    }
    __syncthreads();
    ca = na; cb2 = nb;
    t = tnx;
  }
  base += nt;
}
DI void convert_layer(const Params& p, int l, char* smem, int parts = 3, int skip = 0) {
  unsigned char* ws = p.ws;
  int base = 0;
  if (parts & 1) {
  const float* w_in = p.in[3] + (size_t)l * 1024 * 5800;
  conv_mat(w_in, 5800, 1024, NIN, p.in[2] + l * 1024, 1, (bf16_t*)(ws + OFF_WIN), base, smem, skip);
  conv_mat(w_in, 5800, 1024, 3072, p.in[2] + l * 1024, 2, (bf16_t*)(ws + OFF_WG), base, smem, skip);
  conv_mat(p.in[8] + (size_t)l * 256 * 768, 768, 256, 768, p.in[7] + l * 256, 0, (bf16_t*)(ws + OFF_WQUP), base, smem, skip);
  conv_mat(p.in[10] + (size_t)l * 128 * 1024, 1024, 128, 1024, p.in[9] + l * 128, 0, (bf16_t*)(ws + OFF_WKVUP), base, smem, skip);
  for (int n = 0; n < 3; ++n)
    conv_mat(p.in[16] + ((size_t)l * 3 + n) * 512 * 1024, 1024, 512, 1024, nullptr, 0,
             (bf16_t*)(ws + OFF_WBR) + (size_t)n * 1024 * 512, base, smem, skip);
  conv_mat(p.in[17] + (size_t)l * 1024 * 1024, 1024, 1024, 1024, nullptr, 0, (bf16_t*)(ws + OFF_WO), base, smem, skip);
  conv_mat(p.in[19] + (size_t)l * 1024 * 5632, 5632, 1024, 5632, p.in[18] + l * 1024, 3, (bf16_t*)(ws + OFF_WUP), base, smem, skip);
  }
  if (parts & 2) conv_mat(p.in[22] + (size_t)l * 2816 * 1024, 1024, 2816, 1024, nullptr, 0, (bf16_t*)(ws + OFF_WDN), base, smem, skip);
}

DI void phase_init(const Params& p) {
  unsigned char* ws = p.ws;
  const int tid = threadIdx.x, lane = tid & 63, wid = tid >> 6;
  const int gw = blockIdx.x * 8 + wid, nw = gridDim.x * 8;
  const int gt = blockIdx.x * NTHREADS + tid, ntot = gridDim.x * NTHREADS;
  float* ss = (float*)(ws + OFF_SS);
  bf16_t* hb = (bf16_t*)(ws + OFF_HB);
#pragma unroll 2
  for (int m = gw; m < T; m += nw) {
    int b = m / L, pos = m - b * L;
    const float* src = pos < 16 ? p.in[1] + pos * D : p.in[0] + ((size_t)(b * SEQ + pos - 16)) * D;
    float* dsth = hrow(p, b, pos);
    float s = 0.f;
#pragma unroll
    for (int i = 0; i < 4; ++i) {
      int c = (i * 64 + lane) * 4;
      f32x4 v = *(const f32x4*)(src + c);
      *(f32x4*)(dsth + c) = v;
      *(uint2*)(hb + (size_t)m * D + c) = pk4(v[0], v[1], v[2], v[3]);
      s += v[0] * v[0] + v[1] * v[1] + v[2] * v[2] + v[3] * v[3];
    }
#pragma unroll
    for (int o = 32; o >= 1; o >>= 1) s += __shfl_xor(s, o);
    if (lane == 0) ss[m] = s;
  }
  for (int i = gt; i < 7 * T; i += ntot) ss[T + i] = 0.f;
  if (gt < 64) ((unsigned*)(ws + OFF_CTR))[gt] = 0u;
  for (int i = gt; i < 3456; i += ntot) ((unsigned*)(ws + OFF_XBAR))[i] = 0u;
  float* rc = (float*)(ws + OFF_ROPE);
  float* rsn = rc + L * 16;
  for (int i = gt; i < L * 16; i += ntot) {
    int pos = i >> 4, c = i & 15;
    double ang = (double)pos * ROPE_FREQ[c];
    double k = rint(ang * 0.15915494309189535);
    double x = ang - k * 6.283185307179586476925;
    double x2 = x * x;
    double sn = 0.0, cs = 0.0;
    double ts = x, tc = 1.0;
#pragma unroll 1
    for (int n = 0; n < 15; ++n) {
      sn += ts;
      cs += tc;
      tc = -tc * x2 / (double)((2 * n + 1) * (2 * n + 2));
      ts = -ts * x2 / (double)((2 * n + 2) * (2 * n + 3));
    }
    rc[i] = (float)cs;
    rsn[i] = (float)sn;
  }
}


struct TileIter {
  int xcd, loc, nloc, per, nt, i;
  bool xmode;
  DI TileIter(int ntiles) {
    nt = ntiles;
    xmode = (gridDim.x & 7) == 0;
    if (xmode) { xcd = blockIdx.x & 7; loc = blockIdx.x >> 3; nloc = gridDim.x >> 3; per = (ntiles + 7) >> 3; i = loc; }
    else { xcd = 0; loc = blockIdx.x; nloc = gridDim.x; per = ntiles; i = loc; }
  }
  DI int next() {
    if (i >= per) return -1;
    const int t = xcd * per + i;
    i += nloc;
    return t < nt ? t : -1;
  }
};

DI void phase_inproj(const Params& p, int l, char* smem) {
  unsigned char* ws = p.ws;
  const bf16_t* hb = (const bf16_t*)(ws + OFF_HB);
  const bf16_t* W = (const bf16_t*)(ws + OFF_WIN);
  const float* ss1 = (const float*)(ws + OFF_SS) + (size_t)(l * 2) * T;
  float* ss_cq = (float*)(ws + OFF_SS) + (size_t)(4 + l) * T;
  float* ss_ckv = (float*)(ws + OFF_SS) + (size_t)(6 + l) * T;
  float* ss_kr = (float*)(ws + OFF_SSKR);
  const int lane = threadIdx.x & 63, wid = __builtin_amdgcn_readfirstlane(threadIdx.x >> 6), r = lane & 31, h = lane >> 5, wm = wid >> 2, wn = wid & 3;
  constexpr int NT = NIN / 256, MT = (T + 255) / 256;
  TileIter tit(NT * MT);
  for (int t = tit.next(); t >= 0; t = tit.next()) {
    const int nt = t % NT, mt = t / NT;
    const int m0 = mt * 256, n0 = nt * 256;
    f32x16 acc[4][2];
    zero_acc(acc);
    gemm_main<2, 4, 4, 2>(hb, [&](int row) { return min(m0 + row, T - 1) * D; }, 64, W, D, n0, D / 64, T - m0, acc, smem);
    const int n0w = n0 + wn * 64;
#pragma unroll
    for (int tm = 0; tm < 4; ++tm) {
      const int m = m0 + wm * 128 + tm * 32 + r;
      const bool valid = m < T;
      const int mm = valid ? m : T - 1;
      const int b = mm / L, pos = mm - b * L;
      const float rs = rsqrtf(ss1[mm] * (1.f / 1024.f) + EPS);
#pragma unroll
      for (int tn = 0; tn < 2; ++tn)
#pragma unroll
        for (int i = 0; i < 16; ++i) acc[tm][tn][i] *= rs;
      float ssq = 0.f;
#pragma unroll
      for (int tn = 0; tn < 2; ++tn)
#pragma unroll
        for (int i = 0; i < 16; ++i) ssq += acc[tm][tn][i] * acc[tm][tn][i];
      if (n0w < 2304) {
        int kind, head, nh;
        const float* gain = nullptr;
        float scale = 1.f;
        bf16_t* dst;
        if (n0w < 512) { kind = 0; head = n0w >> 6; nh = 8; gain = p.in[5] + l * 64; scale = 0.125f * LOG2E; dst = (bf16_t*)(ws + A_QF); }
        else if (n0w < 1024) { kind = 0; head = (n0w - 512) >> 6; nh = 8; gain = p.in[6] + l * 64; dst = (bf16_t*)(ws + A_KF); }
        else if (n0w < 1536) { kind = 1; head = (n0w - 1024) >> 6; nh = 8; dst = (bf16_t*)(ws + A_VF); }
        else if (n0w < 2048) { kind = 0; head = (n0w - 1536) >> 6; nh = 8; gain = p.in[13] + l * 64; scale = 0.125f * LOG2E; dst = (bf16_t*)(ws + A_QS); }
        else if (n0w < 2176) { kind = 0; head = (n0w - 2048) >> 6; nh = 2; gain = p.in[14] + l * 64; dst = (bf16_t*)(ws + A_KS); }
        else { kind = 1; head = (n0w - 2176) >> 6; nh = 2; dst = (bf16_t*)(ws + A_VS); }
        if (kind == 0) {
          const float tot = xor32(ssq);
          const float rr = rsqrtf(tot * (1.f / 64.f) + EPS) * scale;
          bf16_t* drow = dst + ((size_t)(b * nh + head) * LP + pos) * 64;
#pragma unroll
          for (int tn = 0; tn < 2; ++tn)
#pragma unroll
            for (int g4 = 0; g4 < 4; ++g4) {
              const int d = tn * 32 + 8 * g4 + 4 * h;
              const f32x4 gv = *(const f32x4*)(gain + d);
              uint2 o = pk4(acc[tm][tn][4 * g4] * rr * gv[0], acc[tm][tn][4 * g4 + 1] * rr * gv[1],
                            acc[tm][tn][4 * g4 + 2] * rr * gv[2], acc[tm][tn][4 * g4 + 3] * rr * gv[3]);
              if (valid) *(uint2*)(drow + d) = o;
            }
        } else {
          bf16_t* dcol = dst + ((size_t)(b * nh + head) * 64) * LP + pos;
          if (valid) {
#pragma unroll
            for (int tn = 0; tn < 2; ++tn)
#pragma unroll
              for (int i = 0; i < 16; ++i) {
                const int d = tn * 32 + (i & 3) + 8 * (i >> 2) + 4 * h;
                dcol[(size_t)d * LP] = f2bf(acc[tm][tn][i]);
              }
          }
        }
      } else if (n0w < 2688) {
        bf16_t* dst;
        float* ssd;
        int ld, c0;
        if (n0w < 2560) { dst = (bf16_t*)(ws + A_CQ); ssd = ss_cq; ld = 256; c0 = n0w - 2304; }
        else { dst = (bf16_t*)(ws + A_CKV); ssd = ss_ckv; ld = 128; c0 = n0w - 2560; }
        const float tot = xor32(ssq);
        if (valid) {
#pragma unroll
          for (int tn = 0; tn < 2; ++tn)
#pragma unroll
            for (int g4 = 0; g4 < 4; ++g4) {
              const int d = c0 + tn * 32 + 8 * g4 + 4 * h;
              *(uint2*)(dst + (size_t)m * ld + d) =
                  pk4(acc[tm][tn][4 * g4], acc[tm][tn][4 * g4 + 1], acc[tm][tn][4 * g4 + 2], acc[tm][tn][4 * g4 + 3]);
            }
          if (h == 0) atomicAdd(ssd + m, tot);
        }
      } else if (n0w == 2688) {
        float s0 = 0.f;
#pragma unroll
        for (int i = 0; i < 16; ++i) s0 += acc[tm][0][i] * acc[tm][0][i];
        s0 = xor32(s0);
        if (valid) {
          bf16_t* kr = (bf16_t*)(ws + OFF_KR) + (size_t)m * 32;
#pragma unroll
          for (int g4 = 0; g4 < 4; ++g4)
            *(uint2*)(kr + 8 * g4 + 4 * h) =
                pk4(acc[tm][0][4 * g4], acc[tm][0][4 * g4 + 1], acc[tm][0][4 * g4 + 2], acc[tm][0][4 * g4 + 3]);
          if (h == 0) ss_kr[m] = s0;
          float* lf = (float*)(ws + OFF_LF) + (size_t)m * 8 + 4 * h;
          f32x4 o;
#pragma unroll
          for (int j = 0; j < 4; ++j) {
            float x = acc[tm][1][j] + p.in[4][l * 8 + 4 * h + j];
            o[j] = fminf(x, 0.f) - log1pf(__expf(-fabsf(x)));
          }
          *(f32x4*)lf = o;
        }
      }
    }
  }
}

DI void phase_mla_up(const Params& p, int l, char* smem) {
  unsigned char* ws = p.ws;
  const int lane = threadIdx.x & 63, wid = __builtin_amdgcn_readfirstlane(threadIdx.x >> 6), r = lane & 31, h = lane >> 5;
  const float* rope_c = (const float*)(ws + OFF_ROPE);
  const float* rope_s = rope_c + L * 16;
  constexpr int MT = 64;
  {
    const bf16_t* A = (const bf16_t*)(ws + A_CQ);
    const bf16_t* W = (const bf16_t*)(ws + OFF_WQUP);
    const float* ssc = (const float*)(ws + OFF_SS) + (size_t)(4 + l) * T;
    const float* g = p.in[11] + l * 96;
    bf16_t* Qm = (bf16_t*)(ws + A_QM);
    const float qscale = 0.10206207261596575f * LOG2E;
    auto epi = [&](f32x16 (&acc)[1][3], int m, int head) {
      const int b = m / L, pos = m - b * L;
      const float rs = rsqrtf(ssc[m] * (1.f / 256.f) + EPS);
      float ssq = 0.f;
#pragma unroll
      for (int tn = 0; tn < 3; ++tn)
#pragma unroll
        for (int i = 0; i < 16; ++i) { acc[0][tn][i] *= rs; ssq += acc[0][tn][i] * acc[0][tn][i]; }
      ssq = xor32(ssq);
      const float rr = rsqrtf(ssq * (1.f / 96.f) + EPS);
      bf16_t* drow = Qm + ((size_t)(b * 8 + head) * LP + pos) * 96;
#pragma unroll
      for (int tn = 0; tn < 2; ++tn)
#pragma unroll
        for (int g4 = 0; g4 < 4; ++g4) {
          const int d = tn * 32 + 8 * g4 + 4 * h;
          const f32x4 gv = *(const f32x4*)(g + d);
          *(uint2*)(drow + d) = pk4(acc[0][tn][4 * g4] * rr * gv[0] * qscale, acc[0][tn][4 * g4 + 1] * rr * gv[1] * qscale,
                                    acc[0][tn][4 * g4 + 2] * rr * gv[2] * qscale, acc[0][tn][4 * g4 + 3] * rr * gv[3] * qscale);
        }
#pragma unroll
      for (int g4 = 0; g4 < 2; ++g4) {
        const int c = 8 * g4 + 4 * h;
        const f32x4 g1 = *(const f32x4*)(g + 64 + c);
        const f32x4 g2 = *(const f32x4*)(g + 80 + c);
        const f32x4 cs = *(const f32x4*)(rope_c + pos * 16 + c);
        const f32x4 sn = *(const f32x4*)(rope_s + pos * 16 + c);
        float o1[4], o2[4];
#pragma unroll
        for (int j = 0; j < 4; ++j) {
          float x1 = acc[0][2][4 * g4 + j] * rr * g1[j];
          float x2 = acc[0][2][4 * g4 + 8 + j] * rr * g2[j];
          o1[j] = (x1 * cs[j] - x2 * sn[j]) * qscale;
          o2[j] = (x2 * cs[j] + x1 * sn[j]) * qscale;
        }
        *(uint2*)(drow + 64 + c) = pk4(o1[0], o1[1], o1[2], o1[3]);
        *(uint2*)(drow + 80 + c) = pk4(o2[0], o2[1], o2[2], o2[3]);
      }
    };
    for (int t = blockIdx.x; t < 8 * MT; t += gridDim.x) {
      const int head = t % 8, mt = t / 8;
      const int m0 = mt * 256;
      f32x16 acc[1][3];
      zero_acc(acc);
      gemm_main<8, 1, 1, 3>(A, [&](int row) { return (m0 + row) * 256; }, 64, W, 256, head * 96, 4, 256, acc, smem);
      epi(acc, m0 + wid * 32 + r, head);
    }
    for (int nt = (int)blockIdx.x - 8; nt >= 0 && nt < 2; nt += gridDim.x) {
      const int wm = wid >> 2, wn = wid & 3;
      f32x16 acc[1][3];
      zero_acc(acc);
      gemm_main<2, 4, 1, 3>(A, [&](int row) { return min(16384 + row, T - 1) * 256; }, 64, W, 256, nt * 384, 4, 64, acc, smem);
      epi(acc, 16384 + wm * 32 + r, nt * 4 + wn);
    }
  }
  {
    const bf16_t* A = (const bf16_t*)(ws + A_CKV);
    const bf16_t* W = (const bf16_t*)(ws + OFF_WKVUP);
    const float* ssc = (const float*)(ws + OFF_SS) + (size_t)(6 + l) * T;
    const float* ss_kr = (const float*)(ws + OFF_SSKR);
    const bf16_t* krp = (const bf16_t*)(ws + OFF_KR);
    const float* g = p.in[12] + l * 96;
    bf16_t* Km = (bf16_t*)(ws + A_KM);
    bf16_t* Vm = (bf16_t*)(ws + A_VM);
    auto epi = [&](f32x16 (&a)[2], int m, int head, int part) {
      const int b = m / L, pos = m - b * L;
      const float rs = rsqrtf(ssc[m] * (1.f / 128.f) + EPS);
      float ssq = 0.f;
#pragma unroll
      for (int tn = 0; tn < 2; ++tn)
#pragma unroll
        for (int i = 0; i < 16; ++i) { a[tn][i] *= rs; ssq += a[tn][i] * a[tn][i]; }
      ssq = xor32(ssq);
      if (part == 0) {
        const float rr = rsqrtf((ssq + ss_kr[m]) * (1.f / 96.f) + EPS);
        bf16_t* drow = Km + ((size_t)(b * 8 + head) * LP + pos) * 96;
#pragma unroll
        for (int tn = 0; tn < 2; ++tn)
#pragma unroll
          for (int g4 = 0; g4 < 4; ++g4) {
            const int d = tn * 32 + 8 * g4 + 4 * h;
            const f32x4 gv = *(const f32x4*)(g + d);
            *(uint2*)(drow + d) = pk4(a[tn][4 * g4] * rr * gv[0], a[tn][4 * g4 + 1] * rr * gv[1], a[tn][4 * g4 + 2] * rr * gv[2],
                                      a[tn][4 * g4 + 3] * rr * gv[3]);
          }
        const int c0 = 8 * h;
        const bf16x8 k1 = *(const bf16x8*)(krp + (size_t)m * 32 + c0);
        const bf16x8 k2 = *(const bf16x8*)(krp + (size_t)m * 32 + 16 + c0);
        float o1[8], o2[8];
#pragma unroll
        for (int j = 0; j < 8; ++j) {
          float x1 = bf2f((bf16_t)k1[j]) * rr * g[64 + c0 + j];
          float x2 = bf2f((bf16_t)k2[j]) * rr * g[80 + c0 + j];
          float cs = rope_c[pos * 16 + c0 + j], sn = rope_s[pos * 16 + c0 + j];
          o1[j] = x1 * cs - x2 * sn;
          o2[j] = x2 * cs + x1 * sn;
        }
        *(uint4*)(drow + 64 + c0) = make_uint4(pk2(o1[0], o1[1]), pk2(o1[2], o1[3]), pk2(o1[4], o1[5]), pk2(o1[6], o1[7]));
        *(uint4*)(drow + 80 + c0) = make_uint4(pk2(o2[0], o2[1]), pk2(o2[2], o2[3]), pk2(o2[4], o2[5]), pk2(o2[6], o2[7]));
      } else {
        bf16_t* dcol = Vm + ((size_t)(b * 8 + head) * 64) * LP + pos;
#pragma unroll
        for (int tn = 0; tn < 2; ++tn)
#pragma unroll
          for (int i = 0; i < 16; ++i) {
            const int d = tn * 32 + (i & 3) + 8 * (i >> 2) + 4 * h;
            dcol[(size_t)d * LP] = f2bf(a[tn][i]);
          }
      }
    };
    {
      const int wm = wid >> 1, wn = wid & 1;
      for (int t = blockIdx.x; t < 8 * MT; t += gridDim.x) {
        const int head = t % 8, mt = t / 8;
        const int m0 = mt * 256;
        f32x16 acc[2][2];
        zero_acc(acc);
        gemm_main<4, 2, 2, 2>(A, [&](int row) { return (m0 + row) * 128; }, 64, W, 128, head * 128, 2, 256, acc, smem);
#pragma unroll
        for (int tm = 0; tm < 2; ++tm) epi(acc[tm], m0 + wm * 64 + tm * 32 + r, head, wn);
      }
    }
    for (int nt = (int)blockIdx.x - 16; nt >= 0 && nt < 4; nt += gridDim.x) {
      const int wm = wid >> 2, wn = wid & 3;
      f32x16 acc[1][2];
      zero_acc(acc);
      gemm_main<2, 4, 1, 2>(A, [&](int row) { return min(16384 + row, T - 1) * 128; }, 64, W, 128, nt * 256, 2, 64, acc, smem);
      epi(acc[0], 16384 + wm * 32 + r, nt * 2 + (wn >> 1), wn & 1);
    }
  }
  {
    const float* lf = (const float*)(ws + OFF_LF);
    float* cd = (float*)(ws + OFF_CDEC);
    float* wtot = (float*)smem;
    const int tid = threadIdx.x;
    for (int s = (int)blockIdx.x - 32; s >= 0 && s < 32; s += gridDim.x) {
      const int b = s >> 3, hd = s & 7;
      float v[9];
#pragma unroll
      for (int c = 0; c < 9; ++c) {
        const int pos = tid * 9 + c;
        v[c] = pos < L ? lf[((size_t)(b * L + pos)) * 8 + hd] : 0.f;
      }
#pragma unroll
      for (int c = 1; c < 9; ++c) v[c] += v[c - 1];
      float tot = v[8];
#pragma unroll
      for (int o = 1; o < 64; o <<= 1) {
        float u = __shfl_up(tot, o);
        if (lane >= o) tot += u;
      }
      __syncthreads();
      if (lane == 63) wtot[wid] = tot;
      __syncthreads();
      float base = tot - v[8];
      for (int w = 0; w < wid; ++w) base += wtot[w];
#pragma unroll
      for (int c = 0; c < 9; ++c) {
        const int pos = tid * 9 + c;
        if (pos < L) cd[(size_t)s * LP + pos] = v[c] + base;
      }
    }
  }
}

template <int DK, int MODE>
DI void attn_item(bf16_t* Qs, const bf16_t* __restrict__ Ks, const bf16_t* __restrict__ Vt, const float* __restrict__ cdec,
                  int q0, int q_end, float slope2, float sink2, char* smem) {
  constexpr int KROW = (DK + 8) * 2;
  constexpr int KSZ = 64 * KROW;
  constexpr int VSZ = 64 * 136;
  constexpr int STAGE = KSZ + VSZ + 256;
  constexpr int NKC = DK / 8;
  constexpr int NKT = 64 * NKC;
  constexpr int NKL = (NKT + 511) / 512;
  constexpr int NS = DK / 16;
  const int tid = threadIdx.x, lane = tid & 63, w = __builtin_amdgcn_readfirstlane(tid >> 6), r = lane & 31, h = lane >> 5;
  const int qi = q0 + w * 32 + r;
  const bool wave_on = q0 + w * 32 < q_end;
  bf16x8 qf[NS];
#pragma unroll
  for (int s = 0; s < NS; ++s) qf[s] = *(const bf16x8*)(Qs + (size_t)qi * DK + s * 16 + 8 * h);
  const int kt_hi = (q_end - 1) >> 6;
  int t_lo = 0, ntiles;
  if (MODE == 2) { t_lo = max(1, (q0 - 127) >> 6); ntiles = 1 + max(0, kt_hi - t_lo + 1); }
  else ntiles = kt_hi + 1;
  auto tile_of = [&](int j) { return MODE == 2 ? (j == 0 ? 0 : t_lo + j - 1) : j; };

  bf16x8 rk[NKL], rv;
  float rc = 0.f;
  auto gload = [&](int tile) {
    const int k0 = tile * 64;
#pragma unroll
    for (int i = 0; i < NKL; ++i) {
      const int c = tid + i * 512, row = c / NKC, cc = c % NKC;
      if (NKT % 512 == 0 || c < NKT) rk[i] = *(const bf16x8*)(Ks + (size_t)(k0 + row) * DK + cc * 8);
    }
    {
      const int row = tid >> 3, cc = tid & 7;
      rv = *(const bf16x8*)(Vt + (size_t)row * LP + k0 + cc * 8);
    }
    if (MODE == 0 && tid < 64) rc = cdec[k0 + tid] * LOG2E;
  };
  auto sstore = [&](int s) {
    char* kb = smem + s * STAGE;
    char* vb = kb + KSZ;
#pragma unroll
    for (int i = 0; i < NKL; ++i) {
      const int c = tid + i * 512, row = c / NKC, cc = c % NKC;
      if (NKT % 512 == 0 || c < NKT) *(bf16x8*)(kb + row * KROW + cc * 16) = rk[i];
    }
    {
      const int row = tid >> 3, cc = tid & 7;
      s16x4 lo = {rv[0], rv[1], rv[2], rv[3]}, hi = {rv[4], rv[5], rv[6], rv[7]};
      *(s16x4*)(vb + row * 136 + cc * 16) = lo;
      *(s16x4*)(vb + row * 136 + cc * 16 + 8) = hi;
    }
    if (MODE == 0 && tid < 64) *(float*)(vb + VSZ + tid * 4) = rc;
  };

  f32x16 o[2];
#pragma unroll
  for (int i = 0; i < 16; ++i) { o[0][i] = 0.f; o[1][i] = 0.f; }
  float m_run = -1e30f, l_run = 0.f;

  gload(tile_of(0));
  sstore(0);
#pragma unroll
  for (int s = 0; s < NS; ++s) asm volatile("" ::"v"(qf[s]));
  __syncthreads();
  for (int j = 0; j < ntiles; ++j) {
    if (j + 1 < ntiles) gload(tile_of(j + 1));
    __builtin_amdgcn_sched_barrier(0);
    const int k0 = tile_of(j) * 64;
    const char* kb = smem + (j & 1) * STAGE;
    const char* vb = kb + KSZ;
    bool active = wave_on && (k0 <= q0 + w * 32 + 31);
    if (MODE == 2) active = active && (k0 == 0 || k0 + 63 >= q0 + w * 32 - 127);
    if (active) {
      f32x16 s[2];
#pragma unroll
      for (int kt = 0; kt < 2; ++kt) {
#pragma unroll
        for (int i = 0; i < 16; ++i) s[kt][i] = 0.f;
#pragma unroll
        for (int ks = 0; ks < NS; ++ks) {
          bf16x8 kf = *(const bf16x8*)(kb + (kt * 32 + r) * KROW + ks * 32 + h * 16);
          s[kt] = mfma32(kf, qf[ks], s[kt]);
        }
      }
      const bool need_mask = (MODE == 2) || (k0 + 63 > q0 + w * 32);
      float mx = -1e30f;
      if (MODE == 0 || MODE == 2) {
#pragma unroll
        for (int kt = 0; kt < 2; ++kt)
#pragma unroll
          for (int g4 = 0; g4 < 4; ++g4) {
            const int kj0 = k0 + kt * 32 + 8 * g4 + 4 * h;
            f32x4 ck;
            if (MODE == 0) ck = *(const f32x4*)(vb + VSZ + (kt * 32 + 8 * g4 + 4 * h) * 4);
#pragma unroll
            for (int jj = 0; jj < 4; ++jj) {
              if (MODE == 0) s[kt][4 * g4 + jj] -= ck[jj];
              if (MODE == 2) s[kt][4 * g4 + jj] -= slope2 * (float)(qi - kj0 - jj);
            }
          }
      }
      if (__builtin_amdgcn_readfirstlane((int)need_mask)) {
#pragma unroll
        for (int kt = 0; kt < 2; ++kt)
#pragma unroll
          for (int i = 0; i < 16; ++i) {
            const int kj = k0 + kt * 32 + (i & 3) + 8 * (i >> 2) + 4 * h;
            bool ok = kj <= qi;
            if (MODE == 2) ok = ok && (kj < 16 || qi - kj < 128);
            s[kt][i] = ok ? s[kt][i] : -1e30f;
          }
        asm volatile("" ::: "memory");
      }
#pragma unroll
      for (int kt = 0; kt < 2; ++kt)
#pragma unroll
        for (int i = 0; i < 16; ++i) mx = fmaxf(mx, s[kt][i]);
      mx = max32(mx);
      const float m_new = fmaxf(m_run, mx);
      const float alpha = fexp2(m_run - m_new);
      m_run = m_new;
      float psum = 0.f;
#pragma unroll
      for (int kt = 0; kt < 2; ++kt)
#pragma unroll
        for (int i = 0; i < 16; ++i) {
          float pv = fexp2(s[kt][i] - m_new);
          s[kt][i] = pv;
          psum += pv;
        }
      l_run = l_run * alpha + psum;
      if (__builtin_amdgcn_ballot_w64(alpha != 1.f) != 0ull) {
#pragma unroll
        for (int i = 0; i < 16; ++i) { o[0][i] *= alpha; o[1][i] *= alpha; }
      }
#pragma unroll
      for (int kt = 0; kt < 2; ++kt)
#pragma unroll
        for (int st = 0; st < 2; ++st) {
          unsigned pw[4];
#pragma unroll
          for (int u = 0; u < 4; ++u) pw[u] = pk2(s[kt][8 * st + 2 * u], s[kt][8 * st + 2 * u + 1]);
          uint4 pu = make_uint4(pw[0], pw[1], pw[2], pw[3]);
          const bf16x8 pf = __builtin_bit_cast(bf16x8, pu);
#pragma unroll
          for (int dt = 0; dt < 2; ++dt) {
            const char* va = vb + (dt * 32 + r) * 136 + (kt * 32 + 16 * st + 4 * h) * 2;
            const s16x4 lo = *(const s16x4*)va;
            const s16x4 hi = *(const s16x4*)(va + 16);
            const bf16x8 vf = {lo[0], lo[1], lo[2], lo[3], hi[0], hi[1], hi[2], hi[3]};
            o[dt] = mfma32(vf, pf, o[dt]);
          }
        }
    }
    __builtin_amdgcn_sched_barrier(0);
    if (j + 1 < ntiles) sstore((j + 1) & 1);
    __syncthreads();
  }
  float lt = xor32(l_run);
  if (MODE == 2) lt += fexp2(sink2 - m_run);
  const float inv = 1.f / lt;
  if (qi < q_end) {
    bf16_t* orow = Qs + (size_t)qi * DK;
#pragma unroll
    for (int dt = 0; dt < 2; ++dt)
#pragma unroll
      for (int g4 = 0; g4 < 4; ++g4) {
        const int d = dt * 32 + 8 * g4 + 4 * h;
        *(uint2*)(orow + d) = pk4(o[dt][4 * g4] * inv, o[dt][4 * g4 + 1] * inv, o[dt][4 * g4 + 2] * inv, o[dt][4 * g4 + 3] * inv);
      }
  }
}

DI int next_item(unsigned* ctr, int* sidx) {
  if (threadIdx.x == 0) *sidx = (int)atomicAdd(ctr, 1u);
  __syncthreads();
  const int idx = *sidx;
  __syncthreads();
  return idx;
}
DI void phase_attn(const Params& p, int l, char* smem) {
  unsigned char* ws = p.ws;
  unsigned* ctr = (unsigned*)(ws + OFF_CTR) + l * 4;
  int* sidx = (int*)(smem + 147456);
  constexpr int NQT = 17, NIT = 32 * NQT;
#pragma unroll 1
  while (true) {
    const int idx = next_item(ctr, sidx);
    if (idx >= NIT) break;
    const int qt = NQT - 1 - (idx >> 5), bh = idx & 31;
    const int q0 = qt == 0 ? 0 : 16 + 256 * (qt - 1), q_end = qt == 0 ? 16 : q0 + 256;
    attn_item<64, 0>((bf16_t*)(ws + A_QF) + (size_t)bh * LP * 64, (const bf16_t*)(ws + A_KF) + (size_t)bh * LP * 64,
                     (const bf16_t*)(ws + A_VF) + (size_t)bh * 64 * LP, (const float*)(ws + OFF_CDEC) + (size_t)bh * LP, q0, q_end,
                     0.f, 0.f, smem);
  }
#pragma unroll 1
  while (true) {
    const int idx = next_item(ctr + 1, sidx);
    if (idx >= NIT) break;
    const int qt = NQT - 1 - (idx >> 5), bh = idx & 31;
    const int q0 = qt == 0 ? 0 : 16 + 256 * (qt - 1), q_end = qt == 0 ? 16 : q0 + 256;
    attn_item<96, 1>((bf16_t*)(ws + A_QM) + (size_t)bh * LP * 96, (const bf16_t*)(ws + A_KM) + (size_t)bh * LP * 96,
                     (const bf16_t*)(ws + A_VM) + (size_t)bh * 64 * LP, nullptr, q0, q_end, 0.f, 0.f, smem);
  }
#pragma unroll 1
  while (true) {
    const int idx = next_item(ctr + 2, sidx);
    if (idx >= NIT) break;
    const int qt = idx >> 5, bh = idx & 31, b = bh >> 3, hq = bh & 7, hk = hq >> 2;
    const int q0 = qt == 0 ? 0 : 16 + 256 * (qt - 1), q_end = qt == 0 ? 16 : q0 + 256;
    const float slope2 = fexp2(-(float)(hq + 1)) * LOG2E;
    const float sink2 = p.in[15][l * 8 + hq] * LOG2E;
    attn_item<64, 2>((bf16_t*)(ws + A_QS) + (size_t)bh * LP * 64, (const bf16_t*)(ws + A_KS) + (size_t)(b * 2 + hk) * LP * 64,
                     (const bf16_t*)(ws + A_VS) + (size_t)(b * 2 + hk) * 64 * LP, nullptr, q0, q_end, slope2, sink2, smem);
  }
}

DI void phase_merge(const Params& p, int l, char* smem) {
  unsigned char* ws = p.ws;
  const bf16_t* hb = (const bf16_t*)(ws + OFF_HB);
  const bf16_t* Wg = (const bf16_t*)(ws + OFF_WG);
  const bf16_t* Wb = (const bf16_t*)(ws + OFF_WBR);
  const float* ss1 = (const float*)(ws + OFF_SS) + (size_t)(l * 2) * T;
  bf16_t* merged = (bf16_t*)(ws + A_MERGED);
  const int lane = threadIdx.x & 63, wid = __builtin_amdgcn_readfirstlane(threadIdx.x >> 6), r = lane & 31, h = lane >> 5, wm = wid >> 1, wn = wid & 1;
  constexpr int NT = 8, MT = 64;
  TileIter tit(NT * MT);
  for (int t = tit.next(); t >= 0; t = tit.next()) {
    const int nt = t % NT, mt = t / NT;
    const int m0 = mt * 256, n0 = nt * 128;
    float rs[2];
#pragma unroll
    for (int tm = 0; tm < 2; ++tm) rs[tm] = rsqrtf(ss1[min(m0 + wm * 64 + tm * 32 + r, T - 1)] * (1.f / 1024.f) + EPS);
#pragma unroll 1
    for (int n = 0; n < 3; ++n) {
      f32x16 acc[2][2];
      zero_acc(acc);
      gemm_main<4, 2, 2, 2, false>(hb, [&](int row) { return min(m0 + row, T - 1) * D; }, 64, Wg + (size_t)n * 1024 * 1024, D, n0, D / 64,
                            T - m0, acc, smem);
      unsigned gp[2][2][8];
#pragma unroll
      for (int tm = 0; tm < 2; ++tm)
#pragma unroll
      for (int tn = 0; tn < 2; ++tn)
#pragma unroll
        for (int u = 0; u < 8; ++u) {
          float a = __builtin_amdgcn_rcpf(1.f + __expf(-acc[tm][tn][2 * u] * rs[tm]));
          float bq = __builtin_amdgcn_rcpf(1.f + __expf(-acc[tm][tn][2 * u + 1] * rs[tm]));
          gp[tm][tn][u] = pk2(a, bq);
        }
      zero_acc(acc);
      const bf16_t* Ab;
      int rstride, kstride;
      if (n == 0) { Ab = (const bf16_t*)(ws + A_QF); rstride = 64; kstride = LP * 64; }
      else if (n == 1) { Ab = (const bf16_t*)(ws + A_QM); rstride = 96; kstride = LP * 96; }
      else { Ab = (const bf16_t*)(ws + A_QS); rstride = 64; kstride = LP * 64; }
      gemm_main<4, 2, 2, 2, false>(Ab, [&](int row) {
        int mr = min(m0 + row, T - 1);
        int b = mr / L, pos = mr - b * L;
        return (b * 8 * LP + pos) * rstride; }, kstride, Wb + (size_t)n * 1024 * 512, 512, n0, 8, T - m0, acc, smem);
#pragma unroll
      for (int tm = 0; tm < 2; ++tm) {
        const int m = m0 + wm * 64 + tm * 32 + r;
        if (m < T) {
#pragma unroll
          for (int tn = 0; tn < 2; ++tn)
#pragma unroll
            for (int g4 = 0; g4 < 4; ++g4) {
              const int col = n0 + wn * 64 + tn * 32 + 8 * g4 + 4 * h;
              uint2* dst = (uint2*)(merged + (size_t)m * D + col);
              uint2 old = make_uint2(0u, 0u);
              if (n > 0) old = *dst;
              const unsigned g0 = gp[tm][tn][2 * g4], g1 = gp[tm][tn][2 * g4 + 1];
              float f0 = __uint_as_float(g0 << 16) * acc[tm][tn][4 * g4] + __uint_as_float(old.x << 16);
              float f1 = __uint_as_float(g0 & 0xffff0000u) * acc[tm][tn][4 * g4 + 1] + __uint_as_float(old.x & 0xffff0000u);
              float f2 = __uint_as_float(g1 << 16) * acc[tm][tn][4 * g4 + 2] + __uint_as_float(old.y << 16);
              float f3 = __uint_as_float(g1 & 0xffff0000u) * acc[tm][tn][4 * g4 + 3] + __uint_as_float(old.y & 0xffff0000u);
              *dst = pk4(f0, f1, f2, f3);
            }
        }
      }
    }
  }
  {
    const int wm1 = wid >> 2, wn1 = wid & 3;
    float* mrem = (float*)(ws + OFF_MREM);
    for (int u = blockIdx.x; u < 24; u += gridDim.x) {
      const int nt = u & 7, n = u >> 3;
      const int m0 = 16384, n0 = nt * 128;
      const int m = m0 + wm1 * 32 + r;
      const float rs1 = rsqrtf(ss1[m] * (1.f / 1024.f) + EPS);
      {
        f32x16 acc[1][1];
        zero_acc(acc);
        gemm_rem(hb, [&](int row) { return min(m0 + row, T - 1) * D; }, 64, Wg + (size_t)n * 1024 * 1024, D, n0, D / 64, acc[0][0], smem);
        float gv[16];
#pragma unroll
        for (int i = 0; i < 16; ++i) gv[i] = __builtin_amdgcn_rcpf(1.f + __expf(-acc[0][0][i] * rs1));
        zero_acc(acc);
        const bf16_t* Ab;
        int rstride, kstride;
        if (n == 0) { Ab = (const bf16_t*)(ws + A_QF); rstride = 64; kstride = LP * 64; }
        else if (n == 1) { Ab = (const bf16_t*)(ws + A_QM); rstride = 96; kstride = LP * 96; }
        else { Ab = (const bf16_t*)(ws + A_QS); rstride = 64; kstride = LP * 64; }
        gemm_rem(Ab, [&](int row) {
          int mr = min(m0 + row, T - 1);
          int b = mr / L, pos = mr - b * L;
          return (b * 8 * LP + pos) * rstride; }, kstride, Wb + (size_t)n * 1024 * 512, 512, n0, 8, acc[0][0], smem);
        float* drow = mrem + ((size_t)n * 64 + (wm1 * 32 + r)) * 1024 + n0 + wn1 * 32 + 4 * h;
#pragma unroll
        for (int g4 = 0; g4 < 4; ++g4) {
          f32x4 v = {gv[4 * g4] * acc[0][0][4 * g4], gv[4 * g4 + 1] * acc[0][0][4 * g4 + 1], gv[4 * g4 + 2] * acc[0][0][4 * g4 + 2],
                     gv[4 * g4 + 3] * acc[0][0][4 * g4 + 3]};
          *(f32x4*)(drow + 8 * g4) = v;
        }
      }
    }
  }
}


DI void stage_half(const f32x16 (&acc)[4][2], int hp, int wm, int wn, int r, int h, const float (&rowscale)[4], float* stg) {
  if ((wn >> 1) == hp) {
#pragma unroll
    for (int tm = 0; tm < 4; ++tm) {
      float* srow = stg + (wm * 128 + tm * 32 + r) * 132 + (wn & 1) * 64 + 4 * h;
#pragma unroll
      for (int tn = 0; tn < 2; ++tn)
#pragma unroll
        for (int g4 = 0; g4 < 4; ++g4) {
          f32x4 v = {acc[tm][tn][4 * g4] * rowscale[tm], acc[tm][tn][4 * g4 + 1] * rowscale[tm],
                     acc[tm][tn][4 * g4 + 2] * rowscale[tm], acc[tm][tn][4 * g4 + 3] * rowscale[tm]};
          *(f32x4*)(srow + tn * 32 + 8 * g4) = v;
        }
    }
  }
}

DI void phase_resid(const Params& p, const bf16_t* A, int K, const bf16_t* W, float* ss_next, bool last, char* smem) {
  unsigned char* ws = p.ws;
  bf16_t* hb = (bf16_t*)(ws + OFF_HB);
  const int tid = threadIdx.x, lane = tid & 63, wid = __builtin_amdgcn_readfirstlane(tid >> 6), r = lane & 31, h = lane >> 5, wm = wid >> 2, wn = wid & 3;
  constexpr int NT = 4, MT = 64;
  float* stg = (float*)smem;
  TileIter tit(NT * MT);
  for (int t = tit.next(); t >= 0; t = tit.next()) {
    const int nt = t % NT, mt = t / NT;
    const int m0 = mt * 256, n0 = nt * 256;
    f32x16 acc[4][2];
    zero_acc(acc);
    gemm_main<2, 4, 4, 2>(A, [&](int row) { return min(m0 + row, T - 1) * K; }, 64, W, K, n0, K / 64, T - m0, acc, smem);
    const float ones[4] = {1.f, 1.f, 1.f, 1.f};
#pragma unroll 1
    for (int hp = 0; hp < 2; ++hp) {
      const int chunk = tid & 15;
      const int col = n0 + hp * 128 + chunk * 8;
      f32x4 h0[2], h1[2];
      auto hptr = [&](int it) {
        const int m = m0 + (tid >> 4) + 32 * it;
        const int b = m / L, pos = m - b * L;
        return hrow(p, b, pos) + col;
      };
      auto issue = [&](int bt) {
#pragma unroll
        for (int q = 0; q < 2; ++q) {
          const float* hp_ = hptr(bt * 2 + q);
          h0[q] = *(const f32x4*)hp_;
          h1[q] = *(const f32x4*)(hp_ + 4);
        }
      };
      auto process = [&](int bt) {
#pragma unroll
        for (int q = 0; q < 2; ++q) {
          const int row = (tid >> 4) + 32 * (bt * 2 + q);
          const int m = m0 + row;
          float* hp_ = hptr(bt * 2 + q);
          const f32x4 a0 = *(const f32x4*)(stg + row * 132 + chunk * 8);
          const f32x4 a1 = *(const f32x4*)(stg + row * 132 + chunk * 8 + 4);
          f32x4 v0, v1;
          float ssq = 0.f;
#pragma unroll
          for (int j = 0; j < 4; ++j) {
            v0[j] = a0[j] + h0[q][j];
            v1[j] = a1[j] + h1[q][j];
            ssq += v0[j] * v0[j] + v1[j] * v1[j];
          }
          *(f32x4*)hp_ = v0;
          *(f32x4*)(hp_ + 4) = v1;
          if (!last) {
            *(uint4*)(hb + (size_t)m * D + col) = make_uint4(pk2(v0[0], v0[1]), pk2(v0[2], v0[3]), pk2(v1[0], v1[1]), pk2(v1[2], v1[3]));
            ssq += __shfl_xor(ssq, 8);
            ssq += __shfl_xor(ssq, 4);
            ssq += __shfl_xor(ssq, 2);
            ssq += __shfl_xor(ssq, 1);
            if (chunk == 0) atomicAdd(ss_next + m, ssq);
          }
        }
      };
      issue(0);
      stage_half(acc, hp, wm, wn, r, h, ones, stg);
      __syncthreads();
      process(0);
#pragma unroll
      for (int bt = 1; bt < 4; ++bt) {
        __builtin_amdgcn_sched_barrier(0);
        issue(bt);
        process(bt);
      }
      __syncthreads();
    }
  }
  for (int nt = blockIdx.x; nt < 8; nt += gridDim.x) {
    const int m0 = 16384, n0 = nt * 128;
    if (A == (const bf16_t*)(ws + A_MERGED)) {
      const float* mrem = (const float*)(ws + OFF_MREM);
      bf16_t* mg = (bf16_t*)(ws + A_MERGED) + (size_t)16384 * D;
      for (int idx = tid; idx < 64 * 1024 / 4; idx += NTHREADS) {
        const f32x4 a = *(const f32x4*)(mrem + (size_t)idx * 4);
        const f32x4 b = *(const f32x4*)(mrem + (size_t)64 * 1024 + (size_t)idx * 4);
        const f32x4 c = *(const f32x4*)(mrem + (size_t)2 * 64 * 1024 + (size_t)idx * 4);
        *(uint2*)(mg + (size_t)idx * 4) = pk4(a[0] + b[0] + c[0], a[1] + b[1] + c[1], a[2] + b[2] + c[2], a[3] + b[3] + c[3]);
      }
      __threadfence_block();
      __syncthreads();
    }
    f32x16 acc[1][1];
    zero_acc(acc);
    gemm_rem(A, [&](int row) { return min(m0 + row, T - 1) * K; }, 64, W, K, n0, K / 64, acc[0][0], smem);
    const int m = m0 + wm * 32 + r;
    const int b = m / L, pos = m - b * L;
    float* hr = hrow(p, b, pos);
    float ssq = 0.f;
    f32x4 hv[4];
#pragma unroll
    for (int g4 = 0; g4 < 4; ++g4) hv[g4] = *(const f32x4*)(hr + n0 + wn * 32 + 8 * g4 + 4 * h);
#pragma unroll
    for (int g4 = 0; g4 < 4; ++g4) {
      const int col = n0 + wn * 32 + 8 * g4 + 4 * h;
      f32x4 v;
#pragma unroll
      for (int j = 0; j < 4; ++j) { v[j] = hv[g4][j] + acc[0][0][4 * g4 + j]; ssq += v[j] * v[j]; }
      *(f32x4*)(hr + col) = v;
      if (!last) *(uint2*)(hb + (size_t)m * D + col) = pk4(v[0], v[1], v[2], v[3]);
    }
    ssq = xor32(ssq);
    if (!last && h == 0) atomicAdd(ss_next + m, ssq);
  }
}

DI void phase_up(const Params& p, int l, char* smem) {
  unsigned char* ws = p.ws;
  const bf16_t* hb = (const bf16_t*)(ws + OFF_HB);
  const bf16_t* W = (const bf16_t*)(ws + OFF_WUP);
  const float* ss2 = (const float*)(ws + OFF_SS) + (size_t)(l * 2 + 1) * T;
  const float* cw = p.in[20] + (size_t)l * 3 * 5632;
  const float* cb = p.in[21] + (size_t)l * 5632;
  bf16_t* act = (bf16_t*)(ws + A_ACT);
  const int tid = threadIdx.x, lane = tid & 63, wid = __builtin_amdgcn_readfirstlane(tid >> 6), r = lane & 31, h = lane >> 5, wm = wid >> 2, wn = wid & 3;
  constexpr int NT = 5632 / 256, MT = (T + 253) / 254;
  float* stg = (float*)smem;
  TileIter tit(NT * MT);
  for (int t = tit.next(); t >= 0; t = tit.next()) {
    const int nt = t % NT, mt = t / NT;
    const int mbase = mt * 254 - 2, n0 = nt * 256;
    f32x16 acc[4][2];
    zero_acc(acc);
    float rsv[4];
#pragma unroll
    for (int tm = 0; tm < 4; ++tm) rsv[tm] = ss2[min(max(mbase + wm * 128 + tm * 32 + r, 0), T - 1)];
    gemm_main<2, 4, 4, 2>(hb, [&](int row) { return min(max(mbase + row, 0), T - 1) * D; }, 64, W, D, n0, D / 64, T - mbase, acc,
                          smem);
#pragma unroll
    for (int tm = 0; tm < 4; ++tm) rsv[tm] = rsqrtf(rsv[tm] * (1.f / 1024.f) + EPS);
#pragma unroll 1
    for (int hp = 0; hp < 2; ++hp) {
      const int chunk = tid & 15, grp = chunk >> 3, jl0 = (chunk & 7) * 4;
      const int jg0 = (n0 / 64 + hp * 2 + grp) * 32 + jl0;
      f32x4 wg[3], wv[3];
#pragma unroll
      for (int i = 0; i < 3; ++i) {
        wg[i] = *(const f32x4*)(cw + i * 5632 + jg0);
        wv[i] = *(const f32x4*)(cw + i * 5632 + DFF + jg0);
      }
      const f32x4 bg = *(const f32x4*)(cb + jg0), bv = *(const f32x4*)(cb + DFF + jg0);
      stage_half(acc, hp, wm, wn, r, h, rsv, stg);
      __syncthreads();
      {
        const float* sgc = stg + grp * 64 + jl0;
#pragma unroll 2
        for (int it = 0; it < 8; ++it) {
          const int row = 2 + (tid >> 4) + 32 * it;
          const int gm = mbase + row;
          if (row < 256 && gm < T) {
            const int b = gm / L, pos = gm - b * L;
            const float* s0 = sgc + row * 132;
            const f32x4 g0 = *(const f32x4*)(s0), v0 = *(const f32x4*)(s0 + 32);
            const f32x4 g1 = *(const f32x4*)(s0 - 132), v1 = *(const f32x4*)(s0 - 132 + 32);
            const f32x4 g2 = *(const f32x4*)(s0 - 264), v2 = *(const f32x4*)(s0 - 264 + 32);
            float o[4];
#pragma unroll
            for (int j = 0; j < 4; ++j) {
              float a = bg[j] + wg[2][j] * g0[j], c = bv[j] + wv[2][j] * v0[j];
              if (pos >= 1) { a += wg[1][j] * g1[j]; c += wv[1][j] * v1[j]; }
              if (pos >= 2) { a += wg[0][j] * g2[j]; c += wv[0][j] * v2[j]; }
              o[j] = a * __builtin_amdgcn_rcpf(1.f + __expf(-a)) * c;
            }
            *(uint2*)(act + (size_t)gm * DFF + jg0) = pk4(o[0], o[1], o[2], o[3]);
          }
        }
      }
      __syncthreads();
    }
  }
}

#define XB_TMO      128
#define XB_XCNT(j)  (256  + 64 * (j))
#define XB_XSUB(j)  (1280 + 64 * (j))
#define XB_XGEN(j)  (2304 + 64 * (j))
#define XB_TOP      3328
#define XB_TOPGEN   3392
#define XB_SPIN_CAP (1u << 22)
DI unsigned xb_ld(unsigned* p) { return __hip_atomic_load(p, __ATOMIC_RELAXED, __HIP_MEMORY_SCOPE_AGENT); }
DI unsigned xb_add(unsigned* p, unsigned v) { return __hip_atomic_fetch_add(p, v, __ATOMIC_RELAXED, __HIP_MEMORY_SCOPE_AGENT); }
DI unsigned xb_xcc_id() { return (unsigned)__builtin_amdgcn_s_getreg((3 << 11) | 20) & 0xFu; }
#define XB_SPIN(cond, bar) do { unsigned _sp = 0; while (cond) { __builtin_amdgcn_s_sleep(1); \
    if ((++_sp & 255u) == 0u) { if (xb_ld(&(bar)[XB_TMO])) break; if (_sp > XB_SPIN_CAP) { atomicAdd(&(bar)[XB_TMO], 1u); break; } } } } while (0)
DI void xcd_barrier_complete(unsigned* bar, unsigned x, unsigned& nloc, unsigned& nx) {
  const unsigned G = gridDim.x;
  unsigned sum, cnt, mine, sp = 0u;
  for (;;) {
    sum = 0u; cnt = 0u; mine = 0u;
#pragma unroll
    for (unsigned j = 0; j < 16; ++j) { const unsigned c = xb_ld(&bar[XB_XCNT(j)]); sum += c; cnt += (c > 0u) ? 1u : 0u; mine = (j == x) ? c : mine; }
    if (sum == G) break;
    __builtin_amdgcn_s_sleep(1);
    if ((++sp & 255u) == 0u) { if (xb_ld(&bar[XB_TMO])) break; if (sp > XB_SPIN_CAP) { atomicAdd(&bar[XB_TMO], 1u); break; } }
  }
  nloc = mine > 0u ? mine : 1u; nx = cnt > 0u ? cnt : 1u;
}
DI void xcd_barrier(unsigned* bar, unsigned x, volatile unsigned* st) {
  asm volatile("s_waitcnt vmcnt(0)" ::: "memory");
  __syncthreads();
  if (threadIdx.x == 0) {
    __builtin_amdgcn_s_waitcnt(0);
    unsigned nloc = st[0], nx = st[1];
    if (nloc == 0u) { xcd_barrier_complete(bar, x, nloc, nx); st[0] = nloc; st[1] = nx; }
    const unsigned old = xb_add(&bar[XB_XSUB(x)], 1u);
    const unsigned gen = old / nloc;
    if (old + 1u == (gen + 1u) * nloc) {
      __builtin_amdgcn_fence(__ATOMIC_RELEASE, "agent");
      asm volatile("s_waitcnt vmcnt(0)" ::: "memory");
      const unsigned og = xb_add(&bar[XB_TOP], 1u);
      const unsigned tg = og / nx;
      if (og + 1u == (tg + 1u) * nx) xb_add(&bar[XB_TOPGEN], 1u);
      else XB_SPIN(xb_ld(&bar[XB_TOPGEN]) == tg, bar);
      __builtin_amdgcn_fence(__ATOMIC_ACQUIRE, "agent");
      xb_add(&bar[XB_XGEN(x)], 1u);
      asm volatile("s_waitcnt vmcnt(0)" ::: "memory");
    } else {
      XB_SPIN(xb_ld(&bar[XB_XGEN(x)]) == gen, bar);
      __builtin_amdgcn_fence(__ATOMIC_ACQUIRE, "agent");
      asm volatile("s_waitcnt vmcnt(0)" ::: "memory");
    }
  }
  __syncthreads();
}

constexpr int NPHASES = 15;
__global__ void __launch_bounds__(NTHREADS, 2) mega_kernel(Params p) {
  __shared__ __attribute__((aligned(16))) char smem[SMEM_BYTES];
  cg::grid_group grid = cg::this_grid();
  unsigned char* ws = p.ws;
  int ph = 0;
  __shared__ __attribute__((aligned(16))) unsigned xb_st[4];
  unsigned* xbar = (unsigned*)(ws + OFF_XBAR);
  const unsigned xb_x = xb_xcc_id();
  if (threadIdx.x < 4) xb_st[threadIdx.x] = 0u;
#define RUN(body)                                   \
  {                                                 \
    if (ph >= p.ph_lo && ph < p.ph_hi) {            \
      body;                                         \
      if (ph + 1 < p.ph_hi) {                       \
        if (ph == 0) {                              \
          grid.sync();                              \
          if (threadIdx.x == 0) (void)xb_add(&xbar[XB_XCNT(xb_x)], 1u); \
        } else xcd_barrier(xbar, xb_x, xb_st);      \
      }                                             \
    }                                               \
    ++ph;                                           \
  }
  RUN(convert_layer(p, 0, smem); phase_init(p));
#define LAYER(l)                                                                                          \
  RUN(if (l == 1) convert_layer(p, 1, smem, 2); phase_inproj(p, l, smem));                                                                          \
  RUN(phase_mla_up(p, l, smem));                                                                          \
  RUN(phase_attn(p, l, smem));                                                                            \
  RUN(phase_merge(p, l, smem));                                                                           \
  RUN(phase_resid(p, (const bf16_t*)(ws + A_MERGED), 1024, (const bf16_t*)(ws + OFF_WO),                  \
                  (float*)(ws + OFF_SS) + (size_t)(l * 2 + 1) * T, false, smem));                         \
  RUN(phase_up(p, l, smem));                                                                              \
  RUN(phase_resid(p, (const bf16_t*)(ws + A_ACT), DFF, (const bf16_t*)(ws + OFF_WDN),                     \
                  (float*)(ws + OFF_SS) + (size_t)((l + 1) * 2) * T, l == 1, smem); if (l == 0) convert_layer(p, 1, smem, 1, 8));
  LAYER(0)
  LAYER(1)
#undef LAYER
#undef RUN
}

extern "C" void kernel_launch(void* const* d_in, const int* in_sizes, int n_in, void* d_out, int out_size, void* d_ws,
                              size_t ws_size, hipStream_t stream) {
  static int grid_blocks = 0;
  if (!grid_blocks) {
    int dev = 0, cus = 0, per_cu = 0;
    hipGetDevice(&dev);
    hipDeviceGetAttribute(&cus, hipDeviceAttributeMultiprocessorCount, dev);
    hipOccupancyMaxActiveBlocksPerMultiprocessor(&per_cu, mega_kernel, NTHREADS, 0);
    if (per_cu < 1) per_cu = 1;
    if (per_cu > 1) per_cu = 1;
    grid_blocks = cus * per_cu;
    if (ws_size < A_END) fprintf(stderr, "workspace too small: %zu < %zu\n", ws_size, (size_t)A_END);
  }
  Params p{};
  for (int i = 0; i < 23; ++i) p.in[i] = (const float*)d_in[i];
  p.out = (float*)d_out;
  p.ws = (unsigned char*)d_ws;
  p.ph_lo = 0;
  p.ph_hi = NPHASES;
  void* args[] = {&p};
  hipError_t e = hipLaunchCooperativeKernel((void*)mega_kernel, dim3(grid_blocks), dim3(NTHREADS), args, 0, stream);
  if (e != hipSuccess) fprintf(stderr, "cooperative launch failed: %s (grid %d)\n", hipGetErrorString(e), grid_blocks);
}
```
